# Optimizing an MI355X kernel written in HIP

```python
import math
import jax, jax.numpy as jnp
from jax import lax
import numpy as np

D_MODEL = 2048
BATCH = 8
SEQ = 2048
DEPTH = 4

D_FF = 5632
A_DILATION_PAIRS = ((128, 1), (512, 4), (2048, 16))
A_HEADS_PER_GROUP = 4
A_HEADS = A_HEADS_PER_GROUP * len(A_DILATION_PAIRS)
A_HEAD_DIM = 128
A_OUT = A_HEADS_PER_GROUP * A_HEAD_DIM
ALIBI_MAX_BIAS = 8.0
B_HEADS = 8
B_HEAD_DIM = 128
B_WIDTH = B_HEADS * B_HEAD_DIM
B_CONV = 4
B_CHUNK = 64
C_HEAD_DIM = 64
C_HEADS = 16
C_WIDTH = C_HEADS * C_HEAD_DIM
C_DECAY_LORA = 96
C_ICLR_LORA = 96
C_GATE_LORA = 256
C_GN_EPS = 64e-5
A_COLS = 3 * A_HEADS * A_HEAD_DIM
B_COLS = 4 * B_WIDTH + 2 * B_HEADS
C_COLS = 3 * C_WIDTH + C_DECAY_LORA + C_ICLR_LORA + C_GATE_LORA
G_COLS = 3 * D_MODEL
IN_COLS = A_COLS + B_COLS + C_COLS + G_COLS

NORM_EPS = 1e-6
NEG_INF = -1e30

kernel_name = 'hybrid_dilated_gdn_rwkv7_macaron'


def split_cols(t, widths):
    return jnp.split(t, np.cumsum(widths)[:-1].tolist(), axis=-1)


def rms_norm(x, g, eps=NORM_EPS):
    xf = x.astype(jnp.float32)
    y = xf * lax.rsqrt(jnp.mean(xf * xf, axis=-1, keepdims=True) + eps)
    return (y * g.astype(jnp.float32)).astype(x.dtype)


def l2_normalize(x, eps=1e-6):
    xf = x.astype(jnp.float32)
    return xf * lax.rsqrt(jnp.sum(xf * xf, axis=-1, keepdims=True) + eps)


def swiglu(h, w_gu, w_down):
    gate, up = jnp.split(h @ w_gu, 2, axis=-1)
    return (jax.nn.silu(gate) * up) @ w_down


def to_heads(t, n_heads):
    return t.reshape(*t.shape[:-1], n_heads, -1)


def token_shift(x, mu):
    prev = jnp.pad(x, ((0, 0), (1, 0), (0, 0)))[:, :-1]
    return x + (prev - x) * mu


def causal_depthwise_conv(x, w):
    K, S = w.shape[0], x.shape[1]
    xp = jnp.pad(x, ((0, 0), (K - 1, 0), (0, 0)))
    return sum(xp[:, j:j + S] * w[j] for j in range(K))


def banded_causal_attention(q, k, v, slopes, steps, dilation):
    N, H, L, Dh = q.shape
    blk = steps
    nb = -(-L // blk)
    lp = nb * blk
    pad = ((0, 0), (0, 0), (0, lp - L), (0, 0))
    q, k, v = (jnp.pad(t, pad) for t in (q, k, v))

    def band(t):
        prev = jnp.pad(t, ((0, 0), (0, 0), (blk, 0), (0, 0)))[:, :, :lp].reshape(N, H, nb, blk, Dh)
        return jnp.concatenate([prev, t.reshape(N, H, nb, blk, Dh)], axis=3)

    s = jnp.einsum('nhbqd,nhbkd->nhbqk', q.reshape(N, H, nb, blk, Dh), band(k)).astype(jnp.float32) * (Dh ** -0.5)
    qi = jnp.arange(blk)[:, None]
    ki = jnp.arange(2 * blk)[None, :]
    delta = qi + blk - ki
    key_pos = jnp.arange(nb)[:, None, None] * blk - blk + ki[None]
    valid = (delta >= 0) & (delta <= steps) & (key_pos >= 0)
    bias = -slopes[:, None, None, None] * (delta * dilation).astype(jnp.float32)
    s = jnp.where(valid, s + bias, NEG_INF)
    lse = jax.nn.logsumexp(s, axis=-1)
    p = jnp.exp(s - lse[..., None])
    o = jnp.einsum('nhbqk,nhbkd->nhbqd', p.astype(v.dtype), band(v))
    return o.reshape(N, H, lp, Dh)[:, :, :L], lse.reshape(N, H, lp)[:, :, :L]


def mixer_dilated_attention(q, k, v):
    Bn, S = q.shape[0], q.shape[1]
    hpg, dh = A_HEADS_PER_GROUP, A_HEAD_DIM
    slopes = 2.0 ** (-ALIBI_MAX_BIAS * (jnp.arange(A_HEADS, dtype=jnp.float32) + 1.0) / A_HEADS)
    outs, lses = [], []
    for gi, (win, dil) in enumerate(A_DILATION_PAIRS):
        hs = slice(gi * hpg, (gi + 1) * hpg)
        L = S // dil

        def to_residue(t):
            t = t[:, :, hs].reshape(Bn, L, dil, hpg, dh).transpose(0, 2, 3, 1, 4)
            return t.reshape(Bn * dil, hpg, L, dh)

        o, lse = banded_causal_attention(to_residue(q), to_residue(k), to_residue(v), slopes[hs], win // dil, dil)
        outs.append(o.reshape(Bn, dil, hpg, L, dh).transpose(0, 3, 1, 2, 4).reshape(Bn, S, hpg, dh))
        lses.append(lse.reshape(Bn, dil, hpg, L).transpose(0, 3, 1, 2).reshape(Bn, S, hpg))
    wts = jax.nn.softmax(jnp.stack(lses, axis=2), axis=2)
    o = jnp.einsum('bsgh,bsghd->bshd', wts.astype(q.dtype), jnp.stack(outs, axis=2))
    return o.reshape(Bn, S, A_OUT)


def chunked_gated_delta_rule(q, k, v, log_decay, beta):
    Bn, H, S, Dk = q.shape
    Dv = v.shape[-1]
    C = B_CHUNK
    n = S // C
    q, k, v = (t.reshape(Bn, H, n, C, t.shape[-1]) for t in (q, k, v))
    beta = beta.reshape(Bn, H, n, C)
    g = jnp.cumsum(log_decay.reshape(Bn, H, n, C), axis=-1)
    tril = jnp.tril(jnp.ones((C, C), dtype=bool))
    tril_strict = jnp.tril(jnp.ones((C, C), dtype=bool), -1)
    decay = jnp.exp(jnp.where(tril, g[..., :, None] - g[..., None, :], NEG_INF))
    kb = k * beta[..., None]
    vb = v * beta[..., None]
    m = jnp.where(tril_strict, jnp.einsum('bhncd,bhnjd->bhncj', kb, k) * decay, 0.0)
    eye = jnp.eye(C, dtype=jnp.float32)
    rhs = jnp.concatenate([vb, kb * jnp.exp(g)[..., None]], axis=-1)
    sol = lax.linalg.triangular_solve(eye + m, rhs, left_side=True, lower=True, unit_diagonal=True)
    u, w = sol[..., :Dv], sol[..., Dv:]
    att = jnp.where(tril, jnp.einsum('bhncd,bhnjd->bhncj', q, k) * decay, 0.0)
    q_dec = q * jnp.exp(g)[..., None]
    k_dec = k * jnp.exp(g[..., -1:] - g)[..., None]
    chunk_decay = jnp.exp(g[..., -1])

    def step(state, xs):
        q_c, k_c, u_c, w_c, att_c, cd = xs
        v_new = u_c - jnp.einsum('bhck,bhkv->bhcv', w_c, state)
        o_c = jnp.einsum('bhck,bhkv->bhcv', q_c, state) + jnp.einsum('bhcj,bhjv->bhcv', att_c, v_new)
        state = state * cd[..., None, None] + jnp.einsum('bhck,bhcv->bhkv', k_c, v_new)
        return state, o_c

    xs = tuple(jnp.moveaxis(t, 2, 0) for t in (q_dec, k_dec, u, w, att, chunk_decay))
    s0 = jnp.zeros((Bn, H, Dk, Dv), jnp.float32)
    _, o = lax.scan(step, s0, xs)
    return jnp.moveaxis(o, 0, 2).reshape(Bn, H, S, Dv)


def mixer_gated_deltanet(qkv, z, alpha, beta_logit, conv_w, a_log, dt_bias, norm_w):
    Bn, S = qkv.shape[0], qkv.shape[1]
    f32 = jnp.float32
    qkv = jax.nn.silu(causal_depthwise_conv(qkv, conv_w))
    q, k, v = jnp.split(qkv, 3, axis=-1)
    heads = lambda t: to_heads(t, B_HEADS).transpose(0, 2, 1, 3)
    q = l2_normalize(heads(q)) * (B_HEAD_DIM ** -0.5)
    k = l2_normalize(heads(k))
    v = heads(v).astype(f32)
    log_decay = (-jnp.exp(a_log.astype(f32)) * jax.nn.softplus(alpha.astype(f32) + dt_bias.astype(f32))).transpose(0, 2, 1)
    beta = jax.nn.sigmoid(beta_logit.astype(f32)).transpose(0, 2, 1)
    o = chunked_gated_delta_rule(q, k, v, log_decay, beta).transpose(0, 2, 1, 3)
    o = rms_norm(o, norm_w) * jax.nn.silu(to_heads(z, B_HEADS).astype(f32))
    return o.reshape(Bn, S, B_WIDTH).astype(z.dtype)


def rwkv7_recurrence(r, log_w, k, v, kk, a):
    xs = tuple(jnp.moveaxis(t.astype(jnp.float32), 1, 0) for t in (r, log_w, k, v, kk, a))
    Bn, H, N = r.shape[0], r.shape[2], r.shape[3]

    def step(state, inp):
        r_t, lw_t, k_t, v_t, kk_t, a_t = inp
        sa = jnp.einsum('bhvk,bhk->bhv', state, -kk_t)
        state = (state * jnp.exp(lw_t)[:, :, None, :]
                 + sa[..., None] * (kk_t * a_t)[:, :, None, :]
                 + v_t[..., None] * k_t[:, :, None, :])
        return state, jnp.einsum('bhvk,bhk->bhv', state, r_t)

    s0 = jnp.zeros((Bn, H, N, N), jnp.float32)
    _, o = lax.scan(step, s0, xs)
    return jnp.moveaxis(o, 0, 1)


def mixer_rwkv7(cols, mu, w0, w2, a0, a2, g2, k_k, k_a, r_k, gn_w, gn_b):
    Bn, S = cols.shape[0], cols.shape[1]
    cols = token_shift(cols, mu)
    r, k, v, xw, xa, xg = split_cols(cols, (C_WIDTH, C_WIDTH, C_WIDTH, C_DECAY_LORA, C_ICLR_LORA, C_GATE_LORA))
    w = -jax.nn.softplus(-(w0 + jnp.tanh(xw) @ w2)) - 0.5
    log_w = -jnp.exp(w.astype(jnp.float32))
    a = jax.nn.sigmoid(a0 + xa @ a2)
    g = jax.nn.sigmoid(xg) @ g2
    kk = l2_normalize(to_heads(k * k_k, C_HEADS))
    k = k * (1 + (a - 1) * k_a)
    rh, kh, vh = to_heads(r, C_HEADS), to_heads(k, C_HEADS), to_heads(v, C_HEADS)
    o = rwkv7_recurrence(rh, to_heads(log_w, C_HEADS), kh, vh, kk, to_heads(a, C_HEADS))
    mean = jnp.mean(o, axis=-1, keepdims=True)
    var = jnp.mean(jnp.square(o - mean), axis=-1, keepdims=True)
    o = ((o - mean) * lax.rsqrt(var + C_GN_EPS)).reshape(Bn, S, C_WIDTH) * gn_w + gn_b
    bonus = jnp.sum(rh * kh * r_k, axis=-1, keepdims=True) * vh
    o = (o + bonus.reshape(Bn, S, C_WIDTH)) * g
    return o.astype(cols.dtype)


def setup_inputs(seed: int = 0) -> dict:
    key = jax.random.key(seed)
    ks = iter(list(jax.random.split(key, 40)))
    nrm = lambda shape, scale: jax.random.normal(next(ks), shape, jnp.float32) * scale
    unif = lambda shape, lo, hi: jax.random.uniform(next(ks), shape, jnp.float32, lo, hi)
    gain = lambda shape: 1.0 + nrm(shape, 0.02)
    L = DEPTH
    x = nrm((BATCH, SEQ, D_MODEL), 1.0)
    ffn1_norm = gain((L, D_MODEL))
    ffn1_w_gu = nrm((L, D_MODEL, 2 * D_FF), D_MODEL ** -0.5)
    ffn1_w_down = nrm((L, D_FF, D_MODEL), D_FF ** -0.5)
    mix_norm = gain((L, D_MODEL))
    w_in = nrm((L, D_MODEL, IN_COLS), D_MODEL ** -0.5)
    b_conv = nrm((L, B_CONV, 3 * B_WIDTH), B_CONV ** -0.5)
    b_a_log = jnp.log(unif((L, B_HEADS), 1.0, 16.0))
    dt = jnp.exp(unif((L, B_HEADS), math.log(1e-3), math.log(1e-1)))
    b_dt_bias = dt + jnp.log(-jnp.expm1(-dt))
    b_norm = gain((L, B_HEAD_DIM))
    c_mu = unif((L, C_COLS), 0.0, 1.0)
    c_w0 = unif((L, C_WIDTH), -6.5, -1.5)
    c_w2 = nrm((L, C_DECAY_LORA, C_WIDTH), 0.1 * C_DECAY_LORA ** -0.5)
    c_a0 = nrm((L, C_WIDTH), 0.1)
    c_a2 = nrm((L, C_ICLR_LORA, C_WIDTH), 0.5 * C_ICLR_LORA ** -0.5)
    c_g2 = nrm((L, C_GATE_LORA, C_WIDTH), C_GATE_LORA ** -0.5)
    c_k_k = 0.85 + nrm((L, C_WIDTH), 0.05)
    c_k_a = 1.0 + nrm((L, C_WIDTH), 0.05)
    c_r_k = nrm((L, C_HEADS, C_HEAD_DIM), 0.1)
    c_gn_w = gain((L, C_WIDTH))
    c_gn_b = nrm((L, C_WIDTH), 0.01)
    proj_a = nrm((L, A_OUT, D_MODEL), A_OUT ** -0.5)
    proj_b = nrm((L, B_WIDTH, D_MODEL), B_WIDTH ** -0.5)
    proj_c = nrm((L, C_WIDTH, D_MODEL), C_WIDTH ** -0.5)
    w_out = nrm((L, D_MODEL, D_MODEL), D_MODEL ** -0.5)
    ffn2_norm = gain((L, D_MODEL))
    ffn2_w_gu = nrm((L, D_MODEL, 2 * D_FF), D_MODEL ** -0.5)
    ffn2_w_down = nrm((L, D_FF, D_MODEL), D_FF ** -0.5)
    final_norm = gain((D_MODEL,))
    return {'x': x, 'ffn1_norm': ffn1_norm, 'ffn1_w_gu': ffn1_w_gu, 'ffn1_w_down': ffn1_w_down,
            'mix_norm': mix_norm, 'w_in': w_in, 'b_conv': b_conv, 'b_a_log': b_a_log,
            'b_dt_bias': b_dt_bias, 'b_norm': b_norm, 'c_mu': c_mu, 'c_w0': c_w0, 'c_w2': c_w2,
            'c_a0': c_a0, 'c_a2': c_a2, 'c_g2': c_g2, 'c_k_k': c_k_k, 'c_k_a': c_k_a, 'c_r_k': c_r_k,
            'c_gn_w': c_gn_w, 'c_gn_b': c_gn_b, 'proj_a': proj_a, 'proj_b': proj_b, 'proj_c': proj_c,
            'w_out': w_out, 'ffn2_norm': ffn2_norm, 'ffn2_w_gu': ffn2_w_gu, 'ffn2_w_down': ffn2_w_down,
            'final_norm': final_norm}


def reference(x, ffn1_norm, ffn1_w_gu, ffn1_w_down, mix_norm, w_in, b_conv, b_a_log, b_dt_bias, b_norm,
              c_mu, c_w0, c_w2, c_a0, c_a2, c_g2, c_k_k, c_k_a, c_r_k, c_gn_w, c_gn_b,
              proj_a, proj_b, proj_c, w_out, ffn2_norm, ffn2_w_gu, ffn2_w_down, final_norm):
    Bn, S = x.shape[0], x.shape[1]
    for l in range(DEPTH):
        x = x + 0.5 * swiglu(rms_norm(x, ffn1_norm[l]), ffn1_w_gu[l], ffn1_w_down[l])
        h = rms_norm(x, mix_norm[l])
        cols_a, cols_b, cols_c, cols_g = split_cols(h @ w_in[l], (A_COLS, B_COLS, C_COLS, G_COLS))
        qa, ka, va = (to_heads(t, A_HEADS) for t in jnp.split(cols_a, 3, axis=-1))
        y_a = mixer_dilated_attention(qa, ka, va)
        qkv_b, z_b, alpha_b, beta_b = split_cols(cols_b, (3 * B_WIDTH, B_WIDTH, B_HEADS, B_HEADS))
        y_b = mixer_gated_deltanet(qkv_b, z_b, alpha_b, beta_b, b_conv[l], b_a_log[l], b_dt_bias[l], b_norm[l])
        y_c = mixer_rwkv7(cols_c, c_mu[l], c_w0[l], c_w2[l], c_a0[l], c_a2[l], c_g2[l],
                          c_k_k[l], c_k_a[l], c_r_k[l], c_gn_w[l], c_gn_b[l])
        g_a, g_b, g_c = jnp.split(jax.nn.sigmoid(cols_g), 3, axis=-1)
        merged = g_a * (y_a @ proj_a[l]) + g_b * (y_b @ proj_b[l]) + g_c * (y_c @ proj_c[l])
        x = x + merged @ w_out[l]
        x = x + 0.5 * swiglu(rms_norm(x, ffn2_norm[l]), ffn2_w_gu[l], ffn2_w_down[l])
    return rms_norm(x, final_norm)
```

```cpp
#define MK_PER_PHASE 1
#include <hip/hip_runtime.h>
#include <cstdio>
#include <cstdint>
namespace pg8 {
#define PG8_LAS __attribute__((address_space(3)))
typedef unsigned short bf16_t;
typedef short bf16x8 __attribute__((ext_vector_type(8)));
typedef float f32x4 __attribute__((ext_vector_type(4)));
typedef unsigned u32x4 __attribute__((ext_vector_type(4)));
constexpr int BM = 256, BK = 64, HALF = 128, HTB = HALF * BK * 2  , STAGE_BYTES = 8 * HTB, NXCD = 8, WGM = 8;

__host__ __device__ __forceinline__ int lds_byte(int r, int c) { const int st = (r >> 4) * 2 + (c >> 5), rr = r & 15, cc = c & 31, ob = rr * 64 + cc * 2; return st * 1024 + (ob ^ (((ob >> 9) & 1) << 5)); }
__host__ __device__ __forceinline__ void stage_rc(int b, int& R, int& C) { const int st = b / 1024, sb = b % 1024, swz = sb ^ (((sb >> 9) & 1) << 5); R = (st >> 1) * 16 + swz / 64; C = (st & 1) * 32 + (swz % 64) / 2; }
__host__ __device__ __forceinline__ int perm32(int rho) { const int n = rho >> 4, i = rho & 15; return 8 * (i >> 2) + 4 * n + (i & 3); }

struct Unit { int pm, pn; };
struct Gemm { const bf16_t* A; const bf16_t* Bt; int M, N, K; };

struct StaticOrder {
    int nM, nN, nwg, G, c;
    __host__ __device__ void init(int M, int N, int G_, int c_) { nM = M / BM; nN = N / BM; nwg = nM * nN; G = G_; c = c_; }
    __host__ __device__ bool next(int i, Unit& u) const {
        const long L = (long)i * G + c; if (L >= nwg) return false;
        int wgid = (int)L; { const int q = nwg / NXCD, r = nwg % NXCD, xcd = wgid % NXCD, off = wgid / NXCD; wgid = (xcd < r ? xcd * (q + 1) : r * (q + 1) + (xcd - r) * q) + off; }
        const int nig = WGM * nN, gid = wgid / nig, fm = gid * WGM, gsz = (nM - fm) < WGM ? (nM - fm) : WGM;
        u.pm = fm + ((wgid % nig) % gsz); u.pn = (wgid % nig) / gsz; return true;
    }
    __device__ __forceinline__ void a_ready(const Unit&) const {}
    __device__ __forceinline__ void done(const Unit&) const {}
};
__device__ __forceinline__ unsigned cvt_pk_bf16(float lo, float hi) { unsigned r; asm volatile("v_cvt_pk_bf16_f32 %0, %1, %2" : "=v"(r) : "v"(lo), "v"(hi)); return r; }
__device__ __forceinline__ float bf_lo(unsigned w) { return __uint_as_float(w << 16); }
__device__ __forceinline__ float bf_hi(unsigned w) { return __uint_as_float(w & 0xffff0000u); }
__device__ __forceinline__ float sigmoid_f(float x) { return __builtin_amdgcn_rcpf(1.0f + __expf(-x)); }
__device__ __forceinline__ float silu_f(float x) { return x * sigmoid_f(x); }

struct EpiSwiglu {
    static constexpr bool PERM = true, AFTER_DRAIN = false;
    bf16_t* O; int ldc;
    __device__ __forceinline__ void operator()(const f32x4 (&acc)[2][2][4][2], const Unit& u, int wr, int wc, int fr, int fq) const {
        const int row0 = u.pm * BM + wr * 64 + fr, col0 = u.pn * HALF + wc * 32 + 8 * fq;
#pragma unroll
        for (int ai = 0; ai < 2; ++ai)
#pragma unroll
            for (int m = 0; m < 4; ++m) { bf16_t* rowp = O + (size_t)(row0 + ai * HALF + m * 16) * ldc + col0;
                const f32x4 g0 = acc[ai][0][m][0], g1 = acc[ai][0][m][1], u0 = acc[ai][1][m][0], u1 = acc[ai][1][m][1];
                f32x4 v0, v1;
#pragma unroll
                for (int j = 0; j < 4; ++j) { v0[j] = silu_f(g0[j]) * u0[j]; v1[j] = silu_f(g1[j]) * u1[j]; }
                u32x4 w; w.x = cvt_pk_bf16(v0[0], v0[1]); w.y = cvt_pk_bf16(v0[2], v0[3]); w.z = cvt_pk_bf16(v1[0], v1[1]); w.w = cvt_pk_bf16(v1[2], v1[3]);
                *(u32x4*)rowp = w; }
    }
};
struct EpiResid {
    static constexpr bool PERM = false, AFTER_DRAIN = false;
    float* X; int ldc; float scale;
    __device__ __forceinline__ void operator()(const f32x4 (&acc)[2][2][4][2], const Unit& u, int wr, int wc, int fr, int fq) const {
        const int row0 = u.pm * BM + wr * 64 + fr, col0 = u.pn * BM + wc * 32 + 4 * fq;
#pragma unroll
        for (int ai = 0; ai < 2; ++ai)
#pragma unroll
            for (int m = 0; m < 4; ++m) { float* rowp = X + (size_t)(row0 + ai * HALF + m * 16) * ldc + col0;
#pragma unroll
                for (int bj = 0; bj < 2; ++bj)
#pragma unroll
                    for (int n = 0; n < 2; ++n) { f32x4* p = (f32x4*)(rowp + bj * HALF + n * 16); const f32x4 o = *p; *p = o + acc[ai][bj][m][n] * scale; }
                asm volatile("" ::: "memory"); }
    }
};
struct EpiCols {
    static constexpr bool PERM = true, AFTER_DRAIN = false;
    bf16_t *cA, *cB, *cC, *cG;
    __device__ __forceinline__ void operator()(const f32x4 (&acc)[2][2][4][2], const Unit& u, int wr, int wc, int fr, int fq) const {
        bf16_t* base; int ldc, colt;
        if (u.pn < 18) { base = cA; ldc = 4608; colt = u.pn * BM; }
        else if (u.pn < 34) { base = cB; ldc = 4096; colt = (u.pn - 18) * BM; }
        else if (u.pn < 48) { base = cC; ldc = 3584; colt = (u.pn - 34) * BM; }
        else { base = cG; ldc = 6144; colt = (u.pn - 48) * BM; }
        const int row0 = u.pm * BM + wr * 64 + fr, col0 = colt + wc * 32 + 8 * fq;
#pragma unroll
        for (int ai = 0; ai < 2; ++ai)
#pragma unroll
            for (int m = 0; m < 4; ++m) { bf16_t* rowp = base + (size_t)(row0 + ai * HALF + m * 16) * ldc + col0;
#pragma unroll
                for (int bj = 0; bj < 2; ++bj) { const f32x4 v0 = acc[ai][bj][m][0], v1 = acc[ai][bj][m][1];
                    u32x4 w; w.x = cvt_pk_bf16(v0[0], v0[1]); w.y = cvt_pk_bf16(v0[2], v0[3]); w.z = cvt_pk_bf16(v1[0], v1[1]); w.w = cvt_pk_bf16(v1[2], v1[3]);
                    *(u32x4*)(rowp + bj * HALF) = w; } }
    }
};
template <int MODE> struct EpiGate {
    static constexpr bool PERM = true, AFTER_DRAIN = false;
    const bf16_t* G; float* T; bf16_t* O;
    __device__ __forceinline__ void operator()(const f32x4 (&acc)[2][2][4][2], const Unit& u, int wr, int wc, int fr, int fq) const {
        const int row0 = u.pm * BM + wr * 64 + fr, col0 = u.pn * BM + wc * 32 + 8 * fq;
#pragma unroll
        for (int ai = 0; ai < 2; ++ai)
#pragma unroll
            for (int m = 0; m < 4; ++m) { const size_t r = (size_t)(row0 + ai * HALF + m * 16);
#pragma unroll
                for (int bj = 0; bj < 2; ++bj) { const int c = col0 + bj * HALF;
                    const u32x4 gw = *(const u32x4*)(G + r * 6144 + c);
                    f32x4 a0 = acc[ai][bj][m][0], a1 = acc[ai][bj][m][1];
                    a0[0] *= sigmoid_f(bf_lo(gw.x)); a0[1] *= sigmoid_f(bf_hi(gw.x)); a0[2] *= sigmoid_f(bf_lo(gw.y)); a0[3] *= sigmoid_f(bf_hi(gw.y));
                    a1[0] *= sigmoid_f(bf_lo(gw.z)); a1[1] *= sigmoid_f(bf_hi(gw.z)); a1[2] *= sigmoid_f(bf_lo(gw.w)); a1[3] *= sigmoid_f(bf_hi(gw.w));
                    f32x4* tp = (f32x4*)(T + r * 2048 + c);
                    if (MODE == 0) { tp[0] = a0; tp[1] = a1; }
                    else if (MODE == 1) { tp[0] = tp[0] + a0; tp[1] = tp[1] + a1; }
                    else { a0 = a0 + tp[0]; a1 = a1 + tp[1];
                        u32x4 w; w.x = cvt_pk_bf16(a0[0], a0[1]); w.y = cvt_pk_bf16(a0[2], a0[3]); w.z = cvt_pk_bf16(a1[0], a1[1]); w.w = cvt_pk_bf16(a1[2], a1[3]);
                        *(u32x4*)(O + r * 2048 + c) = w; }
                    asm volatile("" ::: "memory"); } }
    }
};

template <class Epi, class Sched, bool ALIGN_EPI = false, bool SP2 = false>
__device__ __forceinline__ void gemm_phase(PG8_LAS unsigned char* lds, const Gemm g, const Sched& S, const Epi& E) {
    int tid_raw = threadIdx.x; asm volatile("" : "+v"(tid_raw));
    const int tid = tid_raw, wid = __builtin_amdgcn_readfirstlane(tid >> 6), lane = tid & 63, wr = wid >> 2, wc = wid & 3, fr = lane & 15, fq = lane >> 4;
    const int K = g.K, nt = K / BK;
    unsigned voffA[2], voffB[2];
#pragma unroll
    for (int i = 0; i < 2; ++i) { int R, C; stage_rc(tid * 16 + i * 8192, R, C); const int Rb = Epi::PERM ? ((R & ~31) + perm32(R & 31)) : R;
        voffA[i] = (unsigned)(R * K + C) * 2u; voffB[i] = (unsigned)(Rb * K + C) * 2u; }
    const size_t kstep = (size_t)(BK * 2);
    const size_t hstep = (size_t)HALF * K * 2;
    const size_t tstep = 2 * hstep;
    const unsigned ldsw = (unsigned)wid * 1024u;
    const int aoff = lds_byte(wr * 64 + fr, fq * 8), boff = lds_byte(wc * 32 + fr, fq * 8);
#define PG8_SA(b, h) (((b) * 2 + (h)) * HTB)
#define PG8_SB(b, h) ((4 + (b) * 2 + (h)) * HTB)
#define PG8_STAGE(bufoff, gbase, voff) do { _Pragma("unroll") for (int _i = 0; _i < 2; ++_i) \
        __builtin_amdgcn_global_load_lds((const unsigned*)((const char*)(gbase) + (voff)[_i]), (PG8_LAS unsigned*)(lds + (bufoff) + ldsw + _i * 8192), 16, 0, 0); } while (0)
#define PG8_LDA(dst, b, h) do { _Pragma("unroll") for (int m = 0; m < 4; ++m) _Pragma("unroll") for (int k = 0; k < 2; ++k) dst[m][k] = *(const PG8_LAS bf16x8*)(lds + PG8_SA(b, h) + aoff + m * 2048 + k * 1024); } while (0)
#define PG8_LDB(dst, b, h) do { _Pragma("unroll") for (int n = 0; n < 2; ++n) _Pragma("unroll") for (int k = 0; k < 2; ++k) dst[n][k] = *(const PG8_LAS bf16x8*)(lds + PG8_SB(b, h) + boff + n * 2048 + k * 1024); } while (0)
#define PG8_MMA(ai, bj, At, Bt) do { __builtin_amdgcn_s_setprio(1); _Pragma("unroll") for (int m = 0; m < 4; ++m) _Pragma("unroll") for (int n = 0; n < 2; ++n) _Pragma("unroll") for (int k = 0; k < 2; ++k) \
        acc[ai][bj][m][n] = __builtin_amdgcn_mfma_f32_16x16x32_bf16(Bt[n][k], At[m][k], acc[ai][bj][m][n], 0, 0, 0); __builtin_amdgcn_s_setprio(0); } while (0)
#define PG8_WAIT_V(n) asm volatile("s_waitcnt vmcnt(" #n ")" ::: "memory")
#define PG8_WAIT_L(n) asm volatile("s_waitcnt lgkmcnt(" #n ")" ::: "memory")
#define PG8_BAR __builtin_amdgcn_s_barrier()
#define PG8_SCHED __builtin_amdgcn_sched_barrier(0)
    Unit cur, nxt; int ui = 0;
    if (!S.next(0, cur)) return;
    f32x4 acc[2][2][4][2];
#pragma unroll
    for (int a = 0; a < 2; ++a)
#pragma unroll
        for (int b = 0; b < 2; ++b)
#pragma unroll
            for (int m = 0; m < 4; ++m)
#pragma unroll
                for (int n = 0; n < 2; ++n) acc[a][b][m][n] = (f32x4){0.f, 0.f, 0.f, 0.f};
    bf16x8 At[4][2], B0[2][2], B1[2][2];
    const char* cA = (const char*)g.A + (size_t)cur.pm * tstep; const char* cB = (const char*)g.Bt + (size_t)cur.pn * tstep;
    S.a_ready(cur);
    if constexpr (SP2) {
        PG8_STAGE(PG8_SB(0, 0), cB, voffB); PG8_STAGE(PG8_SB(0, 1), cB + hstep, voffB); PG8_STAGE(PG8_SA(0, 0), cA, voffA); PG8_STAGE(PG8_SA(0, 1), cA + hstep, voffA);
        if (wr == 1) PG8_BAR;
        PG8_WAIT_V(2); PG8_BAR;
        PG8_STAGE(PG8_SB(1, 0), cB + kstep, voffB); PG8_STAGE(PG8_SA(1, 0), cA + kstep, voffA); PG8_STAGE(PG8_SB(1, 1), cB + hstep + kstep, voffB);
        PG8_WAIT_V(6); PG8_BAR;
    } else {
        PG8_STAGE(PG8_SB(0, 0), cB, voffB); PG8_STAGE(PG8_SA(0, 0), cA, voffA); PG8_STAGE(PG8_SB(0, 1), cB + hstep, voffB); PG8_STAGE(PG8_SA(0, 1), cA + hstep, voffA);
        if (wr == 1) PG8_BAR;
        PG8_WAIT_V(4); PG8_BAR;
        PG8_STAGE(PG8_SB(1, 0), cB + kstep, voffB); PG8_STAGE(PG8_SA(1, 0), cA + kstep, voffA); PG8_STAGE(PG8_SB(1, 1), cB + hstep + kstep, voffB);
        PG8_WAIT_V(6); PG8_BAR;
    }
    for (;;) {
        const bool has_next = S.next(ui + 1, nxt);
        const char* nA = has_next ? (const char*)g.A + (size_t)nxt.pm * tstep : cA; const char* nB = has_next ? (const char*)g.Bt + (size_t)nxt.pn * tstep : cB;
        for (int t = 0; t < nt; t += 2) {
            const bool last = (t == nt - 2);
            const char* a1 = cA + (size_t)(t + 1) * kstep;
            const char* a2 = last ? nA : cA + (size_t)(t + 2) * kstep; const char* b2 = last ? nB : cB + (size_t)(t + 2) * kstep;
            const char* a3 = a2 + kstep; const char* b3 = b2 + kstep;
            if (last && has_next) S.a_ready(nxt);
            if constexpr (SP2) {
            PG8_LDB(B0, 0, 0); PG8_LDB(B1, 0, 1); PG8_SCHED; PG8_LDA(At, 0, 0); PG8_STAGE(PG8_SA(1, 1), a1 + hstep, voffA);
            PG8_WAIT_V(8); PG8_WAIT_L(0); PG8_BAR; PG8_MMA(0, 0, At, B0); PG8_MMA(0, 1, At, B1); PG8_BAR; PG8_SCHED;
            PG8_LDA(At, 0, 1); PG8_STAGE(PG8_SB(0, 0), b2, voffB); PG8_STAGE(PG8_SB(0, 1), b2 + hstep, voffB); PG8_STAGE(PG8_SA(0, 0), a2, voffA);
            PG8_WAIT_V(8); PG8_WAIT_L(0); PG8_BAR; PG8_MMA(1, 0, At, B0); PG8_MMA(1, 1, At, B1); PG8_BAR; PG8_SCHED;
            PG8_LDB(B0, 1, 0); PG8_LDB(B1, 1, 1); PG8_SCHED; PG8_LDA(At, 1, 0); PG8_STAGE(PG8_SA(0, 1), a2 + hstep, voffA);
            PG8_WAIT_V(8); PG8_WAIT_L(0); PG8_BAR; PG8_MMA(0, 0, At, B0); PG8_MMA(0, 1, At, B1); PG8_BAR; PG8_SCHED;
            PG8_LDA(At, 1, 1); PG8_STAGE(PG8_SB(1, 0), b3, voffB); PG8_STAGE(PG8_SB(1, 1), b3 + hstep, voffB); PG8_STAGE(PG8_SA(1, 0), a3, voffA);
            PG8_WAIT_V(8); PG8_WAIT_L(0); PG8_BAR; PG8_MMA(1, 0, At, B0); PG8_MMA(1, 1, At, B1); PG8_BAR; PG8_SCHED;
            } else {
            PG8_LDB(B0, 0, 0); PG8_SCHED; PG8_LDA(At, 0, 0); PG8_STAGE(PG8_SA(1, 1), a1 + hstep, voffA);
            PG8_WAIT_L(8); PG8_BAR; PG8_WAIT_L(0); PG8_MMA(0, 0, At, B0); PG8_BAR; PG8_SCHED;
            PG8_LDB(B1, 0, 1); PG8_STAGE(PG8_SB(0, 0), b2, voffB);
            PG8_BAR; PG8_WAIT_L(0); PG8_MMA(0, 1, At, B1); PG8_BAR;
            PG8_LDA(At, 0, 1); PG8_STAGE(PG8_SA(0, 0), a2, voffA);
            PG8_BAR; PG8_WAIT_L(0); PG8_MMA(1, 0, At, B0); PG8_BAR; PG8_SCHED;
            PG8_STAGE(PG8_SB(0, 1), b2 + hstep, voffB);
            PG8_WAIT_V(6); PG8_BAR; PG8_MMA(1, 1, At, B1); PG8_BAR;
            PG8_LDB(B0, 1, 0); PG8_SCHED; PG8_LDA(At, 1, 0); PG8_STAGE(PG8_SA(0, 1), a2 + hstep, voffA);
            PG8_WAIT_L(8); PG8_BAR; PG8_WAIT_L(0); PG8_MMA(0, 0, At, B0); PG8_BAR; PG8_SCHED;
            PG8_LDB(B1, 1, 1); PG8_STAGE(PG8_SB(1, 0), b3, voffB);
            PG8_BAR; PG8_WAIT_L(0); PG8_MMA(0, 1, At, B1); PG8_BAR;
            PG8_LDA(At, 1, 1); PG8_STAGE(PG8_SA(1, 0), a3, voffA);
            PG8_BAR; PG8_WAIT_L(0); PG8_MMA(1, 0, At, B0); PG8_BAR; PG8_SCHED;
            PG8_STAGE(PG8_SB(1, 1), b3 + hstep, voffB);
            PG8_WAIT_V(6); PG8_BAR; PG8_MMA(1, 1, At, B1); PG8_BAR;
            }
        }
        if constexpr (ALIGN_EPI) { if (wr == 0) PG8_BAR; }
        if constexpr (!Epi::AFTER_DRAIN) { E(acc, cur, wr, wc, fr, fq); S.done(cur); }
        if (!has_next) break;
#pragma unroll
        for (int a = 0; a < 2; ++a)
#pragma unroll
            for (int b = 0; b < 2; ++b)
#pragma unroll
                for (int m = 0; m < 4; ++m)
#pragma unroll
                    for (int n = 0; n < 2; ++n) acc[a][b][m][n] = (f32x4){0.f, 0.f, 0.f, 0.f};
        cur = nxt; cA = nA; cB = nB; ++ui;
        if constexpr (ALIGN_EPI) { if (wr == 1) PG8_BAR; }
    }
    PG8_WAIT_V(0);
    if constexpr (!ALIGN_EPI) { if (wr == 0) PG8_BAR; }
    PG8_BAR;
    if constexpr (Epi::AFTER_DRAIN) { E.fused(acc, cur, wr, wc, fr, fq, lds, wid, lane); S.done(cur); }
#undef PG8_SA
#undef PG8_SB
#undef PG8_STAGE
#undef PG8_LDA
#undef PG8_LDB
#undef PG8_MMA
#undef PG8_WAIT_V
#undef PG8_WAIT_L
#undef PG8_BAR
#undef PG8_SCHED
}
}

constexpr int NWAVES = 8;
constexpr int M = 16384, D = 2048, FF = 5632, SEQ = 2048, DEPTH = 4;
constexpr int NIN_PAD = 18432;
constexpr float NORM_EPS = 1e-6f;
#ifndef MK_PER_PHASE
#define MK_PER_PHASE 0
#endif
constexpr int PH_PER_LAYER = 13, N_PHASES = DEPTH * PH_PER_LAYER + 1;

constexpr size_t MiB = 1u << 20;
constexpr size_t WS_CTL = 0, CTL_ZERO_BYTES = 1 * MiB;
constexpr size_t WS_WB = 1 * MiB;
constexpr size_t W_GU1 = 0, W_D1 = 23068672, W_IN = 34603008, W_PA = 72351744, W_PB = 73400320, W_PC = 75497472, W_WO = 77594624, W_GU2 = 81788928, W_D2 = 104857600;
constexpr size_t WS_H = 223 * MiB;
constexpr size_t WS_CA = 287 * MiB, WS_CB = 431 * MiB, WS_CC = 559 * MiB, WS_CG = 671 * MiB;
constexpr size_t WS_ACT = WS_CA;
constexpr size_t WS_GQ = 863 * MiB, WS_GK = 927 * MiB, WS_GV = 991 * MiB, WS_GO = 1055 * MiB, WS_GLD = 1119 * MiB, WS_GBT = 1119 * MiB + 512 * 1024;
constexpr size_t WS_MT = WS_GQ;
constexpr size_t WS_RR = 1120 * MiB, WS_RK = 1184 * MiB, WS_RV = 1248 * MiB, WS_RD = 1312 * MiB, WS_RKK = 1376 * MiB, WS_RKA = 1440 * MiB, WS_RG = 1504 * MiB;
constexpr size_t WS_YA = 1568 * MiB, WS_YB = 1584 * MiB, WS_YC = 1616 * MiB;
constexpr size_t WS_MB = 1648 * MiB;
constexpr size_t WS_END = 1712 * MiB;
constexpr int CW_BAR = 4096, CW_ATT = 16384;

constexpr int RING_OFF = 0, RING_BYTES = 131072;
constexpr int LDSCTL_OFF = RING_BYTES, MISC_OFF = LDSCTL_OFF + 320;
constexpr int LDS_BYTES = 147456;

#define GAS __attribute__((address_space(1)))
#define LAS __attribute__((address_space(3)))
typedef unsigned short bf16;
typedef unsigned v4u __attribute__((ext_vector_type(4)));
typedef unsigned v2u __attribute__((ext_vector_type(2)));
typedef float f32x4 __attribute__((ext_vector_type(4)));
typedef float f32x2 __attribute__((ext_vector_type(2)));
#define LDS_WAIT() asm volatile("s_waitcnt lgkmcnt(0)" ::: "memory")
#define WAVE_SYNC() do { asm volatile("s_waitcnt lgkmcnt(0)" ::: "memory"); __builtin_amdgcn_wave_barrier(); asm volatile("" ::: "memory"); } while (0)
using pg8::cvt_pk_bf16; using pg8::bf_lo; using pg8::bf_hi; using pg8::sigmoid_f; using pg8::silu_f;

__device__ __forceinline__ float wave_sum(float v) {
#pragma unroll
    for (int o = 1; o < 64; o <<= 1) v += __shfl_xor(v, o);
    return v;
}
__device__ __forceinline__ float wave_max(float v) {
#pragma unroll
    for (int o = 1; o < 64; o <<= 1) v = fmaxf(v, __shfl_xor(v, o));
    return v;
}
__device__ __forceinline__ float softplus_f(float x) { return x > 20.f ? x : log1pf(__expf(x)); }

struct MapId { __device__ __forceinline__ int operator()(int n) const { return n; } };
struct MapGu { __device__ __forceinline__ int operator()(int n) const { return (n >> 8) * 128 + (n & 127) + ((n >> 7) & 1) * FF; } };
struct MapIn { __device__ __forceinline__ int operator()(int n) const {
    if (n < 8704) return n;
    if (n < 12224) return n + 16;
    if (n < 12240) return 8704 + (n - 12224);
    if (n < 12288) return -1;
    return n - 48; } };
template <class Map>
__device__ __forceinline__ void conv_matrix(const float* W, int K, int N, bf16* WT, int NP, Map map, LAS float* scr, int& rot, int gw, int NGW, int lane) {
    const int nblk = NP / 32, nitems = (K / 64) * nblk;
    int start = gw - rot; if (start < 0) start += NGW;
    for (int it = start; it < nitems; it += NGW) {
        const int kb = it / nblk, nb = it % nblk, k0 = 64 * kb, n0 = 32 * nb;
        const int sc = map(n0 + (lane & 31));
#pragma unroll 8
        for (int i = 0; i < 32; ++i) { const int kk = 2 * i + (lane >> 5); scr[kk * 33 + (lane & 31)] = sc >= 0 ? W[(size_t)(k0 + kk) * N + sc] : 0.f; }
        LDS_WAIT(); asm volatile("" ::: "memory");
        const int c = lane & 7;
#pragma unroll
        for (int j = 0; j < 4; ++j) { const int n = (lane >> 3) + 8 * j; const LAS float* s = scr + (8 * c) * 33 + n;
            v4u o; o.x = cvt_pk_bf16(s[0 * 33], s[1 * 33]); o.y = cvt_pk_bf16(s[2 * 33], s[3 * 33]); o.z = cvt_pk_bf16(s[4 * 33], s[5 * 33]); o.w = cvt_pk_bf16(s[6 * 33], s[7 * 33]);
            *(v4u*)(WT + (size_t)(n0 + n) * K + k0 + 8 * c) = o; }
        LDS_WAIT(); asm volatile("" ::: "memory");
    }
    rot = (rot + nitems) % NGW;
}

__device__ __forceinline__ void norm_rows(const float* xs, float* xcopy, const float* gain, bf16* hout, int gw, int NGW, int lane) {
    f32x4 g[8];
#pragma unroll
    for (int j = 0; j < 8; ++j) g[j] = ((const f32x4*)gain)[lane + 64 * j];
    for (int m = gw; m < M; m += NGW) {
        const f32x4* xr = (const f32x4*)(xs + (size_t)m * D) + lane;
        f32x4 v[8]; float s = 0.f;
#pragma unroll
        for (int j = 0; j < 8; ++j) { v[j] = xr[64 * j]; s += (v[j].x * v[j].x + v[j].y * v[j].y) + (v[j].z * v[j].z + v[j].w * v[j].w); }
        s = wave_sum(s); const float rs = 1.0f / sqrtf(s * (1.0f / D) + NORM_EPS);
        if (xcopy) {
#pragma unroll
            for (int j = 0; j < 8; ++j) ((f32x4*)(xcopy + (size_t)m * D))[lane + 64 * j] = v[j]; }
        v2u* o8 = (v2u*)(hout + (size_t)m * D) + lane;
#pragma unroll
        for (int j = 0; j < 8; ++j) { v2u o; o.x = cvt_pk_bf16(v[j].x * rs * g[j].x, v[j].y * rs * g[j].y); o.y = cvt_pk_bf16(v[j].z * rs * g[j].z, v[j].w * rs * g[j].w); o8[64 * j] = o; }
    }
}
__device__ __forceinline__ void final_norm_rows(float* x, const float* gain, int gw, int NGW, int lane) {
    f32x4 g[8];
#pragma unroll
    for (int j = 0; j < 8; ++j) g[j] = ((const f32x4*)gain)[lane + 64 * j];
    for (int m = gw; m < M; m += NGW) {
        f32x4* xr = (f32x4*)(x + (size_t)m * D) + lane;
        f32x4 v[8]; float s = 0.f;
#pragma unroll
        for (int j = 0; j < 8; ++j) { v[j] = xr[64 * j]; s += (v[j].x * v[j].x + v[j].y * v[j].y) + (v[j].z * v[j].z + v[j].w * v[j].w); }
        s = wave_sum(s); const float rs = 1.0f / sqrtf(s * (1.0f / D) + NORM_EPS);
#pragma unroll
        for (int j = 0; j < 8; ++j) xr[64 * j] = v[j] * rs * g[j];
    }
}

__device__ __forceinline__ void gdn_prep(const bf16* cB, const bf16* cC, const float* convw, const float* a_log, const float* dt_bias,
                                         float* GQ, float* GK, float* GV, float* GLD, float* GBT, int gw, int NGW, int lane) {
    for (int it = gw; it < M * 8; it += NGW) {
        const int m = it >> 3, h = it & 7, t = m & (SEQ - 1);
        float acc[3][2] = {{0.f, 0.f}, {0.f, 0.f}, {0.f, 0.f}};
#pragma unroll
        for (int j = 0; j < 4; ++j) { const int tt = t - 3 + j;
            if (tt >= 0) { const bf16* row = cB + (size_t)(m - 3 + j) * 4096 + h * 128 + 2 * lane; const float* wr = convw + j * 3072 + h * 128 + 2 * lane;
#pragma unroll
                for (int s = 0; s < 3; ++s) { const unsigned w = *(const unsigned*)(row + s * 1024); const f32x2 cw = *(const f32x2*)(wr + s * 1024);
                    acc[s][0] += bf_lo(w) * cw.x; acc[s][1] += bf_hi(w) * cw.y; } } }
#pragma unroll
        for (int s = 0; s < 3; ++s) { acc[s][0] = silu_f(acc[s][0]); acc[s][1] = silu_f(acc[s][1]); }
        const float sq = wave_sum(acc[0][0] * acc[0][0] + acc[0][1] * acc[0][1]), sk = wave_sum(acc[1][0] * acc[1][0] + acc[1][1] * acc[1][1]);
        const float rq = (1.0f / sqrtf(sq + 1e-6f)) * 0.08838834764831845f, rk = 1.0f / sqrtf(sk + 1e-6f);
        const size_t o = (size_t)m * 1024 + h * 128 + 2 * lane;
        *(f32x2*)(GQ + o) = (f32x2){acc[0][0] * rq, acc[0][1] * rq};
        *(f32x2*)(GK + o) = (f32x2){acc[1][0] * rk, acc[1][1] * rk};
        *(f32x2*)(GV + o) = (f32x2){acc[2][0], acc[2][1]};
        if (lane == 0) { const float alpha = bf_lo((unsigned)cC[(size_t)m * 3584 + 3520 + h]), bl = bf_lo((unsigned)cC[(size_t)m * 3584 + 3528 + h]);
            GLD[m * 8 + h] = -__expf(a_log[h]) * softplus_f(alpha + dt_bias[h]); GBT[m * 8 + h] = sigmoid_f(bl); }
    }
}
__device__ __forceinline__ void gdn_scan_seq(const float* GQ, const float* GK, const float* GV, const float* GLD, const float* GBT, float* GO, int item, int lane, LAS float* wl) {
    const int b = item >> 5, h = (item >> 2) & 7, col = (item & 3) * 32 + (lane >> 1), kh = lane & 1;
    const size_t base = (size_t)(b * SEQ) * 1024 + h * 128; const int gb = (b * SEQ) * 8 + h;
    const int wpos = 2 * lane + (lane >= 32 ? 4 : 0);
    const LAS float* kl = wl + kh * 68; const LAS float* ql = wl + 136 + kh * 68;
    float S[64];
#pragma unroll
    for (int j = 0; j < 64; ++j) S[j] = 0.f;
    f32x2 kn = *(const f32x2*)(GK + base + 2 * lane), qn = *(const f32x2*)(GQ + base + 2 * lane); float vn = GV[base + col], ldn = GLD[gb], btn = GBT[gb];
    for (int t = 0; t < SEQ; ++t) {
        const f32x2 kc = kn, qc = qn; const float vc = vn, al = __expf(ldn), be = btn;
        if (t + 1 < SEQ) { const size_t o = base + (size_t)(t + 1) * 1024; kn = *(const f32x2*)(GK + o + 2 * lane); qn = *(const f32x2*)(GQ + o + 2 * lane); vn = GV[o + col]; ldn = GLD[gb + (t + 1) * 8]; btn = GBT[gb + (t + 1) * 8]; }
        *(LAS f32x2*)(wl + wpos) = kc; *(LAS f32x2*)(wl + 136 + wpos) = qc;
        WAVE_SYNC();
        float s0 = 0.f, s1 = 0.f, s2 = 0.f, s3 = 0.f;
#pragma unroll
        for (int j = 0; j < 64; j += 4) { const f32x4 k4 = *(const LAS f32x4*)(kl + j); s0 += S[j] * k4.x; s1 += S[j + 1] * k4.y; s2 += S[j + 2] * k4.z; s3 += S[j + 3] * k4.w; }
        float sk = (s0 + s1) + (s2 + s3); sk += __shfl_xor(sk, 1);
        const float vnew = be * (vc - al * sk);
        float o0 = 0.f, o1 = 0.f, o2 = 0.f, o3 = 0.f;
#pragma unroll
        for (int j = 0; j < 64; j += 4) { const f32x4 k4 = *(const LAS f32x4*)(kl + j), q4 = *(const LAS f32x4*)(ql + j);
            S[j] = al * S[j] + k4.x * vnew; S[j + 1] = al * S[j + 1] + k4.y * vnew; S[j + 2] = al * S[j + 2] + k4.z * vnew; S[j + 3] = al * S[j + 3] + k4.w * vnew;
            o0 += S[j] * q4.x; o1 += S[j + 1] * q4.y; o2 += S[j + 2] * q4.z; o3 += S[j + 3] * q4.w; }
        float o = (o0 + o1) + (o2 + o3); o += __shfl_xor(o, 1);
        if (kh == 0) GO[base + (size_t)t * 1024 + col] = o;
        WAVE_SYNC();
    }
}
__device__ __forceinline__ void gdn_post(const float* GO, const bf16* cB, const float* norm_w, bf16* YB, int gw, int NGW, int lane) {
    const f32x2 nw = *(const f32x2*)(norm_w + 2 * lane);
    for (int it = gw; it < M * 8; it += NGW) {
        const int m = it >> 3, h = it & 7; const size_t o = (size_t)m * 1024 + h * 128 + 2 * lane;
        const f32x2 v = *(const f32x2*)(GO + o); const unsigned zw = *(const unsigned*)(cB + (size_t)m * 4096 + 3072 + h * 128 + 2 * lane);
        const float ss = wave_sum(v.x * v.x + v.y * v.y), rs = 1.0f / sqrtf(ss * (1.0f / 128.0f) + NORM_EPS);
        *(unsigned*)(YB + o) = cvt_pk_bf16(v.x * rs * nw.x * silu_f(bf_lo(zw)), v.y * rs * nw.y * silu_f(bf_hi(zw)));
    }
}

__device__ __forceinline__ void rwkv_prep_tile(const bf16* cC, const float* mu, const float* w0, const float* w2, const float* a0, const float* a2, const float* g2, const float* k_k, const float* k_a,
                                               float* RR, float* RK, float* RV, float* RD, float* RKK, float* RKA, float* RG, int tile, int tid, LAS float* actl) {
    const int m0 = tile * 16, t0 = m0 & (SEQ - 1);
    for (int idx = tid; idx < 16 * 448; idx += 512) { const int tok = idx / 448, ci = idx % 448, cc = 3072 + ci, m = m0 + tok;
        const float x = bf_lo((unsigned)cC[(size_t)m * 3584 + cc]), xp = (t0 + tok > 0) ? bf_lo((unsigned)cC[(size_t)(m - 1) * 3584 + cc]) : 0.f;
        const float xs = x + (xp - x) * mu[cc];
        actl[ci * 16 + tok] = ci < 96 ? tanhf(xs) : (ci < 192 ? xs : sigmoid_f(xs)); }
    __syncthreads();
    float aw[2][16], aa[2][16], ag[2][16];
#pragma unroll
    for (int ch = 0; ch < 2; ++ch)
#pragma unroll
        for (int k = 0; k < 16; ++k) { aw[ch][k] = 0.f; aa[ch][k] = 0.f; ag[ch][k] = 0.f; }
    for (int i = 0; i < 96; ++i) {
        const float w20 = w2[i * 1024 + tid], w21 = w2[i * 1024 + tid + 512], a20 = a2[i * 1024 + tid], a21 = a2[i * 1024 + tid + 512];
        float xw[16], xa[16];
#pragma unroll
        for (int q = 0; q < 4; ++q) { const f32x4 u = *(const LAS f32x4*)(actl + i * 16 + 4 * q), v = *(const LAS f32x4*)(actl + (96 + i) * 16 + 4 * q);
            xw[4 * q] = u.x; xw[4 * q + 1] = u.y; xw[4 * q + 2] = u.z; xw[4 * q + 3] = u.w; xa[4 * q] = v.x; xa[4 * q + 1] = v.y; xa[4 * q + 2] = v.z; xa[4 * q + 3] = v.w; }
#pragma unroll
        for (int k = 0; k < 16; ++k) { aw[0][k] += xw[k] * w20; aw[1][k] += xw[k] * w21; aa[0][k] += xa[k] * a20; aa[1][k] += xa[k] * a21; }
    }
    for (int i = 0; i < 256; ++i) {
        const float g20 = g2[i * 1024 + tid], g21 = g2[i * 1024 + tid + 512];
        float xg[16];
#pragma unroll
        for (int q = 0; q < 4; ++q) { const f32x4 u = *(const LAS f32x4*)(actl + (192 + i) * 16 + 4 * q); xg[4 * q] = u.x; xg[4 * q + 1] = u.y; xg[4 * q + 2] = u.z; xg[4 * q + 3] = u.w; }
#pragma unroll
        for (int k = 0; k < 16; ++k) { ag[0][k] += xg[k] * g20; ag[1][k] += xg[k] * g21; }
    }
#pragma unroll
    for (int ch = 0; ch < 2; ++ch) {
        const int c = tid + 512 * ch;
        const float mur = mu[c], muk = mu[1024 + c], muv = mu[2048 + c], w0c = w0[c], a0c = a0[c], kkc = k_k[c], kac = k_a[c];
        float pr = 0.f, pk = 0.f, pv = 0.f;
        if (t0 > 0) { const bf16* rp = cC + (size_t)(m0 - 1) * 3584; pr = bf_lo((unsigned)rp[c]); pk = bf_lo((unsigned)rp[1024 + c]); pv = bf_lo((unsigned)rp[2048 + c]); }
#pragma unroll
        for (int k = 0; k < 16; ++k) {
            const int m = m0 + k; const bf16* rc = cC + (size_t)m * 3584;
            const float xr = bf_lo((unsigned)rc[c]), xk = bf_lo((unsigned)rc[1024 + c]), xv = bf_lo((unsigned)rc[2048 + c]);
            const float r = xr + (pr - xr) * mur, kx = xk + (pk - xk) * muk, v = xv + (pv - xv) * muv;
            pr = xr; pk = xk; pv = xv;
            const float wl_ = w0c + aw[ch][k], w = -softplus_f(-wl_) - 0.5f, dec = __expf(-__expf(w));
            const float a = sigmoid_f(a0c + aa[ch][k]);
            const float kkr = kx * kkc, ss = wave_sum(kkr * kkr), kk = kkr * (1.0f / sqrtf(ss + 1e-6f));
            const float k2 = kx * (1.0f + (a - 1.0f) * kac);
            const size_t o = (size_t)m * 1024 + c;
            RR[o] = r; RK[o] = k2; RV[o] = v; RD[o] = dec; RKK[o] = kk; RKA[o] = kk * a; RG[o] = ag[ch][k];
        }
    }
    __syncthreads();
}
__device__ __forceinline__ void rwkv_scan_seq(const float* RR, const float* RK, const float* RV, const float* RD, const float* RKK, const float* RKA, const float* RG,
                                              const float* r_k, const float* gn_w, const float* gn_b, bf16* YC, int item, int lane, LAS float* wl) {
    const int b = item >> 4, h = item & 15;
    const size_t base = (size_t)(b * SEQ) * 1024 + h * 64 + lane;
    const float rkc = r_k[h * 64 + lane], gwc = gn_w[h * 64 + lane], gbc = gn_b[h * 64 + lane];
    float S[64];
#pragma unroll
    for (int j = 0; j < 64; ++j) S[j] = 0.f;
    float rn = RR[base], kn = RK[base], vn = RV[base], dn = RD[base], kkn = RKK[base], kan = RKA[base], gn = RG[base];
    for (int t = 0; t < SEQ; ++t) {
        const float rc = rn, kc = kn, vc = vn, dc = dn, kkc = kkn, kac = kan, gc = gn;
        if (t + 1 < SEQ) { const size_t o = base + (size_t)(t + 1) * 1024; rn = RR[o]; kn = RK[o]; vn = RV[o]; dn = RD[o]; kkn = RKK[o]; kan = RKA[o]; gn = RG[o]; }
        wl[lane] = rc; wl[64 + lane] = kc; wl[128 + lane] = dc; wl[192 + lane] = kkc; wl[256 + lane] = kac;
        WAVE_SYNC();
        float s0 = 0.f, s1 = 0.f, s2 = 0.f, s3 = 0.f;
#pragma unroll
        for (int j = 0; j < 64; j += 4) { const f32x4 k4 = *(const LAS f32x4*)(wl + 192 + j); s0 += S[j] * k4.x; s1 += S[j + 1] * k4.y; s2 += S[j + 2] * k4.z; s3 += S[j + 3] * k4.w; }
        const float sa = -((s0 + s1) + (s2 + s3));
        float o0 = 0.f, o1 = 0.f, o2 = 0.f, o3 = 0.f;
#pragma unroll
        for (int j = 0; j < 64; j += 4) { const f32x4 r4 = *(const LAS f32x4*)(wl + j), k4 = *(const LAS f32x4*)(wl + 64 + j), d4 = *(const LAS f32x4*)(wl + 128 + j), a4 = *(const LAS f32x4*)(wl + 256 + j);
            S[j] = S[j] * d4.x + sa * a4.x + vc * k4.x; S[j + 1] = S[j + 1] * d4.y + sa * a4.y + vc * k4.y; S[j + 2] = S[j + 2] * d4.z + sa * a4.z + vc * k4.z; S[j + 3] = S[j + 3] * d4.w + sa * a4.w + vc * k4.w;
            o0 += S[j] * r4.x; o1 += S[j + 1] * r4.y; o2 += S[j + 2] * r4.z; o3 += S[j + 3] * r4.w; }
        const float o = (o0 + o1) + (o2 + o3);
        const float mean = wave_sum(o) * (1.0f / 64.0f), dv = o - mean, var = wave_sum(dv * dv) * (1.0f / 64.0f);
        const float on = dv * (1.0f / sqrtf(var + 64e-5f)) * gwc + gbc;
        const float bonus = wave_sum(rc * kc * rkc) * vc;
        const float y = (on + bonus) * gc;
        YC[base + (size_t)t * 1024] = (bf16)(cvt_pk_bf16(y, 0.f) & 0xffffu);
        WAVE_SYNC();
    }
}

__device__ __forceinline__ void attn_item(const bf16* cA, bf16* YA, int item, int lane, LAS float* wl) {
    const int m = item >> 2, slot = item & 3, t = m & (SEQ - 1);
    LAS float* ql = wl; LAS float* pl = wl + 384;
#pragma unroll
    for (int g = 0; g < 3; ++g) { const unsigned w = *(const unsigned*)(cA + (size_t)m * 4608 + (4 * g + slot) * 128 + 2 * lane); *(LAS f32x2*)(ql + g * 128 + 2 * lane) = (f32x2){bf_lo(w), bf_hi(w)}; }
    WAVE_SYNC();
    float mx = -1e30f;
#pragma unroll 1
    for (int g = 0; g < 3; ++g) { const int dil = 1 << (2 * g), h = 4 * g + slot; const float slope = exp2f(-8.0f * (float)(h + 1) / 12.0f);
#pragma unroll 1
        for (int i = 0; i < 3; ++i) { const int jj = lane + 64 * i, tk = t - jj * dil; float sc = -1e30f;
            if (jj <= 128 && tk >= 0) { const v4u* kr = (const v4u*)(cA + (size_t)(m - jj * dil) * 4608 + 1536 + h * 128); float d0 = 0.f, d1 = 0.f;
#pragma unroll 4
                for (int c8 = 0; c8 < 16; ++c8) { const v4u kv = kr[c8]; const f32x4 qa = *(const LAS f32x4*)(ql + g * 128 + 8 * c8), qb = *(const LAS f32x4*)(ql + g * 128 + 8 * c8 + 4);
                    d0 += bf_lo(kv.x) * qa.x + bf_hi(kv.x) * qa.y + bf_lo(kv.y) * qa.z + bf_hi(kv.y) * qa.w;
                    d1 += bf_lo(kv.z) * qb.x + bf_hi(kv.z) * qb.y + bf_lo(kv.w) * qb.z + bf_hi(kv.w) * qb.w; }
                sc = (d0 + d1) * 0.08838834764831845f - slope * (float)(jj * dil); }
            pl[g * 192 + jj] = sc; mx = fmaxf(mx, sc); } }
    mx = wave_max(mx);
    float sum = 0.f;
#pragma unroll 1
    for (int e = 0; e < 9; ++e) { const int idx = (e / 3) * 192 + lane + 64 * (e % 3); const float sc = pl[idx]; const float p = sc > -1e29f ? __expf(sc - mx) : 0.f; sum += p; pl[idx] = p; }
    sum = wave_sum(sum);
    WAVE_SYNC();
    float a0 = 0.f, a1 = 0.f;
#pragma unroll
    for (int g = 0; g < 3; ++g) { const int dil = 1 << (2 * g), h = 4 * g + slot; int nk = t / dil; nk = (nk < 128 ? nk : 128) + 1;
        const bf16* vb = cA + (size_t)m * 4608 + 3072 + h * 128 + 2 * lane; const size_t step = (size_t)dil * 4608;
#pragma unroll 4
        for (int jj = 0; jj < nk; ++jj) { const float p = pl[g * 192 + jj]; const unsigned w = *(const unsigned*)(vb - (size_t)jj * step); a0 += p * bf_lo(w); a1 += p * bf_hi(w); } }
    const float inv = 1.0f / sum;
    *(unsigned*)(YA + (size_t)m * 512 + slot * 128 + 2 * lane) = cvt_pk_bf16(a0 * inv, a1 * inv);
    WAVE_SYNC();
}

#define XB_TMO      128
#define XB_XCNT(j)  (256  + 64 * (j))
#define XB_XSUB(j)  (1280 + 64 * (j))
#define XB_XGEN(j)  (2304 + 64 * (j))
#define XB_TOP      3328
#define XB_TOPGEN   3392
#define XCD_BAR_WORDS 3456
#define XB_SPIN_CAP (1u << 18)

__device__ __forceinline__ unsigned xb_ld(unsigned* p)              { return __hip_atomic_load(p, __ATOMIC_RELAXED, __HIP_MEMORY_SCOPE_AGENT); }
__device__ __forceinline__ unsigned xb_add(unsigned* p, unsigned v) { return __hip_atomic_fetch_add(p, v, __ATOMIC_RELAXED, __HIP_MEMORY_SCOPE_AGENT); }
__device__ __forceinline__ unsigned xb_xcc_id() { return (unsigned)__builtin_amdgcn_s_getreg((3 << 11) | 20) & 0xFu; }
#define XB_SPIN(cond, bar) do { unsigned _sp = 0; while (cond) { __builtin_amdgcn_s_sleep(1); \
    if ((++_sp & 255u) == 0u) { if (xb_ld(&(bar)[XB_TMO])) break; if (_sp > XB_SPIN_CAP) { atomicAdd(&(bar)[XB_TMO], 1u); break; } } } } while (0)

struct XcdBarrier {
    unsigned* bar; unsigned x;
    volatile LAS unsigned* st;
};

__device__ __forceinline__ XcdBarrier xcd_barrier_post(unsigned* bar, volatile LAS unsigned* st) {
    XcdBarrier b; b.bar = bar; b.x = xb_xcc_id(); b.st = st;
    if (threadIdx.x == 0) (void)xb_add(&bar[XB_XCNT(b.x)], 1u);
    return b;
}
__device__ __forceinline__ void xcd_barrier_complete(unsigned* bar, unsigned x, unsigned& nloc, unsigned& nx) {
    const unsigned G = gridDim.x * gridDim.y * gridDim.z;
    unsigned sum, cnt, mine, sp = 0u;
    for (;;) {
        sum = 0u; cnt = 0u; mine = 0u;
#pragma unroll
        for (unsigned j = 0; j < 16; ++j) { const unsigned c = xb_ld(&bar[XB_XCNT(j)]); sum += c; cnt += (c > 0u) ? 1u : 0u; mine = (j == x) ? c : mine; }
        if (sum == G) break;
        __builtin_amdgcn_s_sleep(1);
        if ((++sp & 255u) == 0u) { if (xb_ld(&bar[XB_TMO])) break; if (sp > XB_SPIN_CAP) { atomicAdd(&bar[XB_TMO], 1u); break; } }
    }
    nloc = mine > 0u ? mine : 1u; nx = cnt > 0u ? cnt : 1u;
}

__device__ __forceinline__ void xcd_barrier(const XcdBarrier& b) {
    asm volatile("s_waitcnt vmcnt(0)" ::: "memory");
    __syncthreads();
    if (threadIdx.x == 0) {
        unsigned* bar = b.bar;
        __builtin_amdgcn_s_waitcnt(0);
        unsigned nloc = b.st[0], nx = b.st[1];
        if (nloc == 0u) { xcd_barrier_complete(bar, b.x, nloc, nx); b.st[0] = nloc; b.st[1] = nx; }
        const unsigned old = xb_add(&bar[XB_XSUB(b.x)], 1u);
        const unsigned gen = old / nloc;
        if (old + 1u == (gen + 1u) * nloc) {
            __builtin_amdgcn_fence(__ATOMIC_RELEASE, "agent");
            asm volatile("s_waitcnt vmcnt(0)" ::: "memory");
            const unsigned og = xb_add(&bar[XB_TOP], 1u);
            const unsigned tg = og / nx;
            if (og + 1u == (tg + 1u) * nx) xb_add(&bar[XB_TOPGEN], 1u);
            else XB_SPIN(xb_ld(&bar[XB_TOPGEN]) == tg, bar);
            __builtin_amdgcn_fence(__ATOMIC_ACQUIRE, "agent");
            xb_add(&bar[XB_XGEN(b.x)], 1u);
            asm volatile("s_waitcnt vmcnt(0)" ::: "memory");
        } else {
            XB_SPIN(xb_ld(&bar[XB_XGEN(b.x)]) == gen, bar);
            __builtin_amdgcn_fence(__ATOMIC_ACQUIRE, "agent");
            asm volatile("s_waitcnt vmcnt(0)" ::: "memory");
        }
    }
    __syncthreads();
}

struct Args { const float* in[29]; float* out; unsigned char* ws; int ph_lo, ph_hi; };
__global__ void __launch_bounds__(NWAVES * 64, 2) fwd(Args a) {
    extern __shared__ __attribute__((aligned(16))) unsigned char lds_raw[];
    LAS unsigned char* lds = (LAS unsigned char*)lds_raw;
    const int tid0 = threadIdx.x;
    const int G = gridDim.x, bx = blockIdx.x, NGW = G * NWAVES;
    for (int u = tid0; u < (LDS_BYTES - LDSCTL_OFF) / 4; u += NWAVES * 64) ((LAS unsigned*)(lds + LDSCTL_OFF))[u] = 0u;
    __syncthreads();
    unsigned char* ws = a.ws;
    unsigned* ctl = (unsigned*)(ws + WS_CTL);
    const int lo = a.ph_lo, hi = a.ph_hi;
    XcdBarrier bar; bar.bar = ctl + CW_BAR; bar.x = 0; bar.st = nullptr;
    if (hi - lo > 1) bar = xcd_barrier_post(ctl + CW_BAR, (volatile LAS unsigned*)(lds + MISC_OFF) + 8);
#define PH_IF if (lo <= pc && pc < hi)
#define OPQ(p) asm volatile("" : "+s"(p))
#ifndef SKIPMASK
#define SKIPMASK 0
#endif
#define PH_IFN(k) if (!((SKIPMASK >> (k)) & 1) && lo <= pc && pc < hi)
#define PH_ENTER int tid = tid0; asm volatile("" : "+v"(tid)); const int lane = tid & 63, wave = __builtin_amdgcn_readfirstlane(tid >> 6), gw = bx * NWAVES + wave; LAS float* wl = (LAS float*)(lds + RING_OFF + wave * 16384); (void)lane; (void)gw; (void)wl;
#define PH_SEAM do { if (lo <= pc && pc + 1 < hi) xcd_barrier(bar); ++pc; } while (0)
    bf16* WB = (bf16*)(ws + WS_WB); bf16* H = (bf16*)(ws + WS_H); bf16* ACT = (bf16*)(ws + WS_ACT);
    bf16 *CA = (bf16*)(ws + WS_CA), *CB = (bf16*)(ws + WS_CB), *CC = (bf16*)(ws + WS_CC), *CG = (bf16*)(ws + WS_CG);
    float *GQ = (float*)(ws + WS_GQ), *GK = (float*)(ws + WS_GK), *GV = (float*)(ws + WS_GV), *GO = (float*)(ws + WS_GO), *GLD = (float*)(ws + WS_GLD), *GBT = (float*)(ws + WS_GBT);
    float *RR = (float*)(ws + WS_RR), *RK = (float*)(ws + WS_RK), *RV = (float*)(ws + WS_RV), *RD = (float*)(ws + WS_RD), *RKK = (float*)(ws + WS_RKK), *RKA = (float*)(ws + WS_RKA), *RG = (float*)(ws + WS_RG);
    bf16 *YA = (bf16*)(ws + WS_YA), *YB = (bf16*)(ws + WS_YB), *YC = (bf16*)(ws + WS_YC), *MB = (bf16*)(ws + WS_MB);
    float* MT = (float*)(ws + WS_MT);
    float* X = a.out;

    int pc = 0;
    for (int l = 0; l < DEPTH; ++l) {
        for (int f = 0; f < 2; ++f) {
            PH_IFN(0) { PH_ENTER
                if (f == 0) {
                    int rot = 0;
                    conv_matrix(a.in[2] + (size_t)l * D * 2 * FF, D, 2 * FF, WB + W_GU1, 2 * FF, MapGu(), wl, rot, gw, NGW, lane);
                    conv_matrix(a.in[3] + (size_t)l * FF * D, FF, D, WB + W_D1, D, MapId(), wl, rot, gw, NGW, lane);
                    conv_matrix(a.in[5] + (size_t)l * D * 18384, D, 18384, WB + W_IN, NIN_PAD, MapIn(), wl, rot, gw, NGW, lane);
                    conv_matrix(a.in[21] + (size_t)l * 512 * D, 512, D, WB + W_PA, D, MapId(), wl, rot, gw, NGW, lane);
                    conv_matrix(a.in[22] + (size_t)l * 1024 * D, 1024, D, WB + W_PB, D, MapId(), wl, rot, gw, NGW, lane);
                    conv_matrix(a.in[23] + (size_t)l * 1024 * D, 1024, D, WB + W_PC, D, MapId(), wl, rot, gw, NGW, lane);
                    conv_matrix(a.in[24] + (size_t)l * D * D, D, D, WB + W_WO, D, MapId(), wl, rot, gw, NGW, lane);
                    conv_matrix(a.in[26] + (size_t)l * D * 2 * FF, D, 2 * FF, WB + W_GU2, 2 * FF, MapGu(), wl, rot, gw, NGW, lane);
                    conv_matrix(a.in[27] + (size_t)l * FF * D, FF, D, WB + W_D2, D, MapId(), wl, rot, gw, NGW, lane);
                }
                const bool first = (l == 0 && f == 0);
                norm_rows(first ? a.in[0] : X, first ? X : nullptr, (f == 0 ? a.in[1] : a.in[25]) + (size_t)l * D, H, gw, NGW, lane);
            }
            PH_SEAM;
            PH_IFN(1) { PH_ENTER
                const bf16* pa_ = H; const bf16* pb_ = WB + (f == 0 ? W_GU1 : W_GU2); bf16* po_ = ACT; OPQ(pa_); OPQ(pb_); OPQ(po_);
                pg8::Gemm g{pa_, pb_, M, 2 * FF, D}; pg8::StaticOrder S; S.init(M, 2 * FF, G, bx);
                pg8::EpiSwiglu E{po_, FF};
                pg8::gemm_phase<pg8::EpiSwiglu, pg8::StaticOrder, true, true>(lds + RING_OFF, g, S, E);
            }
            PH_SEAM;
            PH_IFN(2) { PH_ENTER
                const bf16* pa_ = ACT; const bf16* pb_ = WB + (f == 0 ? W_D1 : W_D2); float* po_ = X; OPQ(pa_); OPQ(pb_); OPQ(po_);
                pg8::Gemm g{pa_, pb_, M, D, FF}; pg8::StaticOrder S; S.init(M, D, G, bx);
                pg8::EpiResid E{po_, D, 0.5f};
                pg8::gemm_phase<pg8::EpiResid, pg8::StaticOrder, true, true>(lds + RING_OFF, g, S, E);
            }
            PH_SEAM;
            if (f == 0) {
                PH_IFN(3) { PH_ENTER const float* px = X; bf16* ph = H; OPQ(px); OPQ(ph); norm_rows(px, nullptr, a.in[4] + (size_t)l * D, ph, gw, NGW, lane); }
                PH_SEAM;
                PH_IFN(4) { PH_ENTER
                    const bf16* pa_ = H; const bf16* pb_ = WB + W_IN; bf16 *o0 = CA, *o1 = CB, *o2 = CC, *o3 = CG; OPQ(pa_); OPQ(pb_); OPQ(o0); OPQ(o1); OPQ(o2); OPQ(o3);
                    pg8::Gemm g{pa_, pb_, M, NIN_PAD, D}; pg8::StaticOrder S; S.init(M, NIN_PAD, G, bx);
                    pg8::EpiCols E{o0, o1, o2, o3};
                    pg8::gemm_phase<pg8::EpiCols, pg8::StaticOrder, true, true>(lds + RING_OFF, g, S, E);
                }
                PH_SEAM;
                PH_IFN(5) { PH_ENTER
                    for (int tile = bx; tile < M / 16; tile += G)
                        rwkv_prep_tile(CC, a.in[10] + (size_t)l * 3520, a.in[11] + (size_t)l * 1024, a.in[12] + (size_t)l * 96 * 1024, a.in[13] + (size_t)l * 1024, a.in[14] + (size_t)l * 96 * 1024,
                                       a.in[15] + (size_t)l * 256 * 1024, a.in[16] + (size_t)l * 1024, a.in[17] + (size_t)l * 1024, RR, RK, RV, RD, RKK, RKA, RG, tile, tid, (LAS float*)(lds + RING_OFF));
                    gdn_prep(CB, CC, a.in[6] + (size_t)l * 4 * 3072, a.in[7] + (size_t)l * 8, a.in[8] + (size_t)l * 8, GQ, GK, GV, GLD, GBT, gw, NGW, lane);
                }
                PH_SEAM;
                PH_IFN(6) { PH_ENTER
                    if (wave == 0) for (int item = bx; item < 256; item += G) gdn_scan_seq(GQ, GK, GV, GLD, GBT, GO, item, lane, wl);
                    if (wave == 1) for (int item = bx; item < 128; item += G) rwkv_scan_seq(RR, RK, RV, RD, RKK, RKA, RG, a.in[18] + (size_t)l * 1024, a.in[19] + (size_t)l * 1024, a.in[20] + (size_t)l * 1024, YC, item, lane, wl);
                    unsigned* ctr = ctl + CW_ATT + l * 64;
                    for (;;) {
                        int it = 0; if (lane == 0) it = (int)__hip_atomic_fetch_add(ctr, 1u, __ATOMIC_RELAXED, __HIP_MEMORY_SCOPE_AGENT);
                        it = __builtin_amdgcn_readfirstlane(it);
                        if (it >= M * 4) break;
                        attn_item(CA, YA, it, lane, wl);
                    }
                }
                PH_SEAM;
                PH_IFN(7) { PH_ENTER const float* p0 = GO; const bf16* p1 = CB; bf16* p2 = YB; OPQ(p0); OPQ(p1); OPQ(p2); gdn_post(p0, p1, a.in[9] + (size_t)l * 128, p2, gw, NGW, lane); }
                PH_SEAM;
                PH_IFN(8) { PH_ENTER
                    pg8::StaticOrder S; S.init(M, D, G, bx);
                    { const bf16* pa_ = YA; const bf16* pb_ = WB + W_PA; const bf16* pg_ = CG; float* pt_ = MT; bf16* po_ = MB; OPQ(pa_); OPQ(pb_); OPQ(pg_); OPQ(pt_); OPQ(po_);
                      pg8::Gemm g{pa_, pb_, M, D, 512}; pg8::EpiGate<0> E{pg_, pt_, po_}; pg8::gemm_phase<pg8::EpiGate<0>, pg8::StaticOrder, true, true>(lds + RING_OFF, g, S, E); }
                    { const bf16* pa_ = YB; const bf16* pb_ = WB + W_PB; const bf16* pg_ = CG + 2048; float* pt_ = MT; bf16* po_ = MB; OPQ(pa_); OPQ(pb_); OPQ(pg_); OPQ(pt_); OPQ(po_);
                      pg8::Gemm g{pa_, pb_, M, D, 1024}; pg8::EpiGate<1> E{pg_, pt_, po_}; pg8::gemm_phase<pg8::EpiGate<1>, pg8::StaticOrder, true, true>(lds + RING_OFF, g, S, E); }
                    { const bf16* pa_ = YC; const bf16* pb_ = WB + W_PC; const bf16* pg_ = CG + 4096; float* pt_ = MT; bf16* po_ = MB; OPQ(pa_); OPQ(pb_); OPQ(pg_); OPQ(pt_); OPQ(po_);
                      pg8::Gemm g{pa_, pb_, M, D, 1024}; pg8::EpiGate<2> E{pg_, pt_, po_}; pg8::gemm_phase<pg8::EpiGate<2>, pg8::StaticOrder, true, true>(lds + RING_OFF, g, S, E); }
                }
                PH_SEAM;
                PH_IFN(9) { PH_ENTER
                    const bf16* pa_ = MB; const bf16* pb_ = WB + W_WO; float* po_ = X; OPQ(pa_); OPQ(pb_); OPQ(po_);
                    pg8::Gemm g{pa_, pb_, M, D, D}; pg8::StaticOrder S; S.init(M, D, G, bx);
                    pg8::EpiResid E{po_, D, 1.0f};
                    pg8::gemm_phase<pg8::EpiResid, pg8::StaticOrder, true, true>(lds + RING_OFF, g, S, E);
                }
                PH_SEAM;
            }
        }
    }
    PH_IFN(10) { PH_ENTER float* px = X; OPQ(px); final_norm_rows(px, a.in[28], gw, NGW, lane); }
#undef PH_IF
#undef PH_SEAM
}

extern "C" void kernel_launch(void* const* d_in, const int* in_sizes, int n_in, void* d_out, int out_size, void* d_ws, size_t ws_size, hipStream_t stream) {
    static int grid = 0;
    if (grid == 0) {
        if (n_in != 29 || out_size != M * D || ws_size < WS_END) { fprintf(stderr, "kernel_launch: unexpected shapes (n_in %d out %d ws %zu)\n", n_in, out_size, ws_size); grid = -1; return; }
        int dev = 0, cus = 0;
        if (hipGetDevice(&dev) != hipSuccess || hipDeviceGetAttribute(&cus, hipDeviceAttributeMultiprocessorCount, dev) != hipSuccess) { grid = -1; return; }
        if (hipFuncSetAttribute((const void*)fwd, hipFuncAttributeMaxDynamicSharedMemorySize, LDS_BYTES) != hipSuccess) { fprintf(stderr, "kernel_launch: hipFuncSetAttribute failed\n"); grid = -1; return; }
        int per_cu = 0; (void)hipOccupancyMaxActiveBlocksPerMultiprocessor(&per_cu, (const void*)fwd, NWAVES * 64, LDS_BYTES); (void)hipGetLastError();
        grid = cus;
        if (per_cu < 1) fprintf(stderr, "kernel_launch: occupancy query reports %d\n", per_cu);
    }
    if (grid < 0) return;
    if (hipMemsetAsync((char*)d_ws + WS_CTL, 0, CTL_ZERO_BYTES, stream) != hipSuccess) return;
    Args a{};
    for (int i = 0; i < 29; ++i) a.in[i] = (const float*)d_in[i];
    a.out = (float*)d_out; a.ws = (unsigned char*)d_ws;
#if MK_PER_PHASE
    for (int p = 0; p < N_PHASES; ++p) { a.ph_lo = p; a.ph_hi = p + 1; hipLaunchKernelGGL(fwd, dim3(grid), dim3(NWAVES * 64), LDS_BYTES, stream, a); }
#else
    a.ph_lo = 0; a.ph_hi = N_PHASES; hipLaunchKernelGGL(fwd, dim3(grid), dim3(NWAVES * 64), LDS_BYTES, stream, a);
#endif
}
```

```cpp
#define MK_PER_PHASE 0
#include <hip/hip_runtime.h>
#include <cstdio>
#include <cstdint>
namespace pg8 {
#define PG8_LAS __attribute__((address_space(3)))
typedef unsigned short bf16_t;
typedef short bf16x8 __attribute__((ext_vector_type(8)));
typedef float f32x4 __attribute__((ext_vector_type(4)));
typedef unsigned u32x4 __attribute__((ext_vector_type(4)));
constexpr int BM = 256, BK = 64, HALF = 128, HTB = HALF * BK * 2  , STAGE_BYTES = 8 * HTB, NXCD = 8, WGM = 8;

__host__ __device__ __forceinline__ int lds_byte(int r, int c) { const int st = (r >> 4) * 2 + (c >> 5), rr = r & 15, cc = c & 31, ob = rr * 64 + cc * 2; return st * 1024 + (ob ^ (((ob >> 9) & 1) << 5)); }
__host__ __device__ __forceinline__ void stage_rc(int b, int& R, int& C) { const int st = b / 1024, sb = b % 1024, swz = sb ^ (((sb >> 9) & 1) << 5); R = (st >> 1) * 16 + swz / 64; C = (st & 1) * 32 + (swz % 64) / 2; }
__host__ __device__ __forceinline__ int perm32(int rho) { const int n = rho >> 4, i = rho & 15; return 8 * (i >> 2) + 4 * n + (i & 3); }

struct Unit { int pm, pn; };
struct Gemm { const bf16_t* A; const bf16_t* Bt; int M, N, K; };

struct StaticOrder {
    int nM, nN, nwg, G, c;
    __host__ __device__ void init(int M, int N, int G_, int c_) { nM = M / BM; nN = N / BM; nwg = nM * nN; G = G_; c = c_; }
    __host__ __device__ bool next(int i, Unit& u) const {
        const long L = (long)i * G + c; if (L >= nwg) return false;
        int wgid = (int)L; { const int q = nwg / NXCD, r = nwg % NXCD, xcd = wgid % NXCD, off = wgid / NXCD; wgid = (xcd < r ? xcd * (q + 1) : r * (q + 1) + (xcd - r) * q) + off; }
        const int nig = WGM * nN, gid = wgid / nig, fm = gid * WGM, gsz = (nM - fm) < WGM ? (nM - fm) : WGM;
        u.pm = fm + ((wgid % nig) % gsz); u.pn = (wgid % nig) / gsz; return true;
    }
    __device__ __forceinline__ void a_ready(const Unit&) const {}
    __device__ __forceinline__ void done(const Unit&) const {}
};
__device__ __forceinline__ unsigned cvt_pk_bf16(float lo, float hi) { unsigned r; asm volatile("v_cvt_pk_bf16_f32 %0, %1, %2" : "=v"(r) : "v"(lo), "v"(hi)); return r; }
__device__ __forceinline__ float bf_lo(unsigned w) { return __uint_as_float(w << 16); }
__device__ __forceinline__ float bf_hi(unsigned w) { return __uint_as_float(w & 0xffff0000u); }
__device__ __forceinline__ float sigmoid_f(float x) { return __builtin_amdgcn_rcpf(1.0f + __expf(-x)); }
__device__ __forceinline__ float silu_f(float x) { return x * sigmoid_f(x); }

struct EpiSwiglu {
    static constexpr bool PERM = true, AFTER_DRAIN = false;
    bf16_t* O; int ldc;
    __device__ __forceinline__ void operator()(const f32x4 (&acc)[2][2][4][2], const Unit& u, int wr, int wc, int fr, int fq) const {
        const int row0 = u.pm * BM + wr * 64 + fr, col0 = u.pn * HALF + wc * 32 + 8 * fq;
#pragma unroll
        for (int ai = 0; ai < 2; ++ai)
#pragma unroll
            for (int m = 0; m < 4; ++m) { bf16_t* rowp = O + (size_t)(row0 + ai * HALF + m * 16) * ldc + col0;
                const f32x4 g0 = acc[ai][0][m][0], g1 = acc[ai][0][m][1], u0 = acc[ai][1][m][0], u1 = acc[ai][1][m][1];
                f32x4 v0, v1;
#pragma unroll
                for (int j = 0; j < 4; ++j) { v0[j] = silu_f(g0[j]) * u0[j]; v1[j] = silu_f(g1[j]) * u1[j]; }
                u32x4 w; w.x = cvt_pk_bf16(v0[0], v0[1]); w.y = cvt_pk_bf16(v0[2], v0[3]); w.z = cvt_pk_bf16(v1[0], v1[1]); w.w = cvt_pk_bf16(v1[2], v1[3]);
                *(u32x4*)rowp = w; }
    }
};
struct EpiResid {
    static constexpr bool PERM = false, AFTER_DRAIN = false;
    float* X; int ldc; float scale;
    __device__ __forceinline__ void operator()(const f32x4 (&acc)[2][2][4][2], const Unit& u, int wr, int wc, int fr, int fq) const {
        const int row0 = u.pm * BM + wr * 64 + fr, col0 = u.pn * BM + wc * 32 + 4 * fq;
#pragma unroll
        for (int ai = 0; ai < 2; ++ai)
#pragma unroll
            for (int m = 0; m < 4; ++m) { float* rowp = X + (size_t)(row0 + ai * HALF + m * 16) * ldc + col0;
#pragma unroll
                for (int bj = 0; bj < 2; ++bj)
#pragma unroll
                    for (int n = 0; n < 2; ++n) { f32x4* p = (f32x4*)(rowp + bj * HALF + n * 16); const f32x4 o = *p; *p = o + acc[ai][bj][m][n] * scale; }
                asm volatile("" ::: "memory"); }
    }
};
struct EpiCols {
    static constexpr bool PERM = true, AFTER_DRAIN = false;
    bf16_t *cA, *cB, *cC, *cG;
    __device__ __forceinline__ void operator()(const f32x4 (&acc)[2][2][4][2], const Unit& u, int wr, int wc, int fr, int fq) const {
        bf16_t* base; int ldc, colt;
        if (u.pn < 18) { base = cA; ldc = 4608; colt = u.pn * BM; }
        else if (u.pn < 34) { base = cB; ldc = 4096; colt = (u.pn - 18) * BM; }
        else if (u.pn < 48) { base = cC; ldc = 3584; colt = (u.pn - 34) * BM; }
        else { base = cG; ldc = 6144; colt = (u.pn - 48) * BM; }
        const int row0 = u.pm * BM + wr * 64 + fr, col0 = colt + wc * 32 + 8 * fq;
#pragma unroll
        for (int ai = 0; ai < 2; ++ai)
#pragma unroll
            for (int m = 0; m < 4; ++m) { bf16_t* rowp = base + (size_t)(row0 + ai * HALF + m * 16) * ldc + col0;
#pragma unroll
                for (int bj = 0; bj < 2; ++bj) { const f32x4 v0 = acc[ai][bj][m][0], v1 = acc[ai][bj][m][1];
                    u32x4 w; w.x = cvt_pk_bf16(v0[0], v0[1]); w.y = cvt_pk_bf16(v0[2], v0[3]); w.z = cvt_pk_bf16(v1[0], v1[1]); w.w = cvt_pk_bf16(v1[2], v1[3]);
                    *(u32x4*)(rowp + bj * HALF) = w; } }
    }
};
template <int MODE> struct EpiGate {
    static constexpr bool PERM = true, AFTER_DRAIN = false;
    const bf16_t* G; float* T; bf16_t* O;
    __device__ __forceinline__ void operator()(const f32x4 (&acc)[2][2][4][2], const Unit& u, int wr, int wc, int fr, int fq) const {
        const int row0 = u.pm * BM + wr * 64 + fr, col0 = u.pn * BM + wc * 32 + 8 * fq;
#pragma unroll
        for (int ai = 0; ai < 2; ++ai)
#pragma unroll
            for (int m = 0; m < 4; ++m) { const size_t r = (size_t)(row0 + ai * HALF + m * 16);
#pragma unroll
                for (int bj = 0; bj < 2; ++bj) { const int c = col0 + bj * HALF;
                    const u32x4 gw = *(const u32x4*)(G + r * 6144 + c);
                    f32x4 a0 = acc[ai][bj][m][0], a1 = acc[ai][bj][m][1];
                    a0[0] *= sigmoid_f(bf_lo(gw.x)); a0[1] *= sigmoid_f(bf_hi(gw.x)); a0[2] *= sigmoid_f(bf_lo(gw.y)); a0[3] *= sigmoid_f(bf_hi(gw.y));
                    a1[0] *= sigmoid_f(bf_lo(gw.z)); a1[1] *= sigmoid_f(bf_hi(gw.z)); a1[2] *= sigmoid_f(bf_lo(gw.w)); a1[3] *= sigmoid_f(bf_hi(gw.w));
                    f32x4* tp = (f32x4*)(T + r * 2048 + c);
                    if (MODE == 0) { tp[0] = a0; tp[1] = a1; }
                    else if (MODE == 1) { tp[0] = tp[0] + a0; tp[1] = tp[1] + a1; }
                    else { a0 = a0 + tp[0]; a1 = a1 + tp[1];
                        u32x4 w; w.x = cvt_pk_bf16(a0[0], a0[1]); w.y = cvt_pk_bf16(a0[2], a0[3]); w.z = cvt_pk_bf16(a1[0], a1[1]); w.w = cvt_pk_bf16(a1[2], a1[3]);
                        *(u32x4*)(O + r * 2048 + c) = w; }
                    asm volatile("" ::: "memory"); } }
    }
};

template <class Epi, class Sched, bool ALIGN_EPI = false, bool SP2 = false>
__device__ __forceinline__ void gemm_phase(PG8_LAS unsigned char* lds, const Gemm g, const Sched& S, const Epi& E) {
    int tid_raw = threadIdx.x; asm volatile("" : "+v"(tid_raw));
    const int tid = tid_raw, wid = __builtin_amdgcn_readfirstlane(tid >> 6), lane = tid & 63, wr = wid >> 2, wc = wid & 3, fr = lane & 15, fq = lane >> 4;
    const int K = g.K, nt = K / BK;
    unsigned voffA[2], voffB[2];
#pragma unroll
    for (int i = 0; i < 2; ++i) { int R, C; stage_rc(tid * 16 + i * 8192, R, C); const int Rb = Epi::PERM ? ((R & ~31) + perm32(R & 31)) : R;
        voffA[i] = (unsigned)(R * K + C) * 2u; voffB[i] = (unsigned)(Rb * K + C) * 2u; }
    const size_t kstep = (size_t)(BK * 2);
    const size_t hstep = (size_t)HALF * K * 2;
    const size_t tstep = 2 * hstep;
    const unsigned ldsw = (unsigned)wid * 1024u;
    const int aoff = lds_byte(wr * 64 + fr, fq * 8), boff = lds_byte(wc * 32 + fr, fq * 8);
#define PG8_SA(b, h) (((b) * 2 + (h)) * HTB)
#define PG8_SB(b, h) ((4 + (b) * 2 + (h)) * HTB)
#define PG8_STAGE(bufoff, gbase, voff) do { _Pragma("unroll") for (int _i = 0; _i < 2; ++_i) \
        __builtin_amdgcn_global_load_lds((const unsigned*)((const char*)(gbase) + (voff)[_i]), (PG8_LAS unsigned*)(lds + (bufoff) + ldsw + _i * 8192), 16, 0, 0); } while (0)
#define PG8_LDA(dst, b, h) do { _Pragma("unroll") for (int m = 0; m < 4; ++m) _Pragma("unroll") for (int k = 0; k < 2; ++k) dst[m][k] = *(const PG8_LAS bf16x8*)(lds + PG8_SA(b, h) + aoff + m * 2048 + k * 1024); } while (0)
#define PG8_LDB(dst, b, h) do { _Pragma("unroll") for (int n = 0; n < 2; ++n) _Pragma("unroll") for (int k = 0; k < 2; ++k) dst[n][k] = *(const PG8_LAS bf16x8*)(lds + PG8_SB(b, h) + boff + n * 2048 + k * 1024); } while (0)
#define PG8_MMA(ai, bj, At, Bt) do { __builtin_amdgcn_s_setprio(1); _Pragma("unroll") for (int m = 0; m < 4; ++m) _Pragma("unroll") for (int n = 0; n < 2; ++n) _Pragma("unroll") for (int k = 0; k < 2; ++k) \
        acc[ai][bj][m][n] = __builtin_amdgcn_mfma_f32_16x16x32_bf16(Bt[n][k], At[m][k], acc[ai][bj][m][n], 0, 0, 0); __builtin_amdgcn_s_setprio(0); } while (0)
#define PG8_WAIT_V(n) asm volatile("s_waitcnt vmcnt(" #n ")" ::: "memory")
#define PG8_WAIT_L(n) asm volatile("s_waitcnt lgkmcnt(" #n ")" ::: "memory")
#define PG8_BAR __builtin_amdgcn_s_barrier()
#define PG8_SCHED __builtin_amdgcn_sched_barrier(0)
    Unit cur, nxt; int ui = 0;
    if (!S.next(0, cur)) return;
    f32x4 acc[2][2][4][2];
#pragma unroll
    for (int a = 0; a < 2; ++a)
#pragma unroll
        for (int b = 0; b < 2; ++b)
#pragma unroll
            for (int m = 0; m < 4; ++m)
#pragma unroll
                for (int n = 0; n < 2; ++n) acc[a][b][m][n] = (f32x4){0.f, 0.f, 0.f, 0.f};
    bf16x8 At[4][2], B0[2][2], B1[2][2];
    const char* cA = (const char*)g.A + (size_t)cur.pm * tstep; const char* cB = (const char*)g.Bt + (size_t)cur.pn * tstep;
    S.a_ready(cur);
    if constexpr (SP2) {
        PG8_STAGE(PG8_SB(0, 0), cB, voffB); PG8_STAGE(PG8_SB(0, 1), cB + hstep, voffB); PG8_STAGE(PG8_SA(0, 0), cA, voffA); PG8_STAGE(PG8_SA(0, 1), cA + hstep, voffA);
        if (wr == 1) PG8_BAR;
        PG8_WAIT_V(2); PG8_BAR;
        PG8_STAGE(PG8_SB(1, 0), cB + kstep, voffB); PG8_STAGE(PG8_SA(1, 0), cA + kstep, voffA); PG8_STAGE(PG8_SB(1, 1), cB + hstep + kstep, voffB);
        PG8_WAIT_V(6); PG8_BAR;
    } else {
        PG8_STAGE(PG8_SB(0, 0), cB, voffB); PG8_STAGE(PG8_SA(0, 0), cA, voffA); PG8_STAGE(PG8_SB(0, 1), cB + hstep, voffB); PG8_STAGE(PG8_SA(0, 1), cA + hstep, voffA);
        if (wr == 1) PG8_BAR;
        PG8_WAIT_V(4); PG8_BAR;
        PG8_STAGE(PG8_SB(1, 0), cB + kstep, voffB); PG8_STAGE(PG8_SA(1, 0), cA + kstep, voffA); PG8_STAGE(PG8_SB(1, 1), cB + hstep + kstep, voffB);
        PG8_WAIT_V(6); PG8_BAR;
    }
    for (;;) {
        const bool has_next = S.next(ui + 1, nxt);
        const char* nA = has_next ? (const char*)g.A + (size_t)nxt.pm * tstep : cA; const char* nB = has_next ? (const char*)g.Bt + (size_t)nxt.pn * tstep : cB;
        for (int t = 0; t < nt; t += 2) {
            const bool last = (t == nt - 2);
            const char* a1 = cA + (size_t)(t + 1) * kstep;
            const char* a2 = last ? nA : cA + (size_t)(t + 2) * kstep; const char* b2 = last ? nB : cB + (size_t)(t + 2) * kstep;
            const char* a3 = a2 + kstep; const char* b3 = b2 + kstep;
            if (last && has_next) S.a_ready(nxt);
            if constexpr (SP2) {
            PG8_LDB(B0, 0, 0); PG8_LDB(B1, 0, 1); PG8_SCHED; PG8_LDA(At, 0, 0); PG8_STAGE(PG8_SA(1, 1), a1 + hstep, voffA);
            PG8_WAIT_V(8); PG8_WAIT_L(0); PG8_BAR; PG8_MMA(0, 0, At, B0); PG8_MMA(0, 1, At, B1); PG8_BAR; PG8_SCHED;
            PG8_LDA(At, 0, 1); PG8_STAGE(PG8_SB(0, 0), b2, voffB); PG8_STAGE(PG8_SB(0, 1), b2 + hstep, voffB); PG8_STAGE(PG8_SA(0, 0), a2, voffA);
            PG8_WAIT_V(8); PG8_WAIT_L(0); PG8_BAR; PG8_MMA(1, 0, At, B0); PG8_MMA(1, 1, At, B1); PG8_BAR; PG8_SCHED;
            PG8_LDB(B0, 1, 0); PG8_LDB(B1, 1, 1); PG8_SCHED; PG8_LDA(At, 1, 0); PG8_STAGE(PG8_SA(0, 1), a2 + hstep, voffA);
            PG8_WAIT_V(8); PG8_WAIT_L(0); PG8_BAR; PG8_MMA(0, 0, At, B0); PG8_MMA(0, 1, At, B1); PG8_BAR; PG8_SCHED;
            PG8_LDA(At, 1, 1); PG8_STAGE(PG8_SB(1, 0), b3, voffB); PG8_STAGE(PG8_SB(1, 1), b3 + hstep, voffB); PG8_STAGE(PG8_SA(1, 0), a3, voffA);
            PG8_WAIT_V(8); PG8_WAIT_L(0); PG8_BAR; PG8_MMA(1, 0, At, B0); PG8_MMA(1, 1, At, B1); PG8_BAR; PG8_SCHED;
            } else {
            PG8_LDB(B0, 0, 0); PG8_SCHED; PG8_LDA(At, 0, 0); PG8_STAGE(PG8_SA(1, 1), a1 + hstep, voffA);
            PG8_WAIT_L(8); PG8_BAR; PG8_WAIT_L(0); PG8_MMA(0, 0, At, B0); PG8_BAR; PG8_SCHED;
            PG8_LDB(B1, 0, 1); PG8_STAGE(PG8_SB(0, 0), b2, voffB);
            PG8_BAR; PG8_WAIT_L(0); PG8_MMA(0, 1, At, B1); PG8_BAR;
            PG8_LDA(At, 0, 1); PG8_STAGE(PG8_SA(0, 0), a2, voffA);
            PG8_BAR; PG8_WAIT_L(0); PG8_MMA(1, 0, At, B0); PG8_BAR; PG8_SCHED;
            PG8_STAGE(PG8_SB(0, 1), b2 + hstep, voffB);
            PG8_WAIT_V(6); PG8_BAR; PG8_MMA(1, 1, At, B1); PG8_BAR;
            PG8_LDB(B0, 1, 0); PG8_SCHED; PG8_LDA(At, 1, 0); PG8_STAGE(PG8_SA(0, 1), a2 + hstep, voffA);
            PG8_WAIT_L(8); PG8_BAR; PG8_WAIT_L(0); PG8_MMA(0, 0, At, B0); PG8_BAR; PG8_SCHED;
            PG8_LDB(B1, 1, 1); PG8_STAGE(PG8_SB(1, 0), b3, voffB);
            PG8_BAR; PG8_WAIT_L(0); PG8_MMA(0, 1, At, B1); PG8_BAR;
            PG8_LDA(At, 1, 1); PG8_STAGE(PG8_SA(1, 0), a3, voffA);
            PG8_BAR; PG8_WAIT_L(0); PG8_MMA(1, 0, At, B0); PG8_BAR; PG8_SCHED;
            PG8_STAGE(PG8_SB(1, 1), b3 + hstep, voffB);
            PG8_WAIT_V(6); PG8_BAR; PG8_MMA(1, 1, At, B1); PG8_BAR;
            }
        }
        if constexpr (ALIGN_EPI) { if (wr == 0) PG8_BAR; }
        if constexpr (!Epi::AFTER_DRAIN) { E(acc, cur, wr, wc, fr, fq); S.done(cur); }
        if (!has_next) break;
#pragma unroll
        for (int a = 0; a < 2; ++a)
#pragma unroll
            for (int b = 0; b < 2; ++b)
#pragma unroll
                for (int m = 0; m < 4; ++m)
#pragma unroll
                    for (int n = 0; n < 2; ++n) acc[a][b][m][n] = (f32x4){0.f, 0.f, 0.f, 0.f};
        cur = nxt; cA = nA; cB = nB; ++ui;
        if constexpr (ALIGN_EPI) { if (wr == 1) PG8_BAR; }
    }
    PG8_WAIT_V(0);
    if constexpr (!ALIGN_EPI) { if (wr == 0) PG8_BAR; }
    PG8_BAR;
    if constexpr (Epi::AFTER_DRAIN) { E.fused(acc, cur, wr, wc, fr, fq, lds, wid, lane); S.done(cur); }
#undef PG8_SA
#undef PG8_SB
#undef PG8_STAGE
#undef PG8_LDA
#undef PG8_LDB
#undef PG8_MMA
#undef PG8_WAIT_V
#undef PG8_WAIT_L
#undef PG8_BAR
#undef PG8_SCHED
}
}

constexpr int NWAVES = 8;
constexpr int M = 16384, D = 2048, FF = 5632, SEQ = 2048, DEPTH = 4;
constexpr int NIN_PAD = 18432;
constexpr float NORM_EPS = 1e-6f;
#ifndef MK_PER_PHASE
#define MK_PER_PHASE 0
#endif
constexpr int PH_PER_LAYER = 13, N_PHASES = DEPTH * PH_PER_LAYER + 1;

constexpr size_t MiB = 1u << 20;
constexpr size_t WS_CTL = 0, CTL_ZERO_BYTES = 1 * MiB;
constexpr size_t WS_WB = 1 * MiB;
constexpr size_t W_GU1 = 0, W_D1 = 23068672, W_IN = 34603008, W_PA = 72351744, W_PB = 73400320, W_PC = 75497472, W_WO = 77594624, W_GU2 = 81788928, W_D2 = 104857600;
constexpr size_t WS_H = 223 * MiB;
constexpr size_t WS_CA = 287 * MiB, WS_CB = 431 * MiB, WS_CC = 559 * MiB, WS_CG = 671 * MiB;
constexpr size_t WS_ACT = WS_CA;
constexpr size_t WS_GQ = 863 * MiB, WS_GK = 927 * MiB, WS_GV = 991 * MiB, WS_GO = 1055 * MiB, WS_GLD = 1119 * MiB, WS_GBT = 1119 * MiB + 512 * 1024;
constexpr size_t WS_MT = WS_GQ;
constexpr size_t WS_RR = 1120 * MiB, WS_RK = 1184 * MiB, WS_RV = 1248 * MiB, WS_RD = 1312 * MiB, WS_RKK = 1376 * MiB, WS_RKA = 1440 * MiB, WS_RG = 1504 * MiB;
constexpr size_t WS_YA = 1568 * MiB, WS_YB = 1584 * MiB, WS_YC = 1616 * MiB;
constexpr size_t WS_MB = 1648 * MiB;
constexpr size_t WS_END = 1712 * MiB;
constexpr int CW_BAR = 4096, CW_ATT = 16384;

constexpr int RING_OFF = 0, RING_BYTES = 131072;
constexpr int LDSCTL_OFF = RING_BYTES, MISC_OFF = LDSCTL_OFF + 320;
constexpr int LDS_BYTES = 147456;

#define GAS __attribute__((address_space(1)))
#define LAS __attribute__((address_space(3)))
typedef unsigned short bf16;
typedef unsigned v4u __attribute__((ext_vector_type(4)));
typedef unsigned v2u __attribute__((ext_vector_type(2)));
typedef float f32x4 __attribute__((ext_vector_type(4)));
typedef float f32x2 __attribute__((ext_vector_type(2)));
#define LDS_WAIT() asm volatile("s_waitcnt lgkmcnt(0)" ::: "memory")
#define WAVE_SYNC() do { asm volatile("s_waitcnt lgkmcnt(0)" ::: "memory"); __builtin_amdgcn_wave_barrier(); asm volatile("" ::: "memory"); } while (0)
using pg8::cvt_pk_bf16; using pg8::bf_lo; using pg8::bf_hi; using pg8::sigmoid_f; using pg8::silu_f;

__device__ __forceinline__ float wave_sum(float v) {
#pragma unroll
    for (int o = 1; o < 64; o <<= 1) v += __shfl_xor(v, o);
    return v;
}
__device__ __forceinline__ float wave_max(float v) {
#pragma unroll
    for (int o = 1; o < 64; o <<= 1) v = fmaxf(v, __shfl_xor(v, o));
    return v;
}
__device__ __forceinline__ float softplus_f(float x) { return x > 20.f ? x : log1pf(__expf(x)); }

struct MapId { __device__ __forceinline__ int operator()(int n) const { return n; } };
struct MapGu { __device__ __forceinline__ int operator()(int n) const { return (n >> 8) * 128 + (n & 127) + ((n >> 7) & 1) * FF; } };
struct MapIn { __device__ __forceinline__ int operator()(int n) const {
    if (n < 8704) return n;
    if (n < 12224) return n + 16;
    if (n < 12240) return 8704 + (n - 12224);
    if (n < 12288) return -1;
    return n - 48; } };
template <class Map>
__device__ __forceinline__ void conv_matrix(const float* W, int K, int N, bf16* WT, int NP, Map map, LAS float* scr, int& rot, int gw, int NGW, int lane) {
    const int nblk = NP / 32, nitems = (K / 64) * nblk;
    int start = gw - rot; if (start < 0) start += NGW;
    for (int it = start; it < nitems; it += NGW) {
        const int kb = it / nblk, nb = it % nblk, k0 = 64 * kb, n0 = 32 * nb;
        const int sc = map(n0 + (lane & 31));
#pragma unroll 8
        for (int i = 0; i < 32; ++i) { const int kk = 2 * i + (lane >> 5); scr[kk * 33 + (lane & 31)] = sc >= 0 ? W[(size_t)(k0 + kk) * N + sc] : 0.f; }
        LDS_WAIT(); asm volatile("" ::: "memory");
        const int c = lane & 7;
#pragma unroll
        for (int j = 0; j < 4; ++j) { const int n = (lane >> 3) + 8 * j; const LAS float* s = scr + (8 * c) * 33 + n;
            v4u o; o.x = cvt_pk_bf16(s[0 * 33], s[1 * 33]); o.y = cvt_pk_bf16(s[2 * 33], s[3 * 33]); o.z = cvt_pk_bf16(s[4 * 33], s[5 * 33]); o.w = cvt_pk_bf16(s[6 * 33], s[7 * 33]);
            *(v4u*)(WT + (size_t)(n0 + n) * K + k0 + 8 * c) = o; }
        LDS_WAIT(); asm volatile("" ::: "memory");
    }
    rot = (rot + nitems) % NGW;
}

__device__ __forceinline__ void norm_rows(const float* xs, float* xcopy, const float* gain, bf16* hout, int gw, int NGW, int lane) {
    f32x4 g[8];
#pragma unroll
    for (int j = 0; j < 8; ++j) g[j] = ((const f32x4*)gain)[lane + 64 * j];
    for (int m = gw; m < M; m += NGW) {
        const f32x4* xr = (const f32x4*)(xs + (size_t)m * D) + lane;
        f32x4 v[8]; float s = 0.f;
#pragma unroll
        for (int j = 0; j < 8; ++j) { v[j] = xr[64 * j]; s += (v[j].x * v[j].x + v[j].y * v[j].y) + (v[j].z * v[j].z + v[j].w * v[j].w); }
        s = wave_sum(s); const float rs = 1.0f / sqrtf(s * (1.0f / D) + NORM_EPS);
        if (xcopy) {
#pragma unroll
            for (int j = 0; j < 8; ++j) ((f32x4*)(xcopy + (size_t)m * D))[lane + 64 * j] = v[j]; }
        v2u* o8 = (v2u*)(hout + (size_t)m * D) + lane;
#pragma unroll
        for (int j = 0; j < 8; ++j) { v2u o; o.x = cvt_pk_bf16(v[j].x * rs * g[j].x, v[j].y * rs * g[j].y); o.y = cvt_pk_bf16(v[j].z * rs * g[j].z, v[j].w * rs * g[j].w); o8[64 * j] = o; }
    }
}
__device__ __forceinline__ void final_norm_rows(float* x, const float* gain, int gw, int NGW, int lane) {
    f32x4 g[8];
#pragma unroll
    for (int j = 0; j < 8; ++j) g[j] = ((const f32x4*)gain)[lane + 64 * j];
    for (int m = gw; m < M; m += NGW) {
        f32x4* xr = (f32x4*)(x + (size_t)m * D) + lane;
        f32x4 v[8]; float s = 0.f;
#pragma unroll
        for (int j = 0; j < 8; ++j) { v[j] = xr[64 * j]; s += (v[j].x * v[j].x + v[j].y * v[j].y) + (v[j].z * v[j].z + v[j].w * v[j].w); }
        s = wave_sum(s); const float rs = 1.0f / sqrtf(s * (1.0f / D) + NORM_EPS);
#pragma unroll
        for (int j = 0; j < 8; ++j) xr[64 * j] = v[j] * rs * g[j];
    }
}

__device__ __forceinline__ void gdn_prep(const bf16* cB, const bf16* cC, const float* convw, const float* a_log, const float* dt_bias,
                                         float* GQ, float* GK, float* GV, float* GLD, float* GBT, int gw, int NGW, int lane) {
    for (int it = gw; it < M * 8; it += NGW) {
        const int m = it >> 3, h = it & 7, t = m & (SEQ - 1);
        float acc[3][2] = {{0.f, 0.f}, {0.f, 0.f}, {0.f, 0.f}};
#pragma unroll
        for (int j = 0; j < 4; ++j) { const int tt = t - 3 + j;
            if (tt >= 0) { const bf16* row = cB + (size_t)(m - 3 + j) * 4096 + h * 128 + 2 * lane; const float* wr = convw + j * 3072 + h * 128 + 2 * lane;
#pragma unroll
                for (int s = 0; s < 3; ++s) { const unsigned w = *(const unsigned*)(row + s * 1024); const f32x2 cw = *(const f32x2*)(wr + s * 1024);
                    acc[s][0] += bf_lo(w) * cw.x; acc[s][1] += bf_hi(w) * cw.y; } } }
#pragma unroll
        for (int s = 0; s < 3; ++s) { acc[s][0] = silu_f(acc[s][0]); acc[s][1] = silu_f(acc[s][1]); }
        const float sq = wave_sum(acc[0][0] * acc[0][0] + acc[0][1] * acc[0][1]), sk = wave_sum(acc[1][0] * acc[1][0] + acc[1][1] * acc[1][1]);
        const float rq = (1.0f / sqrtf(sq + 1e-6f)) * 0.08838834764831845f, rk = 1.0f / sqrtf(sk + 1e-6f);
        const size_t o = (size_t)m * 1024 + h * 128 + 2 * lane;
        *(f32x2*)(GQ + o) = (f32x2){acc[0][0] * rq, acc[0][1] * rq};
        *(f32x2*)(GK + o) = (f32x2){acc[1][0] * rk, acc[1][1] * rk};
        *(f32x2*)(GV + o) = (f32x2){acc[2][0], acc[2][1]};
        if (lane == 0) { const float alpha = bf_lo((unsigned)cC[(size_t)m * 3584 + 3520 + h]), bl = bf_lo((unsigned)cC[(size_t)m * 3584 + 3528 + h]);
            GLD[m * 8 + h] = -__expf(a_log[h]) * softplus_f(alpha + dt_bias[h]); GBT[m * 8 + h] = sigmoid_f(bl); }
    }
}
__device__ __forceinline__ void gdn_scan_seq(const float* GQ, const float* GK, const float* GV, const float* GLD, const float* GBT, float* GO, int item, int lane, LAS float* wl) {
    const int b = item >> 5, h = (item >> 2) & 7, col = (item & 3) * 32 + (lane >> 1), kh = lane & 1;
    const size_t base = (size_t)(b * SEQ) * 1024 + h * 128; const int gb = (b * SEQ) * 8 + h;
    const int wpos = 2 * lane + (lane >= 32 ? 4 : 0);
    const LAS float* kl = wl + kh * 68; const LAS float* ql = wl + 136 + kh * 68;
    float S[64];
#pragma unroll
    for (int j = 0; j < 64; ++j) S[j] = 0.f;
    f32x2 kn = *(const f32x2*)(GK + base + 2 * lane), qn = *(const f32x2*)(GQ + base + 2 * lane); float vn = GV[base + col], ldn = GLD[gb], btn = GBT[gb];
    for (int t = 0; t < SEQ; ++t) {
        const f32x2 kc = kn, qc = qn; const float vc = vn, al = __expf(ldn), be = btn;
        if (t + 1 < SEQ) { const size_t o = base + (size_t)(t + 1) * 1024; kn = *(const f32x2*)(GK + o + 2 * lane); qn = *(const f32x2*)(GQ + o + 2 * lane); vn = GV[o + col]; ldn = GLD[gb + (t + 1) * 8]; btn = GBT[gb + (t + 1) * 8]; }
        *(LAS f32x2*)(wl + wpos) = kc; *(LAS f32x2*)(wl + 136 + wpos) = qc;
        WAVE_SYNC();
        float s0 = 0.f, s1 = 0.f, s2 = 0.f, s3 = 0.f;
#pragma unroll
        for (int j = 0; j < 64; j += 4) { const f32x4 k4 = *(const LAS f32x4*)(kl + j); s0 += S[j] * k4.x; s1 += S[j + 1] * k4.y; s2 += S[j + 2] * k4.z; s3 += S[j + 3] * k4.w; }
        float sk = (s0 + s1) + (s2 + s3); sk += __shfl_xor(sk, 1);
        const float vnew = be * (vc - al * sk);
        float o0 = 0.f, o1 = 0.f, o2 = 0.f, o3 = 0.f;
#pragma unroll
        for (int j = 0; j < 64; j += 4) { const f32x4 k4 = *(const LAS f32x4*)(kl + j), q4 = *(const LAS f32x4*)(ql + j);
            S[j] = al * S[j] + k4.x * vnew; S[j + 1] = al * S[j + 1] + k4.y * vnew; S[j + 2] = al * S[j + 2] + k4.z * vnew; S[j + 3] = al * S[j + 3] + k4.w * vnew;
            o0 += S[j] * q4.x; o1 += S[j + 1] * q4.y; o2 += S[j + 2] * q4.z; o3 += S[j + 3] * q4.w; }
        float o = (o0 + o1) + (o2 + o3); o += __shfl_xor(o, 1);
        if (kh == 0) GO[base + (size_t)t * 1024 + col] = o;
        WAVE_SYNC();
    }
}
__device__ __forceinline__ void gdn_post(const float* GO, const bf16* cB, const float* norm_w, bf16* YB, int gw, int NGW, int lane) {
    const f32x2 nw = *(const f32x2*)(norm_w + 2 * lane);
    for (int it = gw; it < M * 8; it += NGW) {
        const int m = it >> 3, h = it & 7; const size_t o = (size_t)m * 1024 + h * 128 + 2 * lane;
        const f32x2 v = *(const f32x2*)(GO + o); const unsigned zw = *(const unsigned*)(cB + (size_t)m * 4096 + 3072 + h * 128 + 2 * lane);
        const float ss = wave_sum(v.x * v.x + v.y * v.y), rs = 1.0f / sqrtf(ss * (1.0f / 128.0f) + NORM_EPS);
        *(unsigned*)(YB + o) = cvt_pk_bf16(v.x * rs * nw.x * silu_f(bf_lo(zw)), v.y * rs * nw.y * silu_f(bf_hi(zw)));
    }
}

__device__ __forceinline__ void rwkv_prep_tile(const bf16* cC, const float* mu, const float* w0, const float* w2, const float* a0, const float* a2, const float* g2, const float* k_k, const float* k_a,
                                               float* RR, float* RK, float* RV, float* RD, float* RKK, float* RKA, float* RG, int tile, int tid, LAS float* actl) {
    const int m0 = tile * 16, t0 = m0 & (SEQ - 1);
    for (int idx = tid; idx < 16 * 448; idx += 512) { const int tok = idx / 448, ci = idx % 448, cc = 3072 + ci, m = m0 + tok;
        const float x = bf_lo((unsigned)cC[(size_t)m * 3584 + cc]), xp = (t0 + tok > 0) ? bf_lo((unsigned)cC[(size_t)(m - 1) * 3584 + cc]) : 0.f;
        const float xs = x + (xp - x) * mu[cc];
        actl[ci * 16 + tok] = ci < 96 ? tanhf(xs) : (ci < 192 ? xs : sigmoid_f(xs)); }
    __syncthreads();
    float aw[2][16], aa[2][16], ag[2][16];
#pragma unroll
    for (int ch = 0; ch < 2; ++ch)
#pragma unroll
        for (int k = 0; k < 16; ++k) { aw[ch][k] = 0.f; aa[ch][k] = 0.f; ag[ch][k] = 0.f; }
    for (int i = 0; i < 96; ++i) {
        const float w20 = w2[i * 1024 + tid], w21 = w2[i * 1024 + tid + 512], a20 = a2[i * 1024 + tid], a21 = a2[i * 1024 + tid + 512];
        float xw[16], xa[16];
#pragma unroll
        for (int q = 0; q < 4; ++q) { const f32x4 u = *(const LAS f32x4*)(actl + i * 16 + 4 * q), v = *(const LAS f32x4*)(actl + (96 + i) * 16 + 4 * q);
            xw[4 * q] = u.x; xw[4 * q + 1] = u.y; xw[4 * q + 2] = u.z; xw[4 * q + 3] = u.w; xa[4 * q] = v.x; xa[4 * q + 1] = v.y; xa[4 * q + 2] = v.z; xa[4 * q + 3] = v.w; }
#pragma unroll
        for (int k = 0; k < 16; ++k) { aw[0][k] += xw[k] * w20; aw[1][k] += xw[k] * w21; aa[0][k] += xa[k] * a20; aa[1][k] += xa[k] * a21; }
    }
    for (int i = 0; i < 256; ++i) {
        const float g20 = g2[i * 1024 + tid], g21 = g2[i * 1024 + tid + 512];
        float xg[16];
#pragma unroll
        for (int q = 0; q < 4; ++q) { const f32x4 u = *(const LAS f32x4*)(actl + (192 + i) * 16 + 4 * q); xg[4 * q] = u.x; xg[4 * q + 1] = u.y; xg[4 * q + 2] = u.z; xg[4 * q + 3] = u.w; }
#pragma unroll
        for (int k = 0; k < 16; ++k) { ag[0][k] += xg[k] * g20; ag[1][k] += xg[k] * g21; }
    }
#pragma unroll
    for (int ch = 0; ch < 2; ++ch) {
        const int c = tid + 512 * ch;
        const float mur = mu[c], muk = mu[1024 + c], muv = mu[2048 + c], w0c = w0[c], a0c = a0[c], kkc = k_k[c], kac = k_a[c];
        float pr = 0.f, pk = 0.f, pv = 0.f;
        if (t0 > 0) { const bf16* rp = cC + (size_t)(m0 - 1) * 3584; pr = bf_lo((unsigned)rp[c]); pk = bf_lo((unsigned)rp[1024 + c]); pv = bf_lo((unsigned)rp[2048 + c]); }
#pragma unroll
        for (int k = 0; k < 16; ++k) {
            const int m = m0 + k; const bf16* rc = cC + (size_t)m * 3584;
            const float xr = bf_lo((unsigned)rc[c]), xk = bf_lo((unsigned)rc[1024 + c]), xv = bf_lo((unsigned)rc[2048 + c]);
            const float r = xr + (pr - xr) * mur, kx = xk + (pk - xk) * muk, v = xv + (pv - xv) * muv;
            pr = xr; pk = xk; pv = xv;
            const float wl_ = w0c + aw[ch][k], w = -softplus_f(-wl_) - 0.5f, dec = __expf(-__expf(w));
            const float a = sigmoid_f(a0c + aa[ch][k]);
            const float kkr = kx * kkc, ss = wave_sum(kkr * kkr), kk = kkr * (1.0f / sqrtf(ss + 1e-6f));
            const float k2 = kx * (1.0f + (a - 1.0f) * kac);
            const size_t o = (size_t)m * 1024 + c;
            RR[o] = r; RK[o] = k2; RV[o] = v; RD[o] = dec; RKK[o] = kk; RKA[o] = kk * a; RG[o] = ag[ch][k];
        }
    }
    __syncthreads();
}
__device__ __forceinline__ void rwkv_scan_seq(const float* RR, const float* RK, const float* RV, const float* RD, const float* RKK, const float* RKA, const float* RG,
                                              const float* r_k, const float* gn_w, const float* gn_b, bf16* YC, int item, int lane, LAS float* wl) {
    const int b = item >> 4, h = item & 15;
    const size_t base = (size_t)(b * SEQ) * 1024 + h * 64 + lane;
    const float rkc = r_k[h * 64 + lane], gwc = gn_w[h * 64 + lane], gbc = gn_b[h * 64 + lane];
    float S[64];
#pragma unroll
    for (int j = 0; j < 64; ++j) S[j] = 0.f;
    float rn = RR[base], kn = RK[base], vn = RV[base], dn = RD[base], kkn = RKK[base], kan = RKA[base], gn = RG[base];
    for (int t = 0; t < SEQ; ++t) {
        const float rc = rn, kc = kn, vc = vn, dc = dn, kkc = kkn, kac = kan, gc = gn;
        if (t + 1 < SEQ) { const size_t o = base + (size_t)(t + 1) * 1024; rn = RR[o]; kn = RK[o]; vn = RV[o]; dn = RD[o]; kkn = RKK[o]; kan = RKA[o]; gn = RG[o]; }
        wl[lane] = rc; wl[64 + lane] = kc; wl[128 + lane] = dc; wl[192 + lane] = kkc; wl[256 + lane] = kac;
        WAVE_SYNC();
        float s0 = 0.f, s1 = 0.f, s2 = 0.f, s3 = 0.f;
#pragma unroll
        for (int j = 0; j < 64; j += 4) { const f32x4 k4 = *(const LAS f32x4*)(wl + 192 + j); s0 += S[j] * k4.x; s1 += S[j + 1] * k4.y; s2 += S[j + 2] * k4.z; s3 += S[j + 3] * k4.w; }
        const float sa = -((s0 + s1) + (s2 + s3));
        float o0 = 0.f, o1 = 0.f, o2 = 0.f, o3 = 0.f;
#pragma unroll
        for (int j = 0; j < 64; j += 4) { const f32x4 r4 = *(const LAS f32x4*)(wl + j), k4 = *(const LAS f32x4*)(wl + 64 + j), d4 = *(const LAS f32x4*)(wl + 128 + j), a4 = *(const LAS f32x4*)(wl + 256 + j);
            S[j] = S[j] * d4.x + sa * a4.x + vc * k4.x; S[j + 1] = S[j + 1] * d4.y + sa * a4.y + vc * k4.y; S[j + 2] = S[j + 2] * d4.z + sa * a4.z + vc * k4.z; S[j + 3] = S[j + 3] * d4.w + sa * a4.w + vc * k4.w;
            o0 += S[j] * r4.x; o1 += S[j + 1] * r4.y; o2 += S[j + 2] * r4.z; o3 += S[j + 3] * r4.w; }
        const float o = (o0 + o1) + (o2 + o3);
        const float mean = wave_sum(o) * (1.0f / 64.0f), dv = o - mean, var = wave_sum(dv * dv) * (1.0f / 64.0f);
        const float on = dv * (1.0f / sqrtf(var + 64e-5f)) * gwc + gbc;
        const float bonus = wave_sum(rc * kc * rkc) * vc;
        const float y = (on + bonus) * gc;
        YC[base + (size_t)t * 1024] = (bf16)(cvt_pk_bf16(y, 0.f) & 0xffffu);
        WAVE_SYNC();
    }
}

__device__ __forceinline__ void attn_item(const bf16* cA, bf16* YA, int item, int lane, LAS float* wl) {
    const int m = item >> 2, slot = item & 3, t = m & (SEQ - 1);
    LAS float* ql = wl; LAS float* pl = wl + 384;
#pragma unroll
    for (int g = 0; g < 3; ++g) { const unsigned w = *(const unsigned*)(cA + (size_t)m * 4608 + (4 * g + slot) * 128 + 2 * lane); *(LAS f32x2*)(ql + g * 128 + 2 * lane) = (f32x2){bf_lo(w), bf_hi(w)}; }
    WAVE_SYNC();
    float mx = -1e30f;
#pragma unroll 1
    for (int g = 0; g < 3; ++g) { const int dil = 1 << (2 * g), h = 4 * g + slot; const float slope = exp2f(-8.0f * (float)(h + 1) / 12.0f);
#pragma unroll 1
        for (int i = 0; i < 3; ++i) { const int jj = lane + 64 * i, tk = t - jj * dil; float sc = -1e30f;
            if (jj <= 128 && tk >= 0) { const v4u* kr = (const v4u*)(cA + (size_t)(m - jj * dil) * 4608 + 1536 + h * 128); float d0 = 0.f, d1 = 0.f;
#pragma unroll 4
                for (int c8 = 0; c8 < 16; ++c8) { const v4u kv = kr[c8]; const f32x4 qa = *(const LAS f32x4*)(ql + g * 128 + 8 * c8), qb = *(const LAS f32x4*)(ql + g * 128 + 8 * c8 + 4);
                    d0 += bf_lo(kv.x) * qa.x + bf_hi(kv.x) * qa.y + bf_lo(kv.y) * qa.z + bf_hi(kv.y) * qa.w;
                    d1 += bf_lo(kv.z) * qb.x + bf_hi(kv.z) * qb.y + bf_lo(kv.w) * qb.z + bf_hi(kv.w) * qb.w; }
                sc = (d0 + d1) * 0.08838834764831845f - slope * (float)(jj * dil); }
            pl[g * 192 + jj] = sc; mx = fmaxf(mx, sc); } }
    mx = wave_max(mx);
    float sum = 0.f;
#pragma unroll 1
    for (int e = 0; e < 9; ++e) { const int idx = (e / 3) * 192 + lane + 64 * (e % 3); const float sc = pl[idx]; const float p = sc > -1e29f ? __expf(sc - mx) : 0.f; sum += p; pl[idx] = p; }
    sum = wave_sum(sum);
    WAVE_SYNC();
    float a0 = 0.f, a1 = 0.f;
#pragma unroll
    for (int g = 0; g < 3; ++g) { const int dil = 1 << (2 * g), h = 4 * g + slot; int nk = t / dil; nk = (nk < 128 ? nk : 128) + 1;
        const bf16* vb = cA + (size_t)m * 4608 + 3072 + h * 128 + 2 * lane; const size_t step = (size_t)dil * 4608;
#pragma unroll 4
        for (int jj = 0; jj < nk; ++jj) { const float p = pl[g * 192 + jj]; const unsigned w = *(const unsigned*)(vb - (size_t)jj * step); a0 += p * bf_lo(w); a1 += p * bf_hi(w); } }
    const float inv = 1.0f / sum;
    *(unsigned*)(YA + (size_t)m * 512 + slot * 128 + 2 * lane) = cvt_pk_bf16(a0 * inv, a1 * inv);
    WAVE_SYNC();
}

#define XB_TMO      128
#define XB_XCNT(j)  (256  + 64 * (j))
#define XB_XSUB(j)  (1280 + 64 * (j))
#define XB_XGEN(j)  (2304 + 64 * (j))
#define XB_TOP      3328
#define XB_TOPGEN   3392
#define XCD_BAR_WORDS 3456
#define XB_SPIN_CAP (1u << 18)

__device__ __forceinline__ unsigned xb_ld(unsigned* p)              { return __hip_atomic_load(p, __ATOMIC_RELAXED, __HIP_MEMORY_SCOPE_AGENT); }
__device__ __forceinline__ unsigned xb_add(unsigned* p, unsigned v) { return __hip_atomic_fetch_add(p, v, __ATOMIC_RELAXED, __HIP_MEMORY_SCOPE_AGENT); }
__device__ __forceinline__ unsigned xb_xcc_id() { return (unsigned)__builtin_amdgcn_s_getreg((3 << 11) | 20) & 0xFu; }
#define XB_SPIN(cond, bar) do { unsigned _sp = 0; while (cond) { __builtin_amdgcn_s_sleep(1); \
    if ((++_sp & 255u) == 0u) { if (xb_ld(&(bar)[XB_TMO])) break; if (_sp > XB_SPIN_CAP) { atomicAdd(&(bar)[XB_TMO], 1u); break; } } } } while (0)

struct XcdBarrier {
    unsigned* bar; unsigned x;
    volatile LAS unsigned* st;
};

__device__ __forceinline__ XcdBarrier xcd_barrier_post(unsigned* bar, volatile LAS unsigned* st) {
    XcdBarrier b; b.bar = bar; b.x = xb_xcc_id(); b.st = st;
    if (threadIdx.x == 0) (void)xb_add(&bar[XB_XCNT(b.x)], 1u);
    return b;
}
__device__ __forceinline__ void xcd_barrier_complete(unsigned* bar, unsigned x, unsigned& nloc, unsigned& nx) {
    const unsigned G = gridDim.x * gridDim.y * gridDim.z;
    unsigned sum, cnt, mine, sp = 0u;
    for (;;) {
        sum = 0u; cnt = 0u; mine = 0u;
#pragma unroll
        for (unsigned j = 0; j < 16; ++j) { const unsigned c = xb_ld(&bar[XB_XCNT(j)]); sum += c; cnt += (c > 0u) ? 1u : 0u; mine = (j == x) ? c : mine; }
        if (sum == G) break;
        __builtin_amdgcn_s_sleep(1);
        if ((++sp & 255u) == 0u) { if (xb_ld(&bar[XB_TMO])) break; if (sp > XB_SPIN_CAP) { atomicAdd(&bar[XB_TMO], 1u); break; } }
    }
    nloc = mine > 0u ? mine : 1u; nx = cnt > 0u ? cnt : 1u;
}

__device__ __forceinline__ void xcd_barrier(const XcdBarrier& b) {
    asm volatile("s_waitcnt vmcnt(0)" ::: "memory");
    __syncthreads();
    if (threadIdx.x == 0) {
        unsigned* bar = b.bar;
        __builtin_amdgcn_s_waitcnt(0);
        unsigned nloc = b.st[0], nx = b.st[1];
        if (nloc == 0u) { xcd_barrier_complete(bar, b.x, nloc, nx); b.st[0] = nloc; b.st[1] = nx; }
        const unsigned old = xb_add(&bar[XB_XSUB(b.x)], 1u);
        const unsigned gen = old / nloc;
        if (old + 1u == (gen + 1u) * nloc) {
            __builtin_amdgcn_fence(__ATOMIC_RELEASE, "agent");
            asm volatile("s_waitcnt vmcnt(0)" ::: "memory");
            const unsigned og = xb_add(&bar[XB_TOP], 1u);
            const unsigned tg = og / nx;
            if (og + 1u == (tg + 1u) * nx) xb_add(&bar[XB_TOPGEN], 1u);
            else XB_SPIN(xb_ld(&bar[XB_TOPGEN]) == tg, bar);
            __builtin_amdgcn_fence(__ATOMIC_ACQUIRE, "agent");
            xb_add(&bar[XB_XGEN(b.x)], 1u);
            asm volatile("s_waitcnt vmcnt(0)" ::: "memory");
        } else {
            XB_SPIN(xb_ld(&bar[XB_XGEN(b.x)]) == gen, bar);
            __builtin_amdgcn_fence(__ATOMIC_ACQUIRE, "agent");
            asm volatile("s_waitcnt vmcnt(0)" ::: "memory");
        }
    }
    __syncthreads();
}

struct Args { const float* in[29]; float* out; unsigned char* ws; int ph_lo, ph_hi; };
__global__ void __launch_bounds__(NWAVES * 64, 2) fwd(Args a) {
    extern __shared__ __attribute__((aligned(16))) unsigned char lds_raw[];
    LAS unsigned char* lds = (LAS unsigned char*)lds_raw;
    const int tid0 = threadIdx.x;
    const int G = gridDim.x, bx = blockIdx.x, NGW = G * NWAVES;
    for (int u = tid0; u < (LDS_BYTES - LDSCTL_OFF) / 4; u += NWAVES * 64) ((LAS unsigned*)(lds + LDSCTL_OFF))[u] = 0u;
    __syncthreads();
    unsigned char* ws = a.ws;
    unsigned* ctl = (unsigned*)(ws + WS_CTL);
    const int lo = a.ph_lo, hi = a.ph_hi;
    XcdBarrier bar; bar.bar = ctl + CW_BAR; bar.x = 0; bar.st = nullptr;
    if (hi - lo > 1) bar = xcd_barrier_post(ctl + CW_BAR, (volatile LAS unsigned*)(lds + MISC_OFF) + 8);
#define PH_IF if (lo <= pc && pc < hi)
#define OPQ(p) asm volatile("" : "+s"(p))
#ifndef SKIPMASK
#define SKIPMASK 0
#endif
#define PH_IFN(k) if (!((SKIPMASK >> (k)) & 1) && lo <= pc && pc < hi)
#define PH_ENTER int tid = tid0; asm volatile("" : "+v"(tid)); const int lane = tid & 63, wave = __builtin_amdgcn_readfirstlane(tid >> 6), gw = bx * NWAVES + wave; LAS float* wl = (LAS float*)(lds + RING_OFF + wave * 16384); (void)lane; (void)gw; (void)wl;
#define PH_SEAM do { if (lo <= pc && pc + 1 < hi) xcd_barrier(bar); ++pc; } while (0)
    bf16* WB = (bf16*)(ws + WS_WB); bf16* H = (bf16*)(ws + WS_H); bf16* ACT = (bf16*)(ws + WS_ACT);
    bf16 *CA = (bf16*)(ws + WS_CA), *CB = (bf16*)(ws + WS_CB), *CC = (bf16*)(ws + WS_CC), *CG = (bf16*)(ws + WS_CG);
    float *GQ = (float*)(ws + WS_GQ), *GK = (float*)(ws + WS_GK), *GV = (float*)(ws + WS_GV), *GO = (float*)(ws + WS_GO), *GLD = (float*)(ws + WS_GLD), *GBT = (float*)(ws + WS_GBT);
    float *RR = (float*)(ws + WS_RR), *RK = (float*)(ws + WS_RK), *RV = (float*)(ws + WS_RV), *RD = (float*)(ws + WS_RD), *RKK = (float*)(ws + WS_RKK), *RKA = (float*)(ws + WS_RKA), *RG = (float*)(ws + WS_RG);
    bf16 *YA = (bf16*)(ws + WS_YA), *YB = (bf16*)(ws + WS_YB), *YC = (bf16*)(ws + WS_YC), *MB = (bf16*)(ws + WS_MB);
    float* MT = (float*)(ws + WS_MT);
    float* X = a.out;

    int pc = 0;
    for (int l = 0; l < DEPTH; ++l) {
        for (int f = 0; f < 2; ++f) {
            PH_IFN(0) { PH_ENTER
                if (f == 0) {
                    int rot = 0;
                    conv_matrix(a.in[2] + (size_t)l * D * 2 * FF, D, 2 * FF, WB + W_GU1, 2 * FF, MapGu(), wl, rot, gw, NGW, lane);
                    conv_matrix(a.in[3] + (size_t)l * FF * D, FF, D, WB + W_D1, D, MapId(), wl, rot, gw, NGW, lane);
                    conv_matrix(a.in[5] + (size_t)l * D * 18384, D, 18384, WB + W_IN, NIN_PAD, MapIn(), wl, rot, gw, NGW, lane);
                    conv_matrix(a.in[21] + (size_t)l * 512 * D, 512, D, WB + W_PA, D, MapId(), wl, rot, gw, NGW, lane);
                    conv_matrix(a.in[22] + (size_t)l * 1024 * D, 1024, D, WB + W_PB, D, MapId(), wl, rot, gw, NGW, lane);
                    conv_matrix(a.in[23] + (size_t)l * 1024 * D, 1024, D, WB + W_PC, D, MapId(), wl, rot, gw, NGW, lane);
                    conv_matrix(a.in[24] + (size_t)l * D * D, D, D, WB + W_WO, D, MapId(), wl, rot, gw, NGW, lane);
                    conv_matrix(a.in[26] + (size_t)l * D * 2 * FF, D, 2 * FF, WB + W_GU2, 2 * FF, MapGu(), wl, rot, gw, NGW, lane);
                    conv_matrix(a.in[27] + (size_t)l * FF * D, FF, D, WB + W_D2, D, MapId(), wl, rot, gw, NGW, lane);
                }
                const bool first = (l == 0 && f == 0);
                norm_rows(first ? a.in[0] : X, first ? X : nullptr, (f == 0 ? a.in[1] : a.in[25]) + (size_t)l * D, H, gw, NGW, lane);
            }
            PH_SEAM;
            PH_IFN(1) { PH_ENTER
                const bf16* pa_ = H; const bf16* pb_ = WB + (f == 0 ? W_GU1 : W_GU2); bf16* po_ = ACT; OPQ(pa_); OPQ(pb_); OPQ(po_);
                pg8::Gemm g{pa_, pb_, M, 2 * FF, D}; pg8::StaticOrder S; S.init(M, 2 * FF, G, bx);
                pg8::EpiSwiglu E{po_, FF};
                pg8::gemm_phase<pg8::EpiSwiglu, pg8::StaticOrder, true, true>(lds + RING_OFF, g, S, E);
            }
            PH_SEAM;
            PH_IFN(2) { PH_ENTER
                const bf16* pa_ = ACT; const bf16* pb_ = WB + (f == 0 ? W_D1 : W_D2); float* po_ = X; OPQ(pa_); OPQ(pb_); OPQ(po_);
                pg8::Gemm g{pa_, pb_, M, D, FF}; pg8::StaticOrder S; S.init(M, D, G, bx);
                pg8::EpiResid E{po_, D, 0.5f};
                pg8::gemm_phase<pg8::EpiResid, pg8::StaticOrder, true, true>(lds + RING_OFF, g, S, E);
            }
            PH_SEAM;
            if (f == 0) {
                PH_IFN(3) { PH_ENTER const float* px = X; bf16* ph = H; OPQ(px); OPQ(ph); norm_rows(px, nullptr, a.in[4] + (size_t)l * D, ph, gw, NGW, lane); }
                PH_SEAM;
                PH_IFN(4) { PH_ENTER
                    const bf16* pa_ = H; const bf16* pb_ = WB + W_IN; bf16 *o0 = CA, *o1 = CB, *o2 = CC, *o3 = CG; OPQ(pa_); OPQ(pb_); OPQ(o0); OPQ(o1); OPQ(o2); OPQ(o3);
                    pg8::Gemm g{pa_, pb_, M, NIN_PAD, D}; pg8::StaticOrder S; S.init(M, NIN_PAD, G, bx);
                    pg8::EpiCols E{o0, o1, o2, o3};
                    pg8::gemm_phase<pg8::EpiCols, pg8::StaticOrder, true, true>(lds + RING_OFF, g, S, E);
                }
                PH_SEAM;
                PH_IFN(5) { PH_ENTER
                    for (int tile = bx; tile < M / 16; tile += G)
                        rwkv_prep_tile(CC, a.in[10] + (size_t)l * 3520, a.in[11] + (size_t)l * 1024, a.in[12] + (size_t)l * 96 * 1024, a.in[13] + (size_t)l * 1024, a.in[14] + (size_t)l * 96 * 1024,
                                       a.in[15] + (size_t)l * 256 * 1024, a.in[16] + (size_t)l * 1024, a.in[17] + (size_t)l * 1024, RR, RK, RV, RD, RKK, RKA, RG, tile, tid, (LAS float*)(lds + RING_OFF));
                    gdn_prep(CB, CC, a.in[6] + (size_t)l * 4 * 3072, a.in[7] + (size_t)l * 8, a.in[8] + (size_t)l * 8, GQ, GK, GV, GLD, GBT, gw, NGW, lane);
                }
                PH_SEAM;
                PH_IFN(6) { PH_ENTER
                    if (wave == 0) for (int item = bx; item < 256; item += G) gdn_scan_seq(GQ, GK, GV, GLD, GBT, GO, item, lane, wl);
                    if (wave == 1) for (int item = bx; item < 128; item += G) rwkv_scan_seq(RR, RK, RV, RD, RKK, RKA, RG, a.in[18] + (size_t)l * 1024, a.in[19] + (size_t)l * 1024, a.in[20] + (size_t)l * 1024, YC, item, lane, wl);
                    unsigned* ctr = ctl + CW_ATT + l * 64;
                    for (;;) {
                        int it = 0; if (lane == 0) it = (int)__hip_atomic_fetch_add(ctr, 1u, __ATOMIC_RELAXED, __HIP_MEMORY_SCOPE_AGENT);
                        it = __builtin_amdgcn_readfirstlane(it);
                        if (it >= M * 4) break;
                        attn_item(CA, YA, it, lane, wl);
                    }
                }
                PH_SEAM;
                PH_IFN(7) { PH_ENTER const float* p0 = GO; const bf16* p1 = CB; bf16* p2 = YB; OPQ(p0); OPQ(p1); OPQ(p2); gdn_post(p0, p1, a.in[9] + (size_t)l * 128, p2, gw, NGW, lane); }
                PH_SEAM;
                PH_IFN(8) { PH_ENTER
                    pg8::StaticOrder S; S.init(M, D, G, bx);
                    { const bf16* pa_ = YA; const bf16* pb_ = WB + W_PA; const bf16* pg_ = CG; float* pt_ = MT; bf16* po_ = MB; OPQ(pa_); OPQ(pb_); OPQ(pg_); OPQ(pt_); OPQ(po_);
                      pg8::Gemm g{pa_, pb_, M, D, 512}; pg8::EpiGate<0> E{pg_, pt_, po_}; pg8::gemm_phase<pg8::EpiGate<0>, pg8::StaticOrder, true, true>(lds + RING_OFF, g, S, E); }
                    { const bf16* pa_ = YB; const bf16* pb_ = WB + W_PB; const bf16* pg_ = CG + 2048; float* pt_ = MT; bf16* po_ = MB; OPQ(pa_); OPQ(pb_); OPQ(pg_); OPQ(pt_); OPQ(po_);
                      pg8::Gemm g{pa_, pb_, M, D, 1024}; pg8::EpiGate<1> E{pg_, pt_, po_}; pg8::gemm_phase<pg8::EpiGate<1>, pg8::StaticOrder, true, true>(lds + RING_OFF, g, S, E); }
                    { const bf16* pa_ = YC; const bf16* pb_ = WB + W_PC; const bf16* pg_ = CG + 4096; float* pt_ = MT; bf16* po_ = MB; OPQ(pa_); OPQ(pb_); OPQ(pg_); OPQ(pt_); OPQ(po_);
                      pg8::Gemm g{pa_, pb_, M, D, 1024}; pg8::EpiGate<2> E{pg_, pt_, po_}; pg8::gemm_phase<pg8::EpiGate<2>, pg8::StaticOrder, true, true>(lds + RING_OFF, g, S, E); }
                }
                PH_SEAM;
                PH_IFN(9) { PH_ENTER
                    const bf16* pa_ = MB; const bf16* pb_ = WB + W_WO; float* po_ = X; OPQ(pa_); OPQ(pb_); OPQ(po_);
                    pg8::Gemm g{pa_, pb_, M, D, D}; pg8::StaticOrder S; S.init(M, D, G, bx);
                    pg8::EpiResid E{po_, D, 1.0f};
                    pg8::gemm_phase<pg8::EpiResid, pg8::StaticOrder, true, true>(lds + RING_OFF, g, S, E);
                }
                PH_SEAM;
            }
        }
    }
    PH_IFN(10) { PH_ENTER float* px = X; OPQ(px); final_norm_rows(px, a.in[28], gw, NGW, lane); }
#undef PH_IF
#undef PH_SEAM
}

extern "C" void kernel_launch(void* const* d_in, const int* in_sizes, int n_in, void* d_out, int out_size, void* d_ws, size_t ws_size, hipStream_t stream) {
    static int grid = 0;
    if (grid == 0) {
        if (n_in != 29 || out_size != M * D || ws_size < WS_END) { fprintf(stderr, "kernel_launch: unexpected shapes (n_in %d out %d ws %zu)\n", n_in, out_size, ws_size); grid = -1; return; }
        int dev = 0, cus = 0;
        if (hipGetDevice(&dev) != hipSuccess || hipDeviceGetAttribute(&cus, hipDeviceAttributeMultiprocessorCount, dev) != hipSuccess) { grid = -1; return; }
        if (hipFuncSetAttribute((const void*)fwd, hipFuncAttributeMaxDynamicSharedMemorySize, LDS_BYTES) != hipSuccess) { fprintf(stderr, "kernel_launch: hipFuncSetAttribute failed\n"); grid = -1; return; }
        int per_cu = 0; (void)hipOccupancyMaxActiveBlocksPerMultiprocessor(&per_cu, (const void*)fwd, NWAVES * 64, LDS_BYTES); (void)hipGetLastError();
        grid = cus;
        if (per_cu < 1) fprintf(stderr, "kernel_launch: occupancy query reports %d\n", per_cu);
    }
    if (grid < 0) return;
    if (hipMemsetAsync((char*)d_ws + WS_CTL, 0, CTL_ZERO_BYTES, stream) != hipSuccess) return;
    Args a{};
    for (int i = 0; i < 29; ++i) a.in[i] = (const float*)d_in[i];
    a.out = (float*)d_out; a.ws = (unsigned char*)d_ws;
#if MK_PER_PHASE
    for (int p = 0; p < N_PHASES; ++p) { a.ph_lo = p; a.ph_hi = p + 1; hipLaunchKernelGGL(fwd, dim3(grid), dim3(NWAVES * 64), LDS_BYTES, stream, a); }
#else
    a.ph_lo = 0; a.ph_hi = N_PHASES; hipLaunchKernelGGL(fwd, dim3(grid), dim3(NWAVES * 64), LDS_BYTES, stream, a);
#endif
}
```

```cpp
#define MK_PER_PHASE 0
#include <hip/hip_runtime.h>
#include <cstdio>
#include <cstdint>
namespace pg8 {
#define PG8_LAS __attribute__((address_space(3)))
typedef unsigned short bf16_t;
typedef short bf16x8 __attribute__((ext_vector_type(8)));
typedef float f32x4 __attribute__((ext_vector_type(4)));
typedef unsigned u32x4 __attribute__((ext_vector_type(4)));
constexpr int BM = 256, BK = 64, HALF = 128, HTB = HALF * BK * 2  , STAGE_BYTES = 8 * HTB, NXCD = 8, WGM = 8;

__host__ __device__ __forceinline__ int lds_byte(int r, int c) { const int st = (r >> 4) * 2 + (c >> 5), rr = r & 15, cc = c & 31, ob = rr * 64 + cc * 2; return st * 1024 + (ob ^ (((ob >> 9) & 1) << 5)); }
__host__ __device__ __forceinline__ void stage_rc(int b, int& R, int& C) { const int st = b / 1024, sb = b % 1024, swz = sb ^ (((sb >> 9) & 1) << 5); R = (st >> 1) * 16 + swz / 64; C = (st & 1) * 32 + (swz % 64) / 2; }
__host__ __device__ __forceinline__ int perm32(int rho) { const int n = rho >> 4, i = rho & 15; return 8 * (i >> 2) + 4 * n + (i & 3); }

struct Unit { int pm, pn; };
struct Gemm { const bf16_t* A; const bf16_t* Bt; int M, N, K; };

struct StaticOrder {
    int nM, nN, nwg, G, c;
    __host__ __device__ void init(int M, int N, int G_, int c_) { nM = M / BM; nN = N / BM; nwg = nM * nN; G = G_; c = c_; }
    __host__ __device__ bool next(int i, Unit& u) const {
        const long L = (long)i * G + c; if (L >= nwg) return false;
        int wgid = (int)L; { const int q = nwg / NXCD, r = nwg % NXCD, xcd = wgid % NXCD, off = wgid / NXCD; wgid = (xcd < r ? xcd * (q + 1) : r * (q + 1) + (xcd - r) * q) + off; }
        const int nig = WGM * nN, gid = wgid / nig, fm = gid * WGM, gsz = (nM - fm) < WGM ? (nM - fm) : WGM;
        u.pm = fm + ((wgid % nig) % gsz); u.pn = (wgid % nig) / gsz; return true;
    }
    __device__ __forceinline__ void a_ready(const Unit&) const {}
    __device__ __forceinline__ void done(const Unit&) const {}
};
typedef __bf16 bf16x2_t __attribute__((ext_vector_type(2)));
typedef float f32x2_t __attribute__((ext_vector_type(2)));
__device__ __forceinline__ unsigned cvt_pk_bf16(float lo, float hi) { const f32x2_t v = {lo, hi}; const bf16x2_t b = __builtin_convertvector(v, bf16x2_t); return __builtin_bit_cast(unsigned, b); }
__device__ __forceinline__ float bf_lo(unsigned w) { return __uint_as_float(w << 16); }
__device__ __forceinline__ float bf_hi(unsigned w) { return __uint_as_float(w & 0xffff0000u); }
__device__ __forceinline__ float sigmoid_f(float x) { return __builtin_amdgcn_rcpf(1.0f + __expf(-x)); }
__device__ __forceinline__ float silu_f(float x) { return x * sigmoid_f(x); }

struct EpiSwiglu {
    static constexpr bool PERM = true, AFTER_DRAIN = false, HAS_HOOK = false;
    bf16_t* O; int ldc;
    __device__ __forceinline__ void operator()(const f32x4 (&acc)[2][2][4][2], const Unit& u, int wr, int wc, int fr, int fq) const {
        const int row0 = u.pm * BM + wr * 64 + fr, col0 = u.pn * HALF + wc * 32 + 8 * fq;
#pragma unroll
        for (int ai = 0; ai < 2; ++ai)
#pragma unroll
            for (int m = 0; m < 4; ++m) { bf16_t* rowp = O + (size_t)(row0 + ai * HALF + m * 16) * ldc + col0;
                const f32x4 g0 = acc[ai][0][m][0], g1 = acc[ai][0][m][1], u0 = acc[ai][1][m][0], u1 = acc[ai][1][m][1];
                f32x4 v0, v1;
#pragma unroll
                for (int j = 0; j < 4; ++j) { v0[j] = silu_f(g0[j]) * u0[j]; v1[j] = silu_f(g1[j]) * u1[j]; }
                u32x4 w; w.x = cvt_pk_bf16(v0[0], v0[1]); w.y = cvt_pk_bf16(v0[2], v0[3]); w.z = cvt_pk_bf16(v1[0], v1[1]); w.w = cvt_pk_bf16(v1[2], v1[3]);
                *(u32x4*)rowp = w; }
    }
};
struct EpiResid {
    static constexpr bool PERM = false, AFTER_DRAIN = false, HAS_HOOK = false;
    float* X; int ldc; float scale;
    __device__ __forceinline__ void operator()(const f32x4 (&acc)[2][2][4][2], const Unit& u, int wr, int wc, int fr, int fq) const {
        const int row0 = u.pm * BM + wr * 64 + fr, col0 = u.pn * BM + wc * 32 + 4 * fq;
#pragma unroll
        for (int ai = 0; ai < 2; ++ai) { f32x4 o[4][2][2];
#pragma unroll
            for (int m = 0; m < 4; ++m) { const float* rowp = X + (size_t)(row0 + ai * HALF + m * 16) * ldc + col0;
#pragma unroll
                for (int bj = 0; bj < 2; ++bj)
#pragma unroll
                    for (int n = 0; n < 2; ++n) o[m][bj][n] = *(const f32x4*)(rowp + bj * HALF + n * 16); }
            asm volatile("" ::: "memory");
#pragma unroll
            for (int m = 0; m < 4; ++m) { float* rowp = X + (size_t)(row0 + ai * HALF + m * 16) * ldc + col0;
#pragma unroll
                for (int bj = 0; bj < 2; ++bj)
#pragma unroll
                    for (int n = 0; n < 2; ++n) *(f32x4*)(rowp + bj * HALF + n * 16) = o[m][bj][n] + acc[ai][bj][m][n] * scale; }
            asm volatile("" ::: "memory"); }
    }
};
struct EpiCols {
    static constexpr bool PERM = true, AFTER_DRAIN = false, HAS_HOOK = false;
    bf16_t *cA, *cB, *cC, *cG;
    __device__ __forceinline__ void operator()(const f32x4 (&acc)[2][2][4][2], const Unit& u, int wr, int wc, int fr, int fq) const {
        bf16_t* base; int ldc, colt;
        if (u.pn < 18) { base = cA; ldc = 4608; colt = u.pn * BM; }
        else if (u.pn < 34) { base = cB; ldc = 4096; colt = (u.pn - 18) * BM; }
        else if (u.pn < 48) { base = cC; ldc = 3584; colt = (u.pn - 34) * BM; }
        else { base = cG; ldc = 6144; colt = (u.pn - 48) * BM; }
        const int row0 = u.pm * BM + wr * 64 + fr, col0 = colt + wc * 32 + 8 * fq;
#pragma unroll
        for (int ai = 0; ai < 2; ++ai)
#pragma unroll
            for (int m = 0; m < 4; ++m) { bf16_t* rowp = base + (size_t)(row0 + ai * HALF + m * 16) * ldc + col0;
#pragma unroll
                for (int bj = 0; bj < 2; ++bj) { const f32x4 v0 = acc[ai][bj][m][0], v1 = acc[ai][bj][m][1];
                    u32x4 w; w.x = cvt_pk_bf16(v0[0], v0[1]); w.y = cvt_pk_bf16(v0[2], v0[3]); w.z = cvt_pk_bf16(v1[0], v1[1]); w.w = cvt_pk_bf16(v1[2], v1[3]);
                    *(u32x4*)(rowp + bj * HALF) = w; } }
    }
};
template <int MODE> struct EpiGate {
    static constexpr bool PERM = true, AFTER_DRAIN = false, HAS_HOOK = false;
    const bf16_t* G; float* T; bf16_t* O;
    __device__ __forceinline__ void operator()(const f32x4 (&acc)[2][2][4][2], const Unit& u, int wr, int wc, int fr, int fq) const {
        const int row0 = u.pm * BM + wr * 64 + fr, col0 = u.pn * BM + wc * 32 + 8 * fq;
#pragma unroll
        for (int ai = 0; ai < 2; ++ai)
#pragma unroll
            for (int m = 0; m < 4; ++m) { const size_t r = (size_t)(row0 + ai * HALF + m * 16);
#pragma unroll
                for (int bj = 0; bj < 2; ++bj) { const int c = col0 + bj * HALF;
                    const u32x4 gw = *(const u32x4*)(G + r * 6144 + c);
                    f32x4 a0 = acc[ai][bj][m][0], a1 = acc[ai][bj][m][1];
                    a0[0] *= sigmoid_f(bf_lo(gw.x)); a0[1] *= sigmoid_f(bf_hi(gw.x)); a0[2] *= sigmoid_f(bf_lo(gw.y)); a0[3] *= sigmoid_f(bf_hi(gw.y));
                    a1[0] *= sigmoid_f(bf_lo(gw.z)); a1[1] *= sigmoid_f(bf_hi(gw.z)); a1[2] *= sigmoid_f(bf_lo(gw.w)); a1[3] *= sigmoid_f(bf_hi(gw.w));
                    f32x4* tp = (f32x4*)(T + r * 2048 + c);
                    if (MODE == 0) { tp[0] = a0; tp[1] = a1; }
                    else if (MODE == 1) { tp[0] = tp[0] + a0; tp[1] = tp[1] + a1; }
                    else { a0 = a0 + tp[0]; a1 = a1 + tp[1];
                        u32x4 w; w.x = cvt_pk_bf16(a0[0], a0[1]); w.y = cvt_pk_bf16(a0[2], a0[3]); w.z = cvt_pk_bf16(a1[0], a1[1]); w.w = cvt_pk_bf16(a1[2], a1[3]);
                        *(u32x4*)(O + r * 2048 + c) = w; }
                    asm volatile("" ::: "memory"); } }
    }
};


struct EpiGate3 {
    static constexpr bool PERM = true, AFTER_DRAIN = false, HAS_HOOK = true;
    static constexpr int H0 = 8, H1 = 24;
    const bf16_t* G; bf16_t* O;
    __device__ __forceinline__ void hook(f32x4 (&acc)[2][2][4][2], const Unit& u, int t, int wr, int wc, int fr, int fq) const {
        const int row0 = u.pm * BM + wr * 64 + fr, col0 = u.pn * BM + wc * 32 + 8 * fq + (t == H0 ? 0 : 2048);
#pragma unroll
        for (int ai = 0; ai < 2; ++ai)
#pragma unroll
            for (int mp = 0; mp < 2; ++mp) { u32x4 ga[2][2], gb[2][2];
#pragma unroll
                for (int mm = 0; mm < 2; ++mm) { const unsigned ro = (unsigned)(row0 + ai * HALF + (2 * mp + mm) * 16) * 12288u + 2u * (unsigned)col0;
#pragma unroll
                    for (int bj = 0; bj < 2; ++bj) { const char* gp = (const char*)G + (ro + 256u * (unsigned)bj); ga[mm][bj] = *(const u32x4*)gp; gb[mm][bj] = *(const u32x4*)(gp + 4096); } }
                asm volatile("" ::: "memory");
#pragma unroll
                for (int mm = 0; mm < 2; ++mm)
#pragma unroll
                    for (int bj = 0; bj < 2; ++bj) { const int m = 2 * mp + mm;
                        const unsigned a4[4] = {ga[mm][bj].x, ga[mm][bj].y, ga[mm][bj].z, ga[mm][bj].w}, b4[4] = {gb[mm][bj].x, gb[mm][bj].y, gb[mm][bj].z, gb[mm][bj].w};
#pragma unroll
                        for (int q = 0; q < 4; ++q) {
                            const float r0 = (1.0f + __expf(-bf_lo(b4[q]))) * __builtin_amdgcn_rcpf(1.0f + __expf(-bf_lo(a4[q]))), r1 = (1.0f + __expf(-bf_hi(b4[q]))) * __builtin_amdgcn_rcpf(1.0f + __expf(-bf_hi(a4[q])));
                            acc[ai][bj][m][q >> 1][2 * (q & 1)] *= r0; acc[ai][bj][m][q >> 1][2 * (q & 1) + 1] *= r1; } }
                asm volatile("" ::: "memory"); }
    }
    __device__ __forceinline__ void operator()(const f32x4 (&acc)[2][2][4][2], const Unit& u, int wr, int wc, int fr, int fq) const {
        const int row0 = u.pm * BM + wr * 64 + fr, col0 = u.pn * BM + wc * 32 + 8 * fq;
#pragma unroll
        for (int ai = 0; ai < 2; ++ai) { u32x4 gw[4][2];
#pragma unroll
            for (int m = 0; m < 4; ++m)
#pragma unroll
                for (int bj = 0; bj < 2; ++bj) gw[m][bj] = *(const u32x4*)((const char*)G + ((unsigned)(row0 + ai * HALF + m * 16) * 12288u + 8192u + 2u * (unsigned)(col0 + bj * HALF)));
            asm volatile("" ::: "memory");
#pragma unroll
            for (int m = 0; m < 4; ++m) { const unsigned rr = (unsigned)(row0 + ai * HALF + m * 16);
#pragma unroll
                for (int bj = 0; bj < 2; ++bj) { const unsigned c = (unsigned)(col0 + bj * HALF); const u32x4 g = gw[m][bj];
                    f32x4 a0 = acc[ai][bj][m][0], a1 = acc[ai][bj][m][1];
                    a0[0] *= sigmoid_f(bf_lo(g.x)); a0[1] *= sigmoid_f(bf_hi(g.x)); a0[2] *= sigmoid_f(bf_lo(g.y)); a0[3] *= sigmoid_f(bf_hi(g.y));
                    a1[0] *= sigmoid_f(bf_lo(g.z)); a1[1] *= sigmoid_f(bf_hi(g.z)); a1[2] *= sigmoid_f(bf_lo(g.w)); a1[3] *= sigmoid_f(bf_hi(g.w));
                    u32x4 w; w.x = cvt_pk_bf16(a0[0], a0[1]); w.y = cvt_pk_bf16(a0[2], a0[3]); w.z = cvt_pk_bf16(a1[0], a1[1]); w.w = cvt_pk_bf16(a1[2], a1[3]);
                    *(u32x4*)((char*)O + (rr * 4096u + 2u * c)) = w; } }
            asm volatile("" ::: "memory"); }
    }
};
template <class Epi, class Sched, bool ALIGN_EPI = false, bool SP2 = false>
__device__ __forceinline__ void gemm_phase(PG8_LAS unsigned char* lds, const Gemm g, const Sched& S, const Epi& E, int tid_in) {
    int tid_raw = tid_in; asm volatile("" : "+v"(tid_raw));
    const int tid = tid_raw, wid = __builtin_amdgcn_readfirstlane(tid >> 6), lane = tid & 63, wr = wid >> 2, wc = wid & 3, fr = lane & 15, fq = lane >> 4;
    const int K = g.K, nt = K / BK;
    unsigned voffA[2], voffB[2];
#pragma unroll
    for (int i = 0; i < 2; ++i) { int R, C; stage_rc(tid * 16 + i * 8192, R, C); const int Rb = Epi::PERM ? ((R & ~31) + perm32(R & 31)) : R;
        voffA[i] = (unsigned)(R * K + C) * 2u; voffB[i] = (unsigned)(Rb * K + C) * 2u; }
    const size_t kstep = (size_t)(BK * 2);
    const size_t hstep = (size_t)HALF * K * 2;
    const size_t tstep = 2 * hstep;
    const unsigned ldsw = (unsigned)wid * 1024u;
    const int aoff = lds_byte(wr * 64 + fr, fq * 8), boff = lds_byte(wc * 32 + fr, fq * 8);
#define PG8_SA(b, h) (((b) * 2 + (h)) * HTB)
#define PG8_SB(b, h) ((4 + (b) * 2 + (h)) * HTB)
#define PG8_STAGE(bufoff, gbase, voff) do { _Pragma("unroll") for (int _i = 0; _i < 2; ++_i) \
        __builtin_amdgcn_global_load_lds((const unsigned*)((const char*)(gbase) + (voff)[_i]), (PG8_LAS unsigned*)(lds + (bufoff) + ldsw + _i * 8192), 16, 0, 0); } while (0)
#define PG8_LDA(dst, b, h) do { _Pragma("unroll") for (int m = 0; m < 4; ++m) _Pragma("unroll") for (int k = 0; k < 2; ++k) dst[m][k] = *(const PG8_LAS bf16x8*)(lds + PG8_SA(b, h) + aoff + m * 2048 + k * 1024); } while (0)
#define PG8_LDB(dst, b, h) do { _Pragma("unroll") for (int n = 0; n < 2; ++n) _Pragma("unroll") for (int k = 0; k < 2; ++k) dst[n][k] = *(const PG8_LAS bf16x8*)(lds + PG8_SB(b, h) + boff + n * 2048 + k * 1024); } while (0)
#define PG8_MMA(ai, bj, At, Bt) do { __builtin_amdgcn_s_setprio(1); _Pragma("unroll") for (int m = 0; m < 4; ++m) _Pragma("unroll") for (int n = 0; n < 2; ++n) _Pragma("unroll") for (int k = 0; k < 2; ++k) \
        acc[ai][bj][m][n] = __builtin_amdgcn_mfma_f32_16x16x32_bf16(Bt[n][k], At[m][k], acc[ai][bj][m][n], 0, 0, 0); __builtin_amdgcn_s_setprio(0); } while (0)
#define PG8_WAIT_V(n) asm volatile("s_waitcnt vmcnt(" #n ")" ::: "memory")
#define PG8_WAIT_L(n) asm volatile("s_waitcnt lgkmcnt(" #n ")" ::: "memory")
#define PG8_BAR __builtin_amdgcn_s_barrier()
#define PG8_SCHED __builtin_amdgcn_sched_barrier(0)
    Unit cur, nxt; int ui = 0;
    if (!S.next(0, cur)) return;
    f32x4 acc[2][2][4][2];
#pragma unroll
    for (int a = 0; a < 2; ++a)
#pragma unroll
        for (int b = 0; b < 2; ++b)
#pragma unroll
            for (int m = 0; m < 4; ++m)
#pragma unroll
                for (int n = 0; n < 2; ++n) acc[a][b][m][n] = (f32x4){0.f, 0.f, 0.f, 0.f};
    bf16x8 At[4][2], B0[2][2], B1[2][2];
    const char* cA = (const char*)g.A + (size_t)cur.pm * tstep; const char* cB = (const char*)g.Bt + (size_t)cur.pn * tstep;
    S.a_ready(cur);
    if constexpr (SP2) {
        PG8_STAGE(PG8_SB(0, 0), cB, voffB); PG8_STAGE(PG8_SB(0, 1), cB + hstep, voffB); PG8_STAGE(PG8_SA(0, 0), cA, voffA); PG8_STAGE(PG8_SA(0, 1), cA + hstep, voffA);
        if (wr == 1) PG8_BAR;
        PG8_WAIT_V(2); PG8_BAR;
        PG8_STAGE(PG8_SB(1, 0), cB + kstep, voffB); PG8_STAGE(PG8_SA(1, 0), cA + kstep, voffA); PG8_STAGE(PG8_SB(1, 1), cB + hstep + kstep, voffB);
        PG8_WAIT_V(6); PG8_BAR;
    } else {
        PG8_STAGE(PG8_SB(0, 0), cB, voffB); PG8_STAGE(PG8_SA(0, 0), cA, voffA); PG8_STAGE(PG8_SB(0, 1), cB + hstep, voffB); PG8_STAGE(PG8_SA(0, 1), cA + hstep, voffA);
        if (wr == 1) PG8_BAR;
        PG8_WAIT_V(4); PG8_BAR;
        PG8_STAGE(PG8_SB(1, 0), cB + kstep, voffB); PG8_STAGE(PG8_SA(1, 0), cA + kstep, voffA); PG8_STAGE(PG8_SB(1, 1), cB + hstep + kstep, voffB);
        PG8_WAIT_V(6); PG8_BAR;
    }
    for (;;) {
        const bool has_next = S.next(ui + 1, nxt);
        const char* nA = has_next ? (const char*)g.A + (size_t)nxt.pm * tstep : cA; const char* nB = has_next ? (const char*)g.Bt + (size_t)nxt.pn * tstep : cB;
        for (int t = 0; t < nt; t += 2) {
            const bool last = (t == nt - 2);
            const char* a1 = cA + (size_t)(t + 1) * kstep;
            const char* a2 = last ? nA : cA + (size_t)(t + 2) * kstep; const char* b2 = last ? nB : cB + (size_t)(t + 2) * kstep;
            const char* a3 = a2 + kstep; const char* b3 = b2 + kstep;
            if (last && has_next) S.a_ready(nxt);
            if constexpr (Epi::HAS_HOOK) { if (t == Epi::H0 || t == Epi::H1) { E.hook(acc, cur, t, wr, wc, fr, fq); PG8_WAIT_V(0); } }
            if constexpr (SP2) {
            PG8_LDB(B0, 0, 0); PG8_LDB(B1, 0, 1); PG8_SCHED; PG8_LDA(At, 0, 0); PG8_STAGE(PG8_SA(1, 1), a1 + hstep, voffA);
            PG8_WAIT_V(8); PG8_WAIT_L(0); PG8_BAR; PG8_MMA(0, 0, At, B0); PG8_MMA(0, 1, At, B1); PG8_BAR; PG8_SCHED;
            PG8_LDA(At, 0, 1); PG8_STAGE(PG8_SB(0, 0), b2, voffB); PG8_STAGE(PG8_SB(0, 1), b2 + hstep, voffB); PG8_STAGE(PG8_SA(0, 0), a2, voffA);
            PG8_WAIT_V(8); PG8_WAIT_L(0); PG8_BAR; PG8_MMA(1, 0, At, B0); PG8_MMA(1, 1, At, B1); PG8_BAR; PG8_SCHED;
            PG8_LDB(B0, 1, 0); PG8_LDB(B1, 1, 1); PG8_SCHED; PG8_LDA(At, 1, 0); PG8_STAGE(PG8_SA(0, 1), a2 + hstep, voffA);
            PG8_WAIT_V(8); PG8_WAIT_L(0); PG8_BAR; PG8_MMA(0, 0, At, B0); PG8_MMA(0, 1, At, B1); PG8_BAR; PG8_SCHED;
            PG8_LDA(At, 1, 1); PG8_STAGE(PG8_SB(1, 0), b3, voffB); PG8_STAGE(PG8_SB(1, 1), b3 + hstep, voffB); PG8_STAGE(PG8_SA(1, 0), a3, voffA);
            PG8_WAIT_V(8); PG8_WAIT_L(0); PG8_BAR; PG8_MMA(1, 0, At, B0); PG8_MMA(1, 1, At, B1); PG8_BAR; PG8_SCHED;
            } else {
            PG8_LDB(B0, 0, 0); PG8_SCHED; PG8_LDA(At, 0, 0); PG8_STAGE(PG8_SA(1, 1), a1 + hstep, voffA);
            PG8_WAIT_L(8); PG8_BAR; PG8_WAIT_L(0); PG8_MMA(0, 0, At, B0); PG8_BAR; PG8_SCHED;
            PG8_LDB(B1, 0, 1); PG8_STAGE(PG8_SB(0, 0), b2, voffB);
            PG8_BAR; PG8_WAIT_L(0); PG8_MMA(0, 1, At, B1); PG8_BAR;
            PG8_LDA(At, 0, 1); PG8_STAGE(PG8_SA(0, 0), a2, voffA);
            PG8_BAR; PG8_WAIT_L(0); PG8_MMA(1, 0, At, B0); PG8_BAR; PG8_SCHED;
            PG8_STAGE(PG8_SB(0, 1), b2 + hstep, voffB);
            PG8_WAIT_V(6); PG8_BAR; PG8_MMA(1, 1, At, B1); PG8_BAR;
            PG8_LDB(B0, 1, 0); PG8_SCHED; PG8_LDA(At, 1, 0); PG8_STAGE(PG8_SA(0, 1), a2 + hstep, voffA);
            PG8_WAIT_L(8); PG8_BAR; PG8_WAIT_L(0); PG8_MMA(0, 0, At, B0); PG8_BAR; PG8_SCHED;
            PG8_LDB(B1, 1, 1); PG8_STAGE(PG8_SB(1, 0), b3, voffB);
            PG8_BAR; PG8_WAIT_L(0); PG8_MMA(0, 1, At, B1); PG8_BAR;
            PG8_LDA(At, 1, 1); PG8_STAGE(PG8_SA(1, 0), a3, voffA);
            PG8_BAR; PG8_WAIT_L(0); PG8_MMA(1, 0, At, B0); PG8_BAR; PG8_SCHED;
            PG8_STAGE(PG8_SB(1, 1), b3 + hstep, voffB);
            PG8_WAIT_V(6); PG8_BAR; PG8_MMA(1, 1, At, B1); PG8_BAR;
            }
        }
        if constexpr (ALIGN_EPI) { if (wr == 0) PG8_BAR; }
        if constexpr (!Epi::AFTER_DRAIN) { E(acc, cur, wr, wc, fr, fq); S.done(cur); }
        if (!has_next) break;
#pragma unroll
        for (int a = 0; a < 2; ++a)
#pragma unroll
            for (int b = 0; b < 2; ++b)
#pragma unroll
                for (int m = 0; m < 4; ++m)
#pragma unroll
                    for (int n = 0; n < 2; ++n) acc[a][b][m][n] = (f32x4){0.f, 0.f, 0.f, 0.f};
        cur = nxt; cA = nA; cB = nB; ++ui;
        if constexpr (ALIGN_EPI) { if (wr == 1) PG8_BAR; }
    }
    PG8_WAIT_V(0);
    if constexpr (!ALIGN_EPI) { if (wr == 0) PG8_BAR; }
    PG8_BAR;
    if constexpr (Epi::AFTER_DRAIN) { E.fused(acc, cur, wr, wc, fr, fq, lds, wid, lane); S.done(cur); }
#undef PG8_SA
#undef PG8_SB
#undef PG8_STAGE
#undef PG8_LDA
#undef PG8_LDB
#undef PG8_MMA
#undef PG8_WAIT_V
#undef PG8_WAIT_L
#undef PG8_BAR
#undef PG8_SCHED
}
}

constexpr int NWAVES = 8;
constexpr int M = 16384, D = 2048, FF = 5632, SEQ = 2048, DEPTH = 4;
constexpr int NIN_PAD = 18432;
constexpr float NORM_EPS = 1e-6f;
#ifndef MK_PER_PHASE
#define MK_PER_PHASE 0
#endif
constexpr int PH_PER_LAYER = 13, N_PHASES = DEPTH * PH_PER_LAYER + 1;

constexpr size_t MiB = 1u << 20;
constexpr size_t WS_CTL = 0, CTL_ZERO_BYTES = 1 * MiB;
constexpr size_t WS_WB = 1 * MiB;
constexpr size_t W_GU1 = 0, W_D1 = 23068672, W_IN = 34603008, W_PA = 72351744, W_PB = 73400320, W_PC = 75497472, W_WO = 77594624, W_GU2 = 81788928, W_D2 = 104857600;
constexpr size_t WS_H = 223 * MiB;
constexpr size_t WS_CA = 287 * MiB, WS_CB = 431 * MiB, WS_CC = 559 * MiB, WS_CG = 671 * MiB;
constexpr size_t WS_ACT = WS_CA;
constexpr size_t WS_QR = 863 * MiB, WS_KR = 895 * MiB, WS_KT = 927 * MiB, WS_VT = 959 * MiB;
constexpr size_t WS_FR = 991 * MiB, WS_UF = 1095 * MiB, WS_GSC = 1865 * MiB, WS_GO = 1160 * MiB;
constexpr size_t WS_MT = 863 * MiB;
constexpr size_t WS_RSO = 1224 * MiB, WS_RO = 1520 * MiB, WS_VS = 1584 * MiB, WS_GS = 1616 * MiB, WS_BON = 1648 * MiB, WS_LW = 1649 * MiB;
constexpr size_t WS_SCR = 1672 * MiB;
constexpr size_t WS_YA = 1672 * MiB, WS_YB = 1688 * MiB, WS_YC = 1720 * MiB;
constexpr size_t WS_MB = 1752 * MiB;
constexpr size_t WS_OG = 1816 * MiB, WS_LSE = 1864 * MiB;
constexpr size_t WS_BON2 = 1867 * MiB;
constexpr size_t WS_END = 1869 * MiB;
constexpr int CW_BAR = 4096, CW_ATT = 16384;

constexpr int RING_OFF = 0, RING_BYTES = 131072;
constexpr int LDSCTL_OFF = RING_BYTES, MISC_OFF = LDSCTL_OFF + 320;
constexpr int LDS_BYTES = 147456;

#define GAS __attribute__((address_space(1)))
#define LAS __attribute__((address_space(3)))
typedef unsigned short bf16;
typedef unsigned v4u __attribute__((ext_vector_type(4)));
typedef unsigned v2u __attribute__((ext_vector_type(2)));
typedef float f32x4 __attribute__((ext_vector_type(4)));
typedef float f32x2 __attribute__((ext_vector_type(2)));
typedef float f32x16 __attribute__((ext_vector_type(16)));
#define LDS_WAIT() asm volatile("s_waitcnt lgkmcnt(0)" ::: "memory")
#define WAVE_SYNC() do { asm volatile("s_waitcnt lgkmcnt(0)" ::: "memory"); __builtin_amdgcn_wave_barrier(); asm volatile("" ::: "memory"); } while (0)
using pg8::cvt_pk_bf16; using pg8::bf_lo; using pg8::bf_hi; using pg8::sigmoid_f; using pg8::silu_f;

__device__ __forceinline__ float wave_sum(float v) {
#pragma unroll
    for (int o = 1; o < 64; o <<= 1) v += __shfl_xor(v, o);
    return v;
}
__device__ __forceinline__ float wave_max(float v) {
#pragma unroll
    for (int o = 1; o < 64; o <<= 1) v = fmaxf(v, __shfl_xor(v, o));
    return v;
}
__device__ __forceinline__ float softplus_f(float x) { const float e = __expf(x); return x > 20.f ? x : (x < -10.f ? e : __logf(1.0f + e)); }

struct MapId { __device__ __forceinline__ int operator()(int n) const { return n; } };
struct MapGu { __device__ __forceinline__ int operator()(int n) const { return (n >> 8) * 128 + (n & 127) + ((n >> 7) & 1) * FF; } };
struct MapIn { __device__ __forceinline__ int operator()(int n) const {
    if (n < 8704) return n;
    if (n < 12224) return n + 16;
    if (n < 12240) return 8704 + (n - 12224);
    if (n < 12288) return -1;
    return n - 48; } };
template <class Map>
__device__ __forceinline__ void conv_matrix(const float* W, int K, int N, bf16* WT, int NP, Map map, LAS float* scr, int& rot, int gw, int NGW, int lane, int KP = 0, int pitch = 0) {
    if (KP == 0) KP = K;  if (pitch == 0) pitch = KP;
    const int nblk = NP / 32, nitems = (KP / 64) * nblk;
    int start = gw - rot; if (start < 0) start += NGW;
    for (int it = start; it < nitems; it += 2 * NGW) {
        const bool has2 = it + NGW < nitems;
        f32x16 wv[2][2]; int k0_[2], n0_[2], sc_[2];
#pragma unroll
        for (int u = 0; u < 2; ++u) { const int itu = (u == 1 && has2) ? it + NGW : it; const int kb = itu / nblk, nb = itu % nblk; k0_[u] = 64 * kb; n0_[u] = 32 * nb; sc_[u] = map(n0_[u] + (lane & 31));
            const float* wp = W + (sc_[u] >= 0 ? sc_[u] : 0);
#pragma unroll
            for (int i = 0; i < 32; ++i) { int kr = k0_[u] + 2 * i + (lane >> 5); kr = kr < K ? kr : K - 1; wv[u][i >> 4][i & 15] = wp[(size_t)kr * N]; } }
        asm volatile("" :: "v"(wv[0][0]), "v"(wv[0][1]), "v"(wv[1][0]), "v"(wv[1][1]) : "memory");
#pragma unroll
        for (int u = 0; u < 2; ++u) { if (u == 1 && !has2) break;
            const int k0 = k0_[u], n0 = n0_[u]; const bool cok = sc_[u] >= 0;
#pragma unroll
            for (int i = 0; i < 32; ++i) scr[(2 * i + (lane >> 5)) * 33 + (lane & 31)] = (cok && k0 + 2 * i + (lane >> 5) < K) ? wv[u][i >> 4][i & 15] : 0.f;
            LDS_WAIT(); asm volatile("" ::: "memory");
            const int c = lane & 7;
#pragma unroll
            for (int j = 0; j < 4; ++j) { const int n = (lane >> 3) + 8 * j; const LAS float* s = scr + (8 * c) * 33 + n;
                v4u o; o.x = cvt_pk_bf16(s[0 * 33], s[1 * 33]); o.y = cvt_pk_bf16(s[2 * 33], s[3 * 33]); o.z = cvt_pk_bf16(s[4 * 33], s[5 * 33]); o.w = cvt_pk_bf16(s[6 * 33], s[7 * 33]);
                *(v4u*)(WT + (size_t)(n0 + n) * pitch + k0 + 8 * c) = o; }
            LDS_WAIT(); asm volatile("" ::: "memory"); }
    }
    rot = (rot + nitems) % NGW;
}

__device__ __forceinline__ void norm_rows(const float* xs, float* xcopy, const float* gain, bf16* hout, int gw, int NGW, int lane) {
    f32x4 g[8];
#pragma unroll
    for (int j = 0; j < 8; ++j) g[j] = ((const f32x4*)gain)[lane + 64 * j];
    for (int m2 = gw * 2; m2 < M; m2 += NGW * 2) {
        f32x4 v[2][8]; float s[2] = {0.f, 0.f};
#pragma unroll
        for (int q = 0; q < 2; ++q) { const f32x4* xr = (const f32x4*)(xs + (size_t)(m2 + q) * D) + lane;
#pragma unroll
            for (int j = 0; j < 8; ++j) v[q][j] = xr[64 * j]; }
#pragma unroll
        for (int q = 0; q < 2; ++q) {
#pragma unroll
            for (int j = 0; j < 8; ++j) s[q] += (v[q][j].x * v[q][j].x + v[q][j].y * v[q][j].y) + (v[q][j].z * v[q][j].z + v[q][j].w * v[q][j].w);
            s[q] = wave_sum(s[q]); const float rs = 1.0f / sqrtf(s[q] * (1.0f / D) + NORM_EPS);
            if (xcopy) {
#pragma unroll
                for (int j = 0; j < 8; ++j) ((f32x4*)(xcopy + (size_t)(m2 + q) * D))[lane + 64 * j] = v[q][j]; }
            v2u* o8 = (v2u*)(hout + (size_t)(m2 + q) * D) + lane;
#pragma unroll
            for (int j = 0; j < 8; ++j) { v2u o; o.x = cvt_pk_bf16(v[q][j].x * rs * g[j].x, v[q][j].y * rs * g[j].y); o.y = cvt_pk_bf16(v[q][j].z * rs * g[j].z, v[q][j].w * rs * g[j].w); o8[64 * j] = o; } }
    }
}
__device__ __forceinline__ void final_norm_rows(float* x, const float* gain, int gw, int NGW, int lane) {
    f32x4 g[8];
#pragma unroll
    for (int j = 0; j < 8; ++j) g[j] = ((const f32x4*)gain)[lane + 64 * j];
    for (int m2 = gw * 2; m2 < M; m2 += NGW * 2) {
        f32x4 v[2][8];
#pragma unroll
        for (int q = 0; q < 2; ++q) { const f32x4* xr = (const f32x4*)(x + (size_t)(m2 + q) * D) + lane;
#pragma unroll
            for (int j = 0; j < 8; ++j) v[q][j] = xr[64 * j]; }
        asm volatile("" :: "v"(v[0][0]), "v"(v[0][1]), "v"(v[0][2]), "v"(v[0][3]), "v"(v[0][4]), "v"(v[0][5]), "v"(v[0][6]), "v"(v[0][7]), "v"(v[1][0]), "v"(v[1][1]), "v"(v[1][2]), "v"(v[1][3]), "v"(v[1][4]), "v"(v[1][5]), "v"(v[1][6]), "v"(v[1][7]) : "memory");
#pragma unroll
        for (int q = 0; q < 2; ++q) { float s = 0.f;
#pragma unroll
            for (int j = 0; j < 8; ++j) s += (v[q][j].x * v[q][j].x + v[q][j].y * v[q][j].y) + (v[q][j].z * v[q][j].z + v[q][j].w * v[q][j].w);
            s = wave_sum(s); const float rs = 1.0f / sqrtf(s * (1.0f / D) + NORM_EPS);
            f32x4* xw = (f32x4*)(x + (size_t)(m2 + q) * D) + lane;
#pragma unroll
            for (int j = 0; j < 8; ++j) xw[64 * j] = v[q][j] * rs * g[j]; }
    }
}

template <int CTRL> __device__ __forceinline__ float dppf(float x) { return __builtin_bit_cast(float, __builtin_amdgcn_update_dpp(0, __builtin_bit_cast(int, x), CTRL, 0xf, 0xf, false)); }
__device__ __forceinline__ void gdn_post(const bf16* GO, const bf16* cB, const float* norm_w, bf16* YB, int gtid, int nthr) {
    const int c8 = gtid & 127, j16 = c8 & 15;
    float nw[8];
#pragma unroll
    for (int e = 0; e < 8; ++e) nw[e] = norm_w[8 * j16 + e];
    for (int m4 = (gtid >> 7) * 4; m4 < M; m4 += (nthr >> 7) * 4) {
        v4u ow[4], zw[4];
#pragma unroll
        for (int j = 0; j < 4; ++j) { const size_t o = (size_t)(m4 + j) * 1024 + 8 * c8; ow[j] = *(const v4u*)(GO + o); zw[j] = *(const v4u*)(cB + (size_t)(m4 + j) * 4096 + 3072 + 8 * c8); }
        asm volatile("" :: "v"(ow[0]), "v"(ow[1]), "v"(ow[2]), "v"(ow[3]), "v"(zw[0]), "v"(zw[1]), "v"(zw[2]), "v"(zw[3]) : "memory");
        f32x4 oa[4], ob[4];
#pragma unroll
        for (int j = 0; j < 4; ++j) { oa[j] = (f32x4){bf_lo(ow[j].x), bf_hi(ow[j].x), bf_lo(ow[j].y), bf_hi(ow[j].y)}; ob[j] = (f32x4){bf_lo(ow[j].z), bf_hi(ow[j].z), bf_lo(ow[j].w), bf_hi(ow[j].w)}; }
#pragma unroll
        for (int j = 0; j < 4; ++j) {
            float ss = (oa[j].x * oa[j].x + oa[j].y * oa[j].y) + (oa[j].z * oa[j].z + oa[j].w * oa[j].w) + (ob[j].x * ob[j].x + ob[j].y * ob[j].y) + (ob[j].z * ob[j].z + ob[j].w * ob[j].w);
            ss += dppf<0xB1>(ss); ss += dppf<0x4E>(ss); ss += dppf<0x141>(ss); ss += dppf<0x140>(ss);
            const float rs = 1.0f / sqrtf(ss * (1.0f / 128.0f) + NORM_EPS);
            v4u w;
            w.x = cvt_pk_bf16(oa[j].x * rs * nw[0] * silu_f(bf_lo(zw[j].x)), oa[j].y * rs * nw[1] * silu_f(bf_hi(zw[j].x)));
            w.y = cvt_pk_bf16(oa[j].z * rs * nw[2] * silu_f(bf_lo(zw[j].y)), oa[j].w * rs * nw[3] * silu_f(bf_hi(zw[j].y)));
            w.z = cvt_pk_bf16(ob[j].x * rs * nw[4] * silu_f(bf_lo(zw[j].z)), ob[j].y * rs * nw[5] * silu_f(bf_hi(zw[j].z)));
            w.w = cvt_pk_bf16(ob[j].z * rs * nw[6] * silu_f(bf_lo(zw[j].w)), ob[j].w * rs * nw[7] * silu_f(bf_hi(zw[j].w)));
            *(v4u*)(YB + (size_t)(m4 + j) * 2560 + 8 * c8) = w; }
    }
}


typedef short bf16x8 __attribute__((ext_vector_type(8)));
typedef short s16x4 __attribute__((ext_vector_type(4)));
#define MFMA32(a, b, c) __builtin_amdgcn_mfma_f32_32x32x16_bf16((a), (b), (c), 0, 0, 0)
template <int S2> __device__ __forceinline__ bf16x8 pack8(const f32x16& v) {
    v4u w; w.x = cvt_pk_bf16(v[8 * S2 + 0], v[8 * S2 + 1]); w.y = cvt_pk_bf16(v[8 * S2 + 2], v[8 * S2 + 3]); w.z = cvt_pk_bf16(v[8 * S2 + 4], v[8 * S2 + 5]); w.w = cvt_pk_bf16(v[8 * S2 + 6], v[8 * S2 + 7]);
    return __builtin_bit_cast(bf16x8, w);
}
__device__ __forceinline__ f32x16 zero16() { f32x16 z;
#pragma unroll
    for (int i = 0; i < 16; ++i) { float t; asm volatile("v_mov_b32 %0, 0" : "=v"(t)); z[i] = t; } return z; }
__device__ __forceinline__ unsigned off_b(unsigned row, unsigned ch) { return 256u * row + 16u * (ch ^ (((row & 3u) << 2) | ((row >> 2) & 3u))); }

__device__ __forceinline__ void attn_phase(const bf16* cA, bf16* OG, float* LSE, LAS unsigned char* lds, int tid, int blk, int nblk) {
    const int lane = tid & 63, hf = tid >> 8, tl = tid & 255, wq = (tid >> 6) & 3, l31 = lane & 31, half = lane >> 5;
    LAS unsigned char* Ks = lds + hf * 65536; LAS unsigned char* Vs = Ks + 32768;
    const int blk16 = (lane >> 4) & 1, q4 = (lane & 15) >> 2, p4 = lane & 3;
    for (int pi0 = blk; pi0 < 768; pi0 += nblk) {
        const int pi = (nblk & 7) == 0 ? pi0 - blk + (blk & 7) * (nblk >> 3) + (blk >> 3) : pi0;
        const int unit = 2 * pi + hf, g = unit >> 9, rem = unit & 511;
        const int b = rem >> 6, slot = (rem >> 4) & 3;
        int res, qb, dil;
        if (g == 0) { res = 0; qb = rem & 15; dil = 1; } else if (g == 1) { res = (rem >> 2) & 3; qb = rem & 3; dil = 4; } else { res = rem & 15; qb = 0; dil = 16; }
        const int h = 4 * g + slot;
        const size_t rowstride = (size_t)dil * 4608;
        const bf16* base = cA + ((size_t)b * SEQ + res) * 4608 + h * 128;
        const int iq = 128 * qb + 32 * wq + l31;
        bf16x8 qf[8];
        { const bf16* qp = base + (size_t)iq * rowstride + 8 * half;
#pragma unroll
          for (int s = 0; s < 8; ++s) qf[s] = *(const bf16x8*)(qp + 16 * s); }
        f32x16 O[4];
#pragma unroll
        for (int c = 0; c < 4; ++c) O[c] = zero16();
        float mrun = -1e30f, lsum = 0.f;
        const float sc2 = 0.08838834764831845f * 1.4426950408889634f, sl2 = exp2f(-8.0f * (float)(h + 1) / 12.0f) * (float)dil * 1.4426950408889634f;
#pragma unroll 1
        for (int pslot = 0; pslot < 2; ++pslot) {
            const int pass = hf ? 1 - pslot : pslot;
            const int kb = qb - pass; const bool have = kb >= 0;
            if (have) {
                v4u kreg[8], vreg[8];
#pragma unroll
                for (int it = 0; it < 8; ++it) { const int n = tl + 256 * it, row = n >> 4, ch = n & 15; const bf16* src = base + (size_t)(128 * kb + row) * rowstride + 8 * ch;
                    kreg[it] = *(const v4u*)(src + 1536); vreg[it] = *(const v4u*)(src + 3072); }
#pragma unroll
                for (int it = 0; it < 8; ++it) { const int n = tl + 256 * it, row = n >> 4, ch = n & 15; const unsigned o = off_b(row, ch);
                    *(LAS v4u*)(Ks + o) = kreg[it]; *(LAS v4u*)(Vs + o) = vreg[it]; }
            }
            __syncthreads();
            if (have) {
#pragma unroll 1
                for (int kj = 0; kj < 4; ++kj) {
                    if (pass == 0 ? (kj > wq) : (kj < wq)) continue;
                    f32x16 acc = zero16();
#pragma unroll
                    for (int s = 0; s < 8; ++s) { const bf16x8 kf = *(const LAS bf16x8*)(Ks + off_b(32 * kj + l31, 2 * s + half)); acc = MFMA32(kf, qf[s], acc); }
                    const int d0 = (pass == 0 ? 0 : 128) + 32 * wq + l31 - 32 * kj - 4 * half;
                    float mloc = -1e30f, ps = 0.f, mnew, alpha;
                    const float cb = -sl2 * (float)d0;
                    if (kj == wq) {
#pragma unroll
                        for (int r = 0; r < 16; ++r) { const int kr = 8 * (r >> 2) + (r & 3); const bool valid = pass == 0 ? (kr <= d0) : (d0 - kr <= 128);
                            const float sv = valid ? __builtin_fmaf(acc[r], sc2, __builtin_fmaf(sl2, (float)kr, cb)) : -1e30f; acc[r] = sv; mloc = fmaxf(mloc, sv); }
                        mloc = fmaxf(mloc, __shfl_xor(mloc, 32));
                        mnew = fmaxf(mrun, mloc); alpha = __builtin_amdgcn_exp2f(mrun - mnew); mrun = mnew;
#pragma unroll
                        for (int r = 0; r < 16; ++r) { const float p = acc[r] > -1e29f ? __builtin_amdgcn_exp2f(acc[r] - mnew) : 0.f; acc[r] = p; ps += p; }
                    } else {
#pragma unroll
                        for (int r = 0; r < 16; ++r) { const float sv = __builtin_fmaf(acc[r], sc2, __builtin_fmaf(sl2, (float)(8 * (r >> 2) + (r & 3)), cb)); acc[r] = sv; mloc = fmaxf(mloc, sv); }
                        mloc = fmaxf(mloc, __shfl_xor(mloc, 32));
                        mnew = fmaxf(mrun, mloc); alpha = __builtin_amdgcn_exp2f(mrun - mnew); mrun = mnew;
#pragma unroll
                        for (int r = 0; r < 16; ++r) { const float p = __builtin_amdgcn_exp2f(acc[r] - mnew); acc[r] = p; ps += p; }
                    }
                    lsum = lsum * alpha + ps;
                    if (!__all(alpha == 1.0f)) {
#pragma unroll
                        for (int c = 0; c < 4; ++c)
#pragma unroll
                            for (int r = 0; r < 16; ++r) O[c][r] *= alpha; }
                    const bf16x8 pf0 = pack8<0>(acc), pf1 = pack8<1>(acc);
#pragma unroll
                    for (int s2 = 0; s2 < 2; ++s2)
#pragma unroll
                        for (int c = 0; c < 4; ++c) {
                            const unsigned rb0 = 32 * kj + 16 * s2 + 4 * half + q4, ch = 4 * c + 2 * blk16 + (p4 >> 1);
                            const s16x4 v0 = __builtin_amdgcn_ds_read_tr16_b64_v4i16((LAS s16x4*)(Vs + off_b(rb0, ch) + 8 * (p4 & 1)));
                            const s16x4 v1 = __builtin_amdgcn_ds_read_tr16_b64_v4i16((LAS s16x4*)(Vs + off_b(rb0 + 8, ch) + 8 * (p4 & 1)));
                            bf16x8 vf; vf[0] = v0[0]; vf[1] = v0[1]; vf[2] = v0[2]; vf[3] = v0[3]; vf[4] = v1[0]; vf[5] = v1[1]; vf[6] = v1[2]; vf[7] = v1[3];
                            O[c] = MFMA32(vf, s2 == 0 ? pf0 : pf1, O[c]);
                        }
                }
            }
            __syncthreads();
        }
        const float ltot = lsum + __shfl_xor(lsum, 32), inv = 1.0f / ltot;
        const size_t mq = (size_t)b * SEQ + res + (size_t)iq * dil;
        bf16* op = OG + ((size_t)g * M + mq) * 512 + slot * 128 + 4 * half;
#pragma unroll
        for (int c = 0; c < 4; ++c)
#pragma unroll
            for (int gi = 0; gi < 4; ++gi) { v2u w; w.x = cvt_pk_bf16(O[c][4 * gi] * inv, O[c][4 * gi + 1] * inv); w.y = cvt_pk_bf16(O[c][4 * gi + 2] * inv, O[c][4 * gi + 3] * inv);
                *(v2u*)(op + 32 * c + 8 * gi) = w; }
        if (half == 0) LSE[((size_t)g * M + mq) * 4 + slot] = mrun * 0.6931471805599453f + __logf(ltot);
    }
}
__device__ __forceinline__ void attn_combine(const bf16* OG, const float* LSE, bf16* YA, int gtid, int nthr) {
    for (int it0 = gtid; it0 < M * 64; it0 += 4 * nthr) {
        float l[4][3]; v4u og[4][3];
#pragma unroll
        for (int u = 0; u < 4; ++u) { const int it = it0 + u * nthr, m = it >> 6, c8 = it & 63, slot = c8 >> 4;
#pragma unroll
            for (int g = 0; g < 3; ++g) { l[u][g] = LSE[((size_t)g * M + m) * 4 + slot]; og[u][g] = *(const v4u*)(OG + ((size_t)g * M + m) * 512 + 8 * c8); } }
        asm volatile("" :: "v"(l[0][0]), "v"(l[0][1]), "v"(l[0][2]), "v"(l[1][0]), "v"(l[1][1]), "v"(l[1][2]), "v"(l[2][0]), "v"(l[2][1]), "v"(l[2][2]), "v"(l[3][0]), "v"(l[3][1]), "v"(l[3][2]),
                     "v"(og[0][0]), "v"(og[0][1]), "v"(og[0][2]), "v"(og[1][0]), "v"(og[1][1]), "v"(og[1][2]), "v"(og[2][0]), "v"(og[2][1]), "v"(og[2][2]), "v"(og[3][0]), "v"(og[3][1]), "v"(og[3][2]) : "memory");
#pragma unroll
        for (int u = 0; u < 4; ++u) { const int it = it0 + u * nthr, m = it >> 6, c8 = it & 63;
            const float l0 = l[u][0], l1 = l[u][1], l2 = l[u][2];
            const float mx = fmaxf(l0, fmaxf(l1, l2)); float w0 = __expf(l0 - mx), w1 = __expf(l1 - mx), w2 = __expf(l2 - mx); const float inv = 1.0f / (w0 + w1 + w2); w0 *= inv; w1 *= inv; w2 *= inv;
            const v4u a = og[u][0], b = og[u][1], c = og[u][2];
            v4u o;
            o.x = cvt_pk_bf16(w0 * bf_lo(a.x) + w1 * bf_lo(b.x) + w2 * bf_lo(c.x), w0 * bf_hi(a.x) + w1 * bf_hi(b.x) + w2 * bf_hi(c.x));
            o.y = cvt_pk_bf16(w0 * bf_lo(a.y) + w1 * bf_lo(b.y) + w2 * bf_lo(c.y), w0 * bf_hi(a.y) + w1 * bf_hi(b.y) + w2 * bf_hi(c.y));
            o.z = cvt_pk_bf16(w0 * bf_lo(a.z) + w1 * bf_lo(b.z) + w2 * bf_lo(c.z), w0 * bf_hi(a.z) + w1 * bf_hi(b.z) + w2 * bf_hi(c.z));
            o.w = cvt_pk_bf16(w0 * bf_lo(a.w) + w1 * bf_lo(b.w) + w2 * bf_lo(c.w), w0 * bf_hi(a.w) + w1 * bf_hi(b.w) + w2 * bf_hi(c.w));
            *(v4u*)(YA + (size_t)m * 2560 + 8 * c8) = o; }
    }
}

constexpr int GFR_BYTES = 26 * 1024;
__device__ __forceinline__ void gdn_prep_unit(const bf16* cB, const bf16* cC, const float* convw, const float* a_log, const float* dt_bias,
                                              bf16* QR, bf16* KR, bf16* KT, bf16* VT, unsigned char* FR, float* UF, float* GSC, int unit, int lane, LAS unsigned char* wlb) {
    const int grp = unit >> 3, h = unit & 7, m0 = grp * 64, m = m0 + lane, t0 = m0 & (SEQ - 1), l31 = lane & 31, half = lane >> 5;
    LAS float* Lg = (LAS float*)wlb; LAS float* Lbr = Lg + 64; LAS float* Lrk = Lg + 128; LAS float* Lrq = Lg + 192; LAS float* Lb = Lg + 256; LAS float* Lt2 = Lg + 320;
    LAS float* Acol = Lg + 384;
    LAS float* Lss = Lg + 384;
    bf16x8 kfr[2][8], qfr[2][8];
    { LAS unsigned char* KSL = (LAS unsigned char*)(Lss + 256);
#pragma unroll
      for (int sc = 0; sc < 2; ++sc)
#pragma unroll
      for (int qk = 0; qk < 2; ++qk) {
        int lz = lane; asm volatile("" : "+v"(lz));
        { const int c16 = lz & 15, t8 = lz >> 4, col = qk * 1024 + h * 128 + 8 * c16, tb = 32 * sc + 8 * t8;
          f32x4 wa[4], wb[4];
#pragma unroll
          for (int j = 0; j < 4; ++j) { wa[j] = *(const f32x4*)(convw + j * 3072 + col); wb[j] = *(const f32x4*)(convw + j * 3072 + col + 4); }
          const bf16* rowp = cB + (size_t)(m0 + tb) * 4096 + col; const bool hasp = t0 + tb > 0;
          v4u xs[8], xp[3];
#pragma unroll
          for (int i = 0; i < 8; ++i) xs[i] = *(const v4u*)(rowp + (size_t)i * 4096);
#pragma unroll
          for (int i = 0; i < 3; ++i) xp[i] = *(const v4u*)(hasp ? rowp - (3 - i) * 4096 : rowp);
          asm volatile("" :: "v"(xs[0]), "v"(xs[1]), "v"(xs[2]), "v"(xs[3]), "v"(xs[4]), "v"(xs[5]), "v"(xs[6]), "v"(xs[7]), "v"(xp[0]), "v"(xp[1]), "v"(xp[2]) : "memory");
          const v4u zz = (v4u){0u, 0u, 0u, 0u}; v4u x0 = hasp ? xp[0] : zz, x1 = hasp ? xp[1] : zz, x2 = hasp ? xp[2] : zz;
          unsigned tbuf[8][4];
#pragma unroll
          for (int ii = 0; ii < 8; ++ii) { const v4u x3 = xs[ii];
              float y[8];
              y[0] = bf_lo(x0.x) * wa[0].x + bf_lo(x1.x) * wa[1].x + bf_lo(x2.x) * wa[2].x + bf_lo(x3.x) * wa[3].x; y[1] = bf_hi(x0.x) * wa[0].y + bf_hi(x1.x) * wa[1].y + bf_hi(x2.x) * wa[2].y + bf_hi(x3.x) * wa[3].y;
              y[2] = bf_lo(x0.y) * wa[0].z + bf_lo(x1.y) * wa[1].z + bf_lo(x2.y) * wa[2].z + bf_lo(x3.y) * wa[3].z; y[3] = bf_hi(x0.y) * wa[0].w + bf_hi(x1.y) * wa[1].w + bf_hi(x2.y) * wa[2].w + bf_hi(x3.y) * wa[3].w;
              y[4] = bf_lo(x0.z) * wb[0].x + bf_lo(x1.z) * wb[1].x + bf_lo(x2.z) * wb[2].x + bf_lo(x3.z) * wb[3].x; y[5] = bf_hi(x0.z) * wb[0].y + bf_hi(x1.z) * wb[1].y + bf_hi(x2.z) * wb[2].y + bf_hi(x3.z) * wb[3].y;
              y[6] = bf_lo(x0.w) * wb[0].z + bf_lo(x1.w) * wb[1].z + bf_lo(x2.w) * wb[2].z + bf_lo(x3.w) * wb[3].z; y[7] = bf_hi(x0.w) * wb[0].w + bf_hi(x1.w) * wb[1].w + bf_hi(x2.w) * wb[2].w + bf_hi(x3.w) * wb[3].w;
              x0 = x1; x1 = x2; x2 = x3;
              float ss = 0.f;
#pragma unroll
              for (int e = 0; e < 8; ++e) { y[e] = silu_f(y[e]); ss += y[e] * y[e]; }
              ss += dppf<0xB1>(ss); ss += dppf<0x4E>(ss); ss += dppf<0x141>(ss); ss += dppf<0x140>(ss);
              if (c16 == 0) Lss[qk * 64 + tb + ii] = ss;
              const unsigned w4[4] = {cvt_pk_bf16(y[0], y[1]), cvt_pk_bf16(y[2], y[3]), cvt_pk_bf16(y[4], y[5]), cvt_pk_bf16(y[6], y[7])};
              LAS unsigned char* dq = KSL + (((c16 >> 2) * 2 + ((c16 >> 1) & 1)) * 64 + 8 * t8 + ii) * 16 + 8 * (c16 & 1);
              *(LAS v2u*)dq = (v2u){w4[0], w4[1]}; *(LAS v2u*)(dq + 512) = (v2u){w4[2], w4[3]};
              if (qk == 0) { unsigned char* gq = FR + (size_t)(unit * 2 + sc) * GFR_BYTES + 8192 + (((c16 >> 2) * 2 + ((c16 >> 1) & 1)) * 64 + 8 * t8 + ii) * 16 + 8 * (c16 & 1);
                  *(v2u*)gq = (v2u){w4[0], w4[1]}; *(v2u*)(gq + 512) = (v2u){w4[2], w4[3]}; }
              if (qk == 1) {
#pragma unroll
              for (int e = 0; e < 8; ++e) { const unsigned hv = (e & 1) ? (w4[e >> 1] >> 16) : (w4[e >> 1] & 0xffffu); tbuf[e][ii >> 1] = (ii & 1) ? (tbuf[e][ii >> 1] | (hv << 16)) : hv; } } }
          if (qk == 1)
#pragma unroll
          for (int e = 0; e < 8; ++e) { unsigned char* dk = FR + (size_t)(unit * 2 + sc) * GFR_BYTES + 16384 + (((c16 >> 2) * 2 + (t8 >> 1)) * 64 + 8 * (c16 & 3) + e) * 16 + 8 * (t8 & 1);
              *(v2u*)dk = (v2u){tbuf[e][0], tbuf[e][1]}; *(v2u*)(dk + 512) = (v2u){tbuf[e][2], tbuf[e][3]}; } }
        WAVE_SYNC();
#pragma unroll
        for (int s = 0; s < 8; ++s) { const bf16x8 f = *(const LAS bf16x8*)(KSL + (s * 64 + lz) * 16); if (qk == 0) qfr[sc][s] = f; else kfr[sc][s] = f; }
        WAVE_SYNC();
      }
    }
    WAVE_SYNC();
    const float ssq = Lss[lane], ssk = Lss[64 + lane];
    WAVE_SYNC();
    const float rq = (1.0f / sqrtf(ssq + 1e-6f)) * 0.08838834764831845f, rk = 1.0f / sqrtf(ssk + 1e-6f);
    const float alpha = bf_lo((unsigned)cC[(size_t)m * 3584 + 3520 + h]), bl = bf_lo((unsigned)cC[(size_t)m * 3584 + 3528 + h]);
    const float ld = -__expf(a_log[h]) * softplus_f(alpha + dt_bias[h]), beta = sigmoid_f(bl);
    float g = ld;
#pragma unroll
    for (int d = 1; d < 32; d <<= 1) { const float yv = __shfl_up(g, d, 32); if (l31 >= d) g += yv; }
    const float glast = __shfl(g, lane | 31), eg = __expf(g);
    Lg[lane] = g; Lbr[lane] = beta * rk; Lrk[lane] = rk; Lrq[lane] = rq; Lb[lane] = beta; Lt2[lane] = beta * rk * eg;
    { int lq = lane; asm volatile("" : "+v"(lq)); GSC[(size_t)unit * 132 + lq] = rq * eg; GSC[(size_t)unit * 132 + 64 + lq] = rk * __expf(glast - g); }
    if (l31 == 31) GSC[(size_t)unit * 132 + 128 + half] = __expf(glast);
    WAVE_SYNC();
#pragma unroll
    for (int sc = 0; sc < 2; ++sc) {
        f32x16 X, XT;
        { X = zero16(); XT = zero16();
#pragma unroll
          for (int s = 0; s < 8; ++s) { X = MFMA32(kfr[sc][s], kfr[sc][s], X); XT = MFMA32(kfr[sc][s], qfr[sc][s], XT); } }
        const float gcol = Lg[32 * sc + l31], rkcol = Lrk[32 * sc + l31], rqcol = Lrq[32 * sc + l31];
        f32x16 AT;
#pragma unroll
        for (int gi = 0; gi < 4; ++gi) { const int r0 = 8 * gi + 4 * half; const f32x4 gr = *(const LAS f32x4*)(Lg + 32 * sc + r0), br = *(const LAS f32x4*)(Lbr + 32 * sc + r0), kr = *(const LAS f32x4*)(Lrk + 32 * sc + r0);
            f32x4 av;
#pragma unroll
            for (int e = 0; e < 4; ++e) { const int row = r0 + e; const float gre = gr[e];
                av[e] = row > l31 ? X[4 * gi + e] * br[e] * rkcol * __expf(fminf(gre - gcol, 0.f)) : 0.f;
                AT[4 * gi + e] = row <= l31 ? XT[4 * gi + e] * rqcol * kr[e] * __expf(fminf(gcol - gre, 0.f)) : 0.f; }
            *(LAS f32x4*)(Acol + sc * 1024 + l31 * 32 + r0) = av; }
        unsigned char* fr = FR + (size_t)(unit * 2 + sc) * GFR_BYTES;
        *(bf16x8*)(fr + 24576 + lane * 16) = pack8<0>(AT); *(bf16x8*)(fr + 25600 + lane * 16) = pack8<1>(AT);
    }
    WAVE_SYNC();
    float tr[32];
#pragma unroll
    for (int j = 0; j < 32; ++j) tr[j] = 0.f;
    tr[31] = l31 == 31 ? 1.f : 0.f;
    { const LAS float* Ac = Acol + half * 1024; int li = l31;
#pragma unroll
      for (int j = 30; j >= 0; --j) { asm volatile("" : "+v"(li));
          float a0 = li == j ? 1.f : 0.f, a1 = 0.f;
#pragma unroll
          for (int k4 = ((j + 1) & ~3); k4 < 32; k4 += 4) { const f32x4 a = *(const LAS f32x4*)(Ac + j * 32 + k4); a0 -= tr[k4] * a.x + tr[k4 + 2] * a.z; a1 -= tr[k4 + 1] * a.y + tr[k4 + 3] * a.w; }
          tr[j] = a0 + a1; asm volatile("" : "+v"(tr[j]) :: "memory"); } }
    WAVE_SYNC();
    LAS bf16* T1l = (LAS bf16*)Acol; LAS bf16* T2l = T1l + 64 * 32;
    {
#pragma unroll
      for (int j8 = 0; j8 < 4; ++j8) { v4u o1, o2; float a[8], c[8];
#pragma unroll
          for (int q = 0; q < 2; ++q) { const f32x4 bb = *(const LAS f32x4*)(Lb + 32 * half + 8 * j8 + 4 * q), tt = *(const LAS f32x4*)(Lt2 + 32 * half + 8 * j8 + 4 * q);
#pragma unroll
              for (int e = 0; e < 4; ++e) { a[4 * q + e] = tr[8 * j8 + 4 * q + e] * bb[e]; c[4 * q + e] = tr[8 * j8 + 4 * q + e] * tt[e]; } }
          o1.x = cvt_pk_bf16(a[0], a[1]); o1.y = cvt_pk_bf16(a[2], a[3]); o1.z = cvt_pk_bf16(a[4], a[5]); o1.w = cvt_pk_bf16(a[6], a[7]);
          o2.x = cvt_pk_bf16(c[0], c[1]); o2.y = cvt_pk_bf16(c[2], c[3]); o2.z = cvt_pk_bf16(c[4], c[5]); o2.w = cvt_pk_bf16(c[6], c[7]);
          *(LAS v4u*)(T1l + lane * 32 + 8 * j8) = o1; *(LAS v4u*)(T2l + lane * 32 + 8 * j8) = o2; } }
    WAVE_SYNC();
    asm volatile("s_waitcnt vmcnt(0)" ::: "memory");
    bf16x8 t1f[2][2], t2p[2][2];
#pragma unroll
    for (int sc = 0; sc < 2; ++sc) { const LAS bf16* T1r = T1l + (32 * sc + l31) * 32; const LAS bf16* T2r = T2l + (32 * sc + l31) * 32;
        t1f[sc][0] = *(const LAS bf16x8*)(T1r + 8 * half); t1f[sc][1] = *(const LAS bf16x8*)(T1r + 16 + 8 * half);
#pragma unroll
        for (int s2 = 0; s2 < 2; ++s2) { const v2u ta = *(const LAS v2u*)(T2r + 16 * s2 + 4 * half), tb = *(const LAS v2u*)(T2r + 16 * s2 + 8 + 4 * half); t2p[sc][s2] = __builtin_bit_cast(bf16x8, (v4u){ta.x, ta.y, tb.x, tb.y}); } }
    WAVE_SYNC();
    LAS unsigned char* VTL = (LAS unsigned char*)Acol;
#pragma unroll
    for (int sc = 0; sc < 2; ++sc) {
        unsigned char* fr = FR + (size_t)(unit * 2 + sc) * GFR_BYTES;
        unsigned char* uf = (unsigned char*)UF + (size_t)(unit * 2 + sc) * 8192;
        bf16x8 kF[4][2];
#pragma unroll
        for (int c = 0; c < 4; ++c) { kF[c][0] = *(const bf16x8*)(fr + 16384 + ((c * 2 + 0) * 64 + lane) * 16); kF[c][1] = *(const bf16x8*)(fr + 16384 + ((c * 2 + 1) * 64 + lane) * 16); }
        { const int c16 = lane & 15, t8 = lane >> 4, col = 2 * 1024 + h * 128 + 8 * c16, tb = 32 * sc + 8 * t8;
          f32x4 wa[4], wb[4];
#pragma unroll
          for (int j = 0; j < 4; ++j) { wa[j] = *(const f32x4*)(convw + j * 3072 + col); wb[j] = *(const f32x4*)(convw + j * 3072 + col + 4); }
          const bf16* rowp = cB + (size_t)(m0 + tb) * 4096 + col; const bool hasp = t0 + tb > 0;
          v4u xs[8], xp[3];
#pragma unroll
          for (int i = 0; i < 8; ++i) xs[i] = *(const v4u*)(rowp + (size_t)i * 4096);
#pragma unroll
          for (int i = 0; i < 3; ++i) xp[i] = *(const v4u*)(hasp ? rowp - (3 - i) * 4096 : rowp);
          asm volatile("" :: "v"(xs[0]), "v"(xs[1]), "v"(xs[2]), "v"(xs[3]), "v"(xs[4]), "v"(xs[5]), "v"(xs[6]), "v"(xs[7]), "v"(xp[0]), "v"(xp[1]), "v"(xp[2]) : "memory");
          const v4u zz = (v4u){0u, 0u, 0u, 0u}; v4u x0 = hasp ? xp[0] : zz, x1 = hasp ? xp[1] : zz, x2 = hasp ? xp[2] : zz;
          unsigned tbuf[8][4];
#pragma unroll
          for (int ii = 0; ii < 8; ++ii) { const v4u x3 = xs[ii];
              float y[8];
              y[0] = bf_lo(x0.x) * wa[0].x + bf_lo(x1.x) * wa[1].x + bf_lo(x2.x) * wa[2].x + bf_lo(x3.x) * wa[3].x; y[1] = bf_hi(x0.x) * wa[0].y + bf_hi(x1.x) * wa[1].y + bf_hi(x2.x) * wa[2].y + bf_hi(x3.x) * wa[3].y;
              y[2] = bf_lo(x0.y) * wa[0].z + bf_lo(x1.y) * wa[1].z + bf_lo(x2.y) * wa[2].z + bf_lo(x3.y) * wa[3].z; y[3] = bf_hi(x0.y) * wa[0].w + bf_hi(x1.y) * wa[1].w + bf_hi(x2.y) * wa[2].w + bf_hi(x3.y) * wa[3].w;
              y[4] = bf_lo(x0.z) * wb[0].x + bf_lo(x1.z) * wb[1].x + bf_lo(x2.z) * wb[2].x + bf_lo(x3.z) * wb[3].x; y[5] = bf_hi(x0.z) * wb[0].y + bf_hi(x1.z) * wb[1].y + bf_hi(x2.z) * wb[2].y + bf_hi(x3.z) * wb[3].y;
              y[6] = bf_lo(x0.w) * wb[0].z + bf_lo(x1.w) * wb[1].z + bf_lo(x2.w) * wb[2].z + bf_lo(x3.w) * wb[3].z; y[7] = bf_hi(x0.w) * wb[0].w + bf_hi(x1.w) * wb[1].w + bf_hi(x2.w) * wb[2].w + bf_hi(x3.w) * wb[3].w;
              x0 = x1; x1 = x2; x2 = x3;
#pragma unroll
              for (int e = 0; e < 8; ++e) y[e] = silu_f(y[e]);
              const unsigned w4[4] = {cvt_pk_bf16(y[0], y[1]), cvt_pk_bf16(y[2], y[3]), cvt_pk_bf16(y[4], y[5]), cvt_pk_bf16(y[6], y[7])};
#pragma unroll
              for (int e = 0; e < 8; ++e) { const unsigned hv = (e & 1) ? (w4[e >> 1] >> 16) : (w4[e >> 1] & 0xffffu); tbuf[e][ii >> 1] = (ii & 1) ? (tbuf[e][ii >> 1] | (hv << 16)) : hv; } }
#pragma unroll
          for (int e = 0; e < 8; ++e) *(LAS v4u*)(VTL + (8 * c16 + e) * 64 + 16 * t8) = (v4u){tbuf[e][0], tbuf[e][1], tbuf[e][2], tbuf[e][3]}; }
        WAVE_SYNC();
        bf16x8 vF[4][2];
#pragma unroll
        for (int c = 0; c < 4; ++c) { vF[c][0] = *(const LAS bf16x8*)(VTL + (32 * c + l31) * 64 + 16 * half); vF[c][1] = *(const LAS bf16x8*)(VTL + (32 * c + l31) * 64 + 32 + 16 * half); }
#pragma unroll
        for (int c = 0; c < 4; ++c) {
            f32x16 U = zero16(); U = MFMA32(t1f[sc][0], vF[c][0], U); U = MFMA32(t1f[sc][1], vF[c][1], U);
            *(bf16x8*)(uf + c * 2048 + lane * 32) = pack8<0>(U); *(bf16x8*)(uf + c * 2048 + lane * 32 + 16) = pack8<1>(U);
            f32x16 WT = zero16(); WT = MFMA32(kF[c][0], t2p[sc][0], WT); WT = MFMA32(kF[c][1], t2p[sc][1], WT);
#pragma unroll
            for (int r = 0; r < 16; ++r) WT[r] = -WT[r];
            *(bf16x8*)(fr + ((c * 2 + 0) * 64 + lane) * 16) = pack8<0>(WT); *(bf16x8*)(fr + ((c * 2 + 1) * 64 + lane) * 16) = pack8<1>(WT);
        }
        WAVE_SYNC();
    }
}
constexpr int GSLOT = GFR_BYTES + 512;
__device__ __forceinline__ void gdn_scan_blk(const unsigned char* FR, const float* UF, const float* GSC, bf16* GO, int bh, int tid, LAS unsigned char* lds) {
    const int b = bh >> 3, h = bh & 7, wave = tid >> 6, lane = tid & 63, l31 = lane & 31, half = lane >> 5, ltid = tid - 256;
    f32x16 S[4]; v4u Un0 = (v4u){0u, 0u, 0u, 0u}, Un1 = Un0;
#pragma unroll
    for (int kt = 0; kt < 4; ++kt) S[kt] = zero16();
    const int grp0 = (b * SEQ) >> 6;

    if (wave >= 4) {
#pragma unroll
        for (int c0 = 0; c0 < 2; ++c0) { const unsigned char* src = FR + (size_t)((grp0 * 8 + h) * 2 + c0) * GFR_BYTES; LAS unsigned char* dst = lds + c0 * GSLOT;
#pragma unroll
            for (int i = 0; i < 7; ++i) { const int idx = ltid + 256 * i; if (idx < 1664) *(LAS v4u*)(dst + idx * 16) = *(const v4u*)(src + (size_t)idx * 16); }
            const float* sc = GSC + (size_t)(grp0 * 8 + h) * 132;
            if (ltid < 16) *(LAS v4u*)(dst + GFR_BYTES + ltid * 16) = *(const v4u*)(sc + (ltid < 8 ? 32 * c0 + 4 * ltid : 64 + 32 * c0 + 4 * (ltid - 8)));
            else if (ltid == 16) *(LAS float*)(dst + GFR_BYTES + 256) = sc[128 + c0]; }
    } else {
        const int unit0 = grp0 * 8 + h;
        const unsigned char* up = (const unsigned char*)UF + ((size_t)(unit0 * 2) * 4 + wave) * 2048 + lane * 32;
        Un0 = *(const v4u*)up; Un1 = *(const v4u*)(up + 16);

    }
#pragma unroll 1
    for (int c = 0; c < 64; ++c) {
        __syncthreads();
        if (wave >= 4) {
            if (c + 2 < 64) { const int un = (grp0 + ((c + 2) >> 1)) * 8 + h, cc = (c + 2) & 1; const unsigned char* src = FR + (size_t)(un * 2 + cc) * GFR_BYTES; LAS unsigned char* dst = lds + ((c + 2) % 3) * GSLOT;
                v4u tmp[7], tsc = (v4u){0u, 0u, 0u, 0u}; float tcd = 0.f; const float* sc = GSC + (size_t)un * 132;
#pragma unroll
                for (int i = 0; i < 7; ++i) { const int idx = ltid + 256 * i; tmp[i] = idx < 1664 ? *(const v4u*)(src + (size_t)idx * 16) : (v4u){0u, 0u, 0u, 0u}; }
                if (ltid < 16) tsc = *(const v4u*)(sc + (ltid < 8 ? 32 * cc + 4 * ltid : 64 + 32 * cc + 4 * (ltid - 8)));
                else if (ltid == 16) tcd = sc[128 + cc];
#pragma unroll
                for (int i = 0; i < 7; ++i) { const int idx = ltid + 256 * i; if (idx < 1664) *(LAS v4u*)(dst + idx * 16) = tmp[i]; }
                if (ltid < 16) *(LAS v4u*)(dst + GFR_BYTES + ltid * 16) = tsc;
                else if (ltid == 16) *(LAS float*)(dst + GFR_BYTES + 256) = tcd; }
        } else {
            const LAS unsigned char* buf = lds + (c % 3) * GSLOT;
            f32x16 VN; f32x4 qsv[4], ksv[4];
            { const v4u a = Un0, b = Un1; VN[0] = bf_lo(a.x); VN[1] = bf_hi(a.x); VN[2] = bf_lo(a.y); VN[3] = bf_hi(a.y); VN[4] = bf_lo(a.z); VN[5] = bf_hi(a.z); VN[6] = bf_lo(a.w); VN[7] = bf_hi(a.w);
              VN[8] = bf_lo(b.x); VN[9] = bf_hi(b.x); VN[10] = bf_lo(b.y); VN[11] = bf_hi(b.y); VN[12] = bf_lo(b.z); VN[13] = bf_hi(b.z); VN[14] = bf_lo(b.w); VN[15] = bf_hi(b.w); }
            const LAS float* scq = (const LAS float*)(buf + GFR_BYTES);
#pragma unroll
            for (int gi = 0; gi < 4; ++gi) { qsv[gi] = *(const LAS f32x4*)(scq + 8 * gi + 4 * half); ksv[gi] = *(const LAS f32x4*)(scq + 32 + 8 * gi + 4 * half); }
            const float cd = scq[64];
            if (c + 1 < 64) { const int un = (grp0 + ((c + 1) >> 1)) * 8 + h; const unsigned char* up = (const unsigned char*)UF + ((size_t)(un * 2 + ((c + 1) & 1)) * 4 + wave) * 2048 + lane * 32;
                Un0 = *(const v4u*)up; Un1 = *(const v4u*)(up + 16); }
            bf16x8 Sf[4][2];
#pragma unroll
            for (int kt = 0; kt < 4; ++kt) { Sf[kt][0] = pack8<0>(S[kt]); Sf[kt][1] = pack8<1>(S[kt]); }
            f32x16 O1 = zero16();
#pragma unroll
            for (int kt = 0; kt < 4; ++kt)
#pragma unroll
                for (int s2 = 0; s2 < 2; ++s2) { VN = MFMA32(*(const LAS bf16x8*)(buf + ((kt * 2 + s2) * 64 + lane) * 16), Sf[kt][s2], VN);
                                                O1 = MFMA32(*(const LAS bf16x8*)(buf + 8192 + ((kt * 2 + s2) * 64 + lane) * 16), Sf[kt][s2], O1); }
            const bf16x8 vf0 = pack8<0>(VN), vf1 = pack8<1>(VN);
            f32x16 O2 = zero16();
            O2 = MFMA32(*(const LAS bf16x8*)(buf + 24576 + lane * 16), vf0, O2); O2 = MFMA32(*(const LAS bf16x8*)(buf + 25600 + lane * 16), vf1, O2);
            bf16* op = GO + ((size_t)b * SEQ + 32 * c) * 1024 + h * 128 + 32 * wave + l31;
#pragma unroll
            for (int r = 0; r < 16; r += 2) { const int tok = 8 * (r >> 2) + 4 * half + (r & 3); const unsigned w = cvt_pk_bf16(qsv[r >> 2][r & 3] * O1[r] + O2[r], qsv[r >> 2][(r & 3) + 1] * O1[r + 1] + O2[r + 1]);
                op[(size_t)tok * 1024] = (bf16)(w & 0xffffu); op[(size_t)(tok + 1) * 1024] = (bf16)(w >> 16); }
            f32x16 VS;
#pragma unroll
            for (int r = 0; r < 16; ++r) VS[r] = VN[r] * ksv[r >> 2][r & 3];
            const bf16x8 vs0 = pack8<0>(VS), vs1 = pack8<1>(VS);
#pragma unroll
            for (int kt = 0; kt < 4; ++kt) {
#pragma unroll
                for (int r = 0; r < 16; ++r) S[kt][r] *= cd;
                S[kt] = MFMA32(*(const LAS bf16x8*)(buf + 16384 + ((kt * 2 + 0) * 64 + lane) * 16), vs0, S[kt]);
                S[kt] = MFMA32(*(const LAS bf16x8*)(buf + 16384 + ((kt * 2 + 1) * 64 + lane) * 16), vs1, S[kt]); }
        }
    }
    __syncthreads();
}

template <int CTRL> __device__ __forceinline__ float dpp_f(float x) { return __builtin_bit_cast(float, __builtin_amdgcn_update_dpp(0, __builtin_bit_cast(int, x), CTRL, 0xf, 0xf, false)); }
__device__ __forceinline__ float sum32(float x) {
#ifdef SAFE_SUM
    x += __shfl_xor(x, 1); x += __shfl_xor(x, 2); x += __shfl_xor(x, 4); x += __shfl_xor(x, 8); x += __shfl_xor(x, 16); return x; }
#else
    x += dpp_f<0xB1>(x); x += dpp_f<0x4E>(x); x += dpp_f<0x141>(x); x += dpp_f<0x140>(x); x += __shfl_xor(x, 16); return x; }
#endif
__device__ __forceinline__ v2u pack4(float a, float b, float c, float d) { v2u w; w.x = cvt_pk_bf16(a, b); w.y = cvt_pk_bf16(c, d); return w; }
__device__ __forceinline__ bf16x8 ld2x8(const bf16* p) { const v2u a = *(const v2u*)p, b = *(const v2u*)(p + 8); return __builtin_bit_cast(bf16x8, (v4u){a.x, a.y, b.x, b.y}); }
__device__ __forceinline__ f32x16 ld_tile(const float* p) { f32x16 t;
#pragma unroll
    for (int q = 0; q < 4; ++q) { const f32x4 u = *(const f32x4*)(p + 4 * q); t[4 * q] = u.x; t[4 * q + 1] = u.y; t[4 * q + 2] = u.z; t[4 * q + 3] = u.w; } return t; }
__device__ __forceinline__ f32x16 unpack_tile(const v4u a, const v4u b) { f32x16 t;
    t[0] = bf_lo(a.x); t[1] = bf_hi(a.x); t[2] = bf_lo(a.y); t[3] = bf_hi(a.y); t[4] = bf_lo(a.z); t[5] = bf_hi(a.z); t[6] = bf_lo(a.w); t[7] = bf_hi(a.w);
    t[8] = bf_lo(b.x); t[9] = bf_hi(b.x); t[10] = bf_lo(b.y); t[11] = bf_hi(b.y); t[12] = bf_lo(b.z); t[13] = bf_hi(b.z); t[14] = bf_lo(b.w); t[15] = bf_hi(b.w); return t; }
__device__ __forceinline__ void st_tile(float* p, const f32x16& t) {
#pragma unroll
    for (int q = 0; q < 4; ++q) *(f32x4*)(p + 4 * q) = (f32x4){t[4 * q], t[4 * q + 1], t[4 * q + 2], t[4 * q + 3]}; }
__device__ __forceinline__ float ldbf(const void* base, unsigned off) { return bf_lo((unsigned)*(const bf16*)((const char*)base + off)); }
__device__ __forceinline__ void stbf(void* base, unsigned off, float v) { *(bf16*)((char*)base + off) = (bf16)(cvt_pk_bf16(v, 0.f) & 0xffffu); }
#ifdef SAFE_SUM
#define RW_SYNC() do { asm volatile("s_waitcnt vmcnt(0) lgkmcnt(0)" ::: "memory"); __builtin_amdgcn_fence(__ATOMIC_ACQUIRE, "agent"); asm volatile("s_waitcnt vmcnt(0) lgkmcnt(0)" ::: "memory"); __builtin_amdgcn_wave_barrier(); asm volatile("" ::: "memory"); } while (0)
#else
#define RW_SYNC() WAVE_SYNC()
#endif
__device__ __forceinline__ bf16x8 natf(const bf16* X, int kt, int s, int lane) { return *(const bf16x8*)(X + ((kt * 4 + s) * 64 + lane) * 8); }
__device__ __forceinline__ bf16x8 perf(const bf16* X, int kt, int s, int l31, int half) { const bf16* p = X + ((kt * 4 + s) * 64 + l31) * 8 + 4 * half; const v2u a = *(const v2u*)p, b = *(const v2u*)(p + 256); return __builtin_bit_cast(bf16x8, (v4u){a.x, a.y, b.x, b.y}); }
constexpr int NPARK = 4;
constexpr int RSO_BYTES = 24832;
constexpr int XL_PITCH = 912;
constexpr int RW_SCR = 72 * 1024;

template <bool ONLY_A>
__device__ __forceinline__ void lora_tiles(const LAS unsigned char* XL, const bf16* W2T, const bf16* A2T, const bf16* G2T, int sc, int cch, int l31, int half, f32x16& Wl, f32x16& Al, f32x16& Gl) {
    const LAS unsigned char* xr = XL + (32 * sc + l31) * XL_PITCH + 16 * half;
    Al = zero16();
#pragma unroll
    for (int s = 0; s < 6; ++s) Al = MFMA32(*(const LAS bf16x8*)(xr + 192 + 32 * s), *(const bf16x8*)(A2T + (size_t)cch * 128 + 16 * s + 8 * half), Al);
    if (!ONLY_A) {
        Wl = zero16(); Gl = zero16();
#pragma unroll
        for (int s = 0; s < 6; ++s) Wl = MFMA32(*(const LAS bf16x8*)(xr + 32 * s), *(const bf16x8*)(W2T + (size_t)cch * 128 + 16 * s + 8 * half), Wl);
#pragma unroll
        for (int s = 0; s < 16; ++s) Gl = MFMA32(*(const LAS bf16x8*)(xr + 384 + 32 * s), *(const bf16x8*)(G2T + (size_t)cch * 256 + 16 * s + 8 * half), Gl);
    }
}
__device__ __forceinline__ void rwkv_prep_blk(const bf16* cC, const float* mu, const float* w0, const float* a0, const float* k_k, const float* k_a, const float* r_k,
                                              const bf16* W2T, const bf16* A2T, const bf16* G2T, unsigned char* RSO, float* BON, bf16* GS, unsigned char* SCR,
                                              int grp, int tid, LAS unsigned char* lds) {
    const int m0 = grp * 64, b = m0 >> 11, t0 = m0 & (SEQ - 1);
    LAS unsigned char* XL = lds + 69632;
    if (tid < 448) { const int cg = tid % 56, tb = 8 * (tid / 56), cc = 3072 + 8 * cg; const bf16* rowp = cC + (size_t)(m0 + tb) * 3584 + cc; const bool hp0 = t0 + tb > 0;
        v4u xq[8], xp = *(const v4u*)(hp0 ? rowp - 3584 : rowp);
#pragma unroll
        for (int u = 0; u < 8; ++u) xq[u] = *(const v4u*)(rowp + (size_t)u * 3584);
        const f32x4 ma = *(const f32x4*)(mu + cc), mb = *(const f32x4*)(mu + cc + 4);
        asm volatile("" :: "v"(xq[0]), "v"(xq[1]), "v"(xq[2]), "v"(xq[3]), "v"(xq[4]), "v"(xq[5]), "v"(xq[6]), "v"(xq[7]), "v"(xp) : "memory");
        if (!hp0) xp = (v4u){0u, 0u, 0u, 0u};
#pragma unroll
        for (int u = 0; u < 8; ++u) { const v4u x = xq[u];
            float y[8];
            y[0] = bf_lo(x.x) + (bf_lo(xp.x) - bf_lo(x.x)) * ma.x; y[1] = bf_hi(x.x) + (bf_hi(xp.x) - bf_hi(x.x)) * ma.y; y[2] = bf_lo(x.y) + (bf_lo(xp.y) - bf_lo(x.y)) * ma.z; y[3] = bf_hi(x.y) + (bf_hi(xp.y) - bf_hi(x.y)) * ma.w;
            y[4] = bf_lo(x.z) + (bf_lo(xp.z) - bf_lo(x.z)) * mb.x; y[5] = bf_hi(x.z) + (bf_hi(xp.z) - bf_hi(x.z)) * mb.y; y[6] = bf_lo(x.w) + (bf_lo(xp.w) - bf_lo(x.w)) * mb.z; y[7] = bf_hi(x.w) + (bf_hi(xp.w) - bf_hi(x.w)) * mb.w;
            xp = x;
#pragma unroll
            for (int e = 0; e < 8; ++e) y[e] = cg < 12 ? tanhf(y[e]) : (cg < 24 ? y[e] : sigmoid_f(y[e]));
            v4u o; o.x = cvt_pk_bf16(y[0], y[1]); o.y = cvt_pk_bf16(y[2], y[3]); o.z = cvt_pk_bf16(y[4], y[5]); o.w = cvt_pk_bf16(y[6], y[7]);
            *(LAS v4u*)(XL + (tb + u) * XL_PITCH + 16 * cg) = o; } }
    { LAS float* RN = (LAS float*)(lds + 135168);
      asm volatile("" : "+v"(tid));
      const int kg = tid & 127; const f32x4 ma = *(const f32x4*)(mu + 1024 + 8 * kg), mb = *(const f32x4*)(mu + 1024 + 8 * kg + 4), ka = *(const f32x4*)(k_k + 8 * kg), kb = *(const f32x4*)(k_k + 8 * kg + 4);
      const int tk0 = 16 * (tid >> 7); const bf16* rowp = cC + (size_t)(m0 + tk0) * 3584 + 1024 + 8 * kg; const bool hp0 = t0 + tk0 > 0;
      v4u xp = *(const v4u*)(hp0 ? rowp - 3584 : rowp);
#pragma unroll
      for (int j8 = 0; j8 < 16; j8 += 8) { v4u xq[8];
#pragma unroll
        for (int u = 0; u < 8; ++u) xq[u] = *(const v4u*)(rowp + (size_t)(j8 + u) * 3584);
        asm volatile("" :: "v"(xq[0]), "v"(xq[1]), "v"(xq[2]), "v"(xq[3]), "v"(xq[4]), "v"(xq[5]), "v"(xq[6]), "v"(xq[7]), "v"(xp) : "memory");
        if (j8 == 0 && !hp0) xp = (v4u){0u, 0u, 0u, 0u};
#pragma unroll
        for (int u = 0; u < 8; ++u) { const int tok = tk0 + j8 + u;
          const v4u x = xq[u];
          float y[8];
          y[0] = (bf_lo(x.x) + (bf_lo(xp.x) - bf_lo(x.x)) * ma.x) * ka.x; y[1] = (bf_hi(x.x) + (bf_hi(xp.x) - bf_hi(x.x)) * ma.y) * ka.y; y[2] = (bf_lo(x.y) + (bf_lo(xp.y) - bf_lo(x.y)) * ma.z) * ka.z; y[3] = (bf_hi(x.y) + (bf_hi(xp.y) - bf_hi(x.y)) * ma.w) * ka.w;
          y[4] = (bf_lo(x.z) + (bf_lo(xp.z) - bf_lo(x.z)) * mb.x) * kb.x; y[5] = (bf_hi(x.z) + (bf_hi(xp.z) - bf_hi(x.z)) * mb.y) * kb.y; y[6] = (bf_lo(x.w) + (bf_lo(xp.w) - bf_lo(x.w)) * mb.z) * kb.z; y[7] = (bf_hi(x.w) + (bf_hi(xp.w) - bf_hi(x.w)) * mb.w) * kb.w;
          xp = x;
          float ss = (y[0] * y[0] + y[1] * y[1]) + (y[2] * y[2] + y[3] * y[3]) + (y[4] * y[4] + y[5] * y[5]) + (y[6] * y[6] + y[7] * y[7]);
          ss += dpp_f<0xB1>(ss); ss += dpp_f<0x4E>(ss); ss += dpp_f<0x141>(ss);
          if ((kg & 7) == 0) RN[(kg >> 3) * 64 + tok] = 1.0f / sqrtf(ss + 1e-6f); } } }
    __syncthreads();
    int lane_ = tid & 63; const int wave = __builtin_amdgcn_readfirstlane(tid >> 6);
    LAS float* Acol = (LAS float*)(lds + wave * 8704);
    bf16* scr = (bf16*)(SCR + (size_t)(blockIdx.x * 8 + wave) * RW_SCR);
    bf16 *AR = scr, *BR = scr + 4096, *KRr = scr + 8192, *RRr = scr + 12288, *AT = scr + 16384, *BT = scr + 20480, *KTt = scr + 24576, *RT = scr + 28672, *VTt = scr + 32768;
    unsigned char* FS = (unsigned char*)(scr + 36864) - 0;
#pragma unroll 1
    for (int hh = 0; hh < 2; ++hh) {
        const int h = 2 * wave + hh;
#ifndef REP2
#define REP2 1
#endif
        for (int rp2_ = 0; rp2_ < REP2; ++rp2_)
#pragma unroll 1
        for (int sc = 0; sc < 2; ++sc) {
            asm volatile("" : "+v"(lane_)); const int l31 = lane_ & 31, half = lane_ >> 5;
            v2u pk[2][5][4];
            {
            unsigned char* rso = RSO + (size_t)((b * 16 + h) * 64 + (t0 >> 5) + sc) * RSO_BYTES;
#pragma unroll
            for (int ct = 0; ct < 2; ++ct) {
                const int c = h * 64 + 32 * ct + l31, cl = 32 * ct + l31;
                f32x16 Wl, Al;
                LAS unsigned char* WL = (LAS unsigned char*)Acol;
                v4u st[7];
#pragma unroll
                for (int t = 0; t < 7; ++t) { int item = t * 64 + lane_; item = item > 395 ? 395 : item; const int ar = item / 132, rem = item - ar * 132, row = rem >> 2, q = rem & 3;
                    int tk = 32 * sc + row - 1; tk = (t0 + tk < 0) ? 0 : tk;
                    st[t] = *(const v4u*)((const char*)cC + (unsigned)(m0 + tk) * 7168u + 2u * (unsigned)(ar * 1024 + h * 64 + 32 * ct + 8 * q)); }
                { bf16x8 gw[16];
#pragma unroll
                  for (int s = 0; s < 16; ++s) gw[s] = *(const bf16x8*)(G2T + (size_t)c * 256 + 16 * s + 8 * half);
                  asm volatile("" ::: "memory");
                  f32x16 Gl = zero16(); const LAS unsigned char* xg = XL + (32 * sc + l31) * XL_PITCH + 16 * half + 384;
#pragma unroll
                  for (int s = 0; s < 16; ++s) Gl = MFMA32(*(const LAS bf16x8*)(xg + 32 * s), gw[s], Gl);
#pragma unroll
                  for (int r = 0; r < 16; ++r) *(LAS bf16*)(WL + (8 * (r >> 2) + 4 * half + (r & 3)) * 80 + 2 * l31) = (bf16)(cvt_pk_bf16(Gl[r], 0.f) & 0xffffu);
                  WAVE_SYNC();
#pragma unroll
                  for (int u = 0; u < 2; ++u) { const int item = u * 64 + lane_, row = item >> 2, q = item & 3;
                      *(v4u*)((char*)GS + (unsigned)(m0 + 32 * sc + row) * 2048u + 2u * (unsigned)(h * 64 + 32 * ct + 8 * q)) = *(const LAS v4u*)(WL + row * 80 + 16 * q); }
                  WAVE_SYNC(); }
#pragma unroll
                for (int t = 0; t < 7; ++t) { const int item = t * 64 + lane_; const int ar = item / 132, rem = item - ar * 132, row = rem >> 2, q = rem & 3;
                    if (item < 396) *(LAS v4u*)(WL + ar * 2640 + row * 80 + 16 * q) = st[t]; }
                WAVE_SYNC();
                const float mur = mu[c], muk = mu[1024 + c], muv = mu[2048 + c], w0c = w0[c], a0c = a0[c], kkc = k_k[c], kac = k_a[c], rkc = r_k[c];
                { bf16x8 ww[6], aw[6];
#pragma unroll
                  for (int s = 0; s < 6; ++s) { ww[s] = *(const bf16x8*)(W2T + (size_t)c * 128 + 16 * s + 8 * half); aw[s] = *(const bf16x8*)(A2T + (size_t)c * 128 + 16 * s + 8 * half); }
                  asm volatile("" ::: "memory");
                  const LAS unsigned char* xr0 = XL + (32 * sc + l31) * XL_PITCH + 16 * half; Wl = zero16(); Al = zero16();
#pragma unroll
                  for (int s = 0; s < 6; ++s) { Wl = MFMA32(*(const LAS bf16x8*)(xr0 + 32 * s), ww[s], Wl); Al = MFMA32(*(const LAS bf16x8*)(xr0 + 192 + 32 * s), aw[s], Al); } }
                float lw[16], rr[16], kx[16];
#pragma unroll
                for (int gi = 0; gi < 4; ++gi) {
                    const int tok0 = 32 * sc + 8 * gi + 4 * half; const bool hp = t0 + tok0 > 0;
                    const LAS unsigned char* p0 = WL + (8 * gi + 4 * half) * 80 + 2 * l31;
                    float pr = hp ? bf_lo((unsigned)*(const LAS bf16*)p0) : 0.f, pkk = hp ? bf_lo((unsigned)*(const LAS bf16*)(p0 + 2640)) : 0.f, pv = hp ? bf_lo((unsigned)*(const LAS bf16*)(p0 + 5280)) : 0.f; float vv[4];
#pragma unroll
                    for (int e = 0; e < 4; ++e) { const int r = 4 * gi + e; const LAS unsigned char* p = p0 + 80 * (e + 1);
                        const float xr = bf_lo((unsigned)*(const LAS bf16*)p), xk = bf_lo((unsigned)*(const LAS bf16*)(p + 2640)), xv = bf_lo((unsigned)*(const LAS bf16*)(p + 5280));
                        rr[r] = xr + (pr - xr) * mur; kx[r] = xk + (pkk - xk) * muk; vv[e] = xv + (pv - xv) * muv; pr = xr; pkk = xk; pv = xv;
                        lw[r] = -0.6065306597f * sigmoid_f(w0c + Wl[r]);
                        Al[r] = sigmoid_f(a0c + Al[r]); }
                    pk[ct][4][gi] = pack4(vv[0], vv[1], vv[2], vv[3]); }
                float lg[16], tot[4], oth[4];
#pragma unroll
                for (int gi = 0; gi < 4; ++gi) { lg[4 * gi] = lw[4 * gi]; lg[4 * gi + 1] = lg[4 * gi] + lw[4 * gi + 1]; lg[4 * gi + 2] = lg[4 * gi + 1] + lw[4 * gi + 2]; lg[4 * gi + 3] = lg[4 * gi + 2] + lw[4 * gi + 3]; tot[gi] = lg[4 * gi + 3]; }
#pragma unroll
                for (int gi = 0; gi < 4; ++gi) oth[gi] = __shfl_xor(tot[gi], 32);
                float basev = 0.f;
#pragma unroll
                for (int gi = 0; gi < 4; ++gi) { const float off = basev + (half ? oth[gi] : 0.f);
#pragma unroll
                    for (int e = 0; e < 4; ++e) lg[4 * gi + e] += off;
                    basev += tot[gi] + oth[gi]; }
                if (half == 0) *(float*)(rso + 24576 + cl * 4) = __expf(basev);
                float gam[16], gprev[4];
#pragma unroll
                for (int r = 0; r < 16; ++r) gam[r] = __expf(lg[r]);
#pragma unroll
                for (int gi = 0; gi < 4; ++gi) { const float o3 = __shfl_xor(gam[4 * gi + 3], 32);
                    gprev[gi] = half ? o3 : 0.f; }
                { float o3p[4];
#pragma unroll
                  for (int gi = 0; gi < 4; ++gi) o3p[gi] = __shfl_xor(gam[4 * gi + 3], 32);
#pragma unroll
                  for (int gi = 0; gi < 4; ++gi) if (!half) gprev[gi] = gi == 0 ? 1.0f : o3p[gi - 1]; }
                float bv = 0.f;
#pragma unroll
                for (int gi = 0; gi < 4; ++gi) { float At_[4], Bt_[4], Kt_[4], Rt_[4];
                    const f32x4 rn4 = *(const LAS f32x4*)((LAS float*)(lds + 135168) + h * 64 + 32 * sc + 8 * gi + 4 * half);
#pragma unroll
                    for (int e = 0; e < 4; ++e) { const int r = 4 * gi + e; const float a = Al[r], kk = kx[r] * kkc * rn4[e], k2 = kx[r] * (1.0f + (a - 1.0f) * kac);
                        const float gg = gam[r], gi_ = __builtin_amdgcn_rcpf(gg), gp = e == 0 ? gprev[gi] : gam[r - 1];
                        At_[e] = -kk * gp; Bt_[e] = kk * a * gi_; Kt_[e] = k2 * gi_; Rt_[e] = rr[r] * gg; { const float sr = sum32(rr[r] * k2 * rkc); bv = (l31 == r) ? sr : bv; } }
                    pk[ct][0][gi] = pack4(At_[0], At_[1], At_[2], At_[3]); pk[ct][1][gi] = pack4(Bt_[0], Bt_[1], Bt_[2], Bt_[3]);
                    pk[ct][2][gi] = pack4(Kt_[0], Kt_[1], Kt_[2], Kt_[3]); pk[ct][3][gi] = pack4(Rt_[0], Rt_[1], Rt_[2], Rt_[3]);
                    }
                if (ct == 0) {
                    char* pkp = (char*)AT + lane_ * 16;
#pragma unroll
                    for (int ar = 0; ar < NPARK; ++ar)
#pragma unroll
                        for (int s2 = 0; s2 < 2; ++s2) *(v4u*)(pkp + (ar * 2 + s2) * 1024) = (v4u){pk[0][5 - NPARK + ar][2 * s2].x, pk[0][5 - NPARK + ar][2 * s2].y, pk[0][5 - NPARK + ar][2 * s2 + 1].x, pk[0][5 - NPARK + ar][2 * s2 + 1].y}; }
                { if (l31 < 16) BON[((size_t)(m0 + 32 * sc + 8 * (l31 >> 2) + 4 * half + (l31 & 3)) * 16 + h) * 2 + ct] = bv; }
            }
        }
            asm volatile("s_waitcnt vmcnt(0)" ::: "memory");
            RW_SYNC();
            { const char* pkp = (const char*)AT + lane_ * 16;
#pragma unroll
              for (int ar = 0; ar < NPARK; ++ar)
#pragma unroll
                  for (int s2 = 0; s2 < 2; ++s2) { const v4u q = *(const v4u*)(pkp + (ar * 2 + s2) * 1024); pk[0][5 - NPARK + ar][2 * s2] = (v2u){q.x, q.y}; pk[0][5 - NPARK + ar][2 * s2 + 1] = (v2u){q.z, q.w}; } }
            bf16x8 akF[2], rbF[2], rkF[2];
            {
            LAS unsigned char* G0 = (LAS unsigned char*)Acol; LAS unsigned char* G1 = G0 + 4096;
#define GWR(arr, G) do { _Pragma("unroll") for (int ct_ = 0; ct_ < 2; ++ct_) _Pragma("unroll") for (int gi_ = 0; gi_ < 4; ++gi_) { const v2u q_ = pk[ct_][arr][gi_]; _Pragma("unroll") for (int e_ = 0; e_ < 4; ++e_) { \
                const int row_ = 8 * gi_ + 4 * half + e_; const unsigned v_ = (e_ & 1) ? ((e_ >> 1) ? q_.y : q_.x) >> 16 : ((e_ >> 1) ? q_.y : q_.x) & 0xffffu; \
                *(LAS bf16*)((G) + row_ * 128 + 16 * ((4 * ct_ + (l31 >> 3)) ^ ((row_ >> 1) & 7)) + 2 * (l31 & 7)) = (bf16)v_; } } } while (0)
#define GRD(G, s_) (*(const LAS bf16x8*)((G) + l31 * 128 + 16 * ((2 * (s_) + half) ^ ((l31 >> 1) & 7))))
            f32x4 avv[4];
            GWR(0, G0); GWR(1, G1); WAVE_SYNC();
            bf16x8 xF[4], yF[4];
#pragma unroll
            for (int s = 0; s < 4; ++s) { xF[s] = GRD(G0, s); yF[s] = GRD(G1, s); }
            { f32x16 AB = zero16();
#pragma unroll
              for (int s = 0; s < 4; ++s) AB = MFMA32(xF[s], yF[s], AB);
#pragma unroll
              for (int gi = 0; gi < 4; ++gi)
#pragma unroll
                  for (int e = 0; e < 4; ++e) avv[gi][e] = (8 * gi + 4 * half + e) > l31 ? -AB[4 * gi + e] : 0.f; }
            WAVE_SYNC(); GWR(3, G0); WAVE_SYNC();
#pragma unroll
            for (int s = 0; s < 4; ++s) xF[s] = GRD(G0, s);
            { f32x16 RBT = zero16();
#pragma unroll
              for (int s = 0; s < 4; ++s) RBT = MFMA32(yF[s], xF[s], RBT);
#pragma unroll
              for (int r = 0; r < 16; ++r) RBT[r] = (8 * (r >> 2) + 4 * half + (r & 3)) <= l31 ? RBT[r] : 0.f;
              rbF[0] = pack8<0>(RBT); rbF[1] = pack8<1>(RBT); }
            WAVE_SYNC(); GWR(2, G1); WAVE_SYNC();
#pragma unroll
            for (int s = 0; s < 4; ++s) yF[s] = GRD(G1, s);
            { f32x16 RKT = zero16();
#pragma unroll
              for (int s = 0; s < 4; ++s) RKT = MFMA32(yF[s], xF[s], RKT);
#pragma unroll
              for (int r = 0; r < 16; ++r) RKT[r] = (8 * (r >> 2) + 4 * half + (r & 3)) <= l31 ? RKT[r] : 0.f;
              rkF[0] = pack8<0>(RKT); rkF[1] = pack8<1>(RKT); }
            WAVE_SYNC(); GWR(0, G0); WAVE_SYNC();
#pragma unroll
            for (int s = 0; s < 4; ++s) xF[s] = GRD(G0, s);
            { f32x16 AKT = zero16();
#pragma unroll
              for (int s = 0; s < 4; ++s) AKT = MFMA32(yF[s], xF[s], AKT);
#pragma unroll
              for (int r = 0; r < 16; ++r) AKT[r] = (8 * (r >> 2) + 4 * half + (r & 3)) < l31 ? AKT[r] : 0.f;
              akF[0] = pack8<0>(AKT); akF[1] = pack8<1>(AKT); }
            WAVE_SYNC();
#pragma unroll
            for (int gi = 0; gi < 4; ++gi) *(LAS f32x4*)(Acol + l31 * 32 + 8 * gi + 4 * half) = avv[gi];
#undef GWR
#undef GRD
            }
            RW_SYNC();
            {
            float tr[32];
#pragma unroll
            for (int j = 0; j < 32; ++j) tr[j] = 0.f;
            tr[31] = l31 == 31 ? 1.f : 0.f;
            const LAS float* Ac = Acol; int li = l31;
#pragma unroll
            for (int j = 30; j >= 0; --j) { asm volatile("" : "+v"(li));
                float x0 = li == j ? 1.f : 0.f, x1 = 0.f;
#pragma unroll
                for (int k4 = ((j + 1) & ~3); k4 < 32; k4 += 4) { const f32x4 a = *(const LAS f32x4*)(Ac + j * 32 + k4); x0 -= tr[k4] * a.x + tr[k4 + 2] * a.z; x1 -= tr[k4 + 1] * a.y + tr[k4 + 3] * a.w; }
                tr[j] = x0 + x1; asm volatile("" : "+v"(tr[j]) :: "memory"); }
            RW_SYNC();
            LAS bf16* Tl = (LAS bf16*)Acol + 2048;
#pragma unroll
            for (int j8 = 0; j8 < 4; ++j8) { v4u o; o.x = cvt_pk_bf16(tr[8 * j8], tr[8 * j8 + 1]); o.y = cvt_pk_bf16(tr[8 * j8 + 2], tr[8 * j8 + 3]); o.z = cvt_pk_bf16(tr[8 * j8 + 4], tr[8 * j8 + 5]); o.w = cvt_pk_bf16(tr[8 * j8 + 6], tr[8 * j8 + 7]);
                *(LAS v4u*)(Tl + l31 * 32 + 8 * j8) = o; }
            }
            RW_SYNC();
            {
            const int lane = lane_;
#define PKF(arr, ct_, s2_) __builtin_bit_cast(bf16x8, (v4u){pk[ct_][arr][2 * (s2_)].x, pk[ct_][arr][2 * (s2_)].y, pk[ct_][arr][2 * (s2_) + 1].x, pk[ct_][arr][2 * (s2_) + 1].y})
            const LAS bf16* Tl = (const LAS bf16*)Acol + 2048 + l31 * 32;
            bf16x8 tP[2];
#pragma unroll
            for (int s2 = 0; s2 < 2; ++s2) { const v2u a = *(const LAS v2u*)(Tl + 16 * s2 + 4 * half), bq = *(const LAS v2u*)(Tl + 16 * s2 + 8 + 4 * half); tP[s2] = __builtin_bit_cast(bf16x8, (v4u){a.x, a.y, bq.x, bq.y}); }
            unsigned char* rso = RSO + (size_t)((b * 16 + h) * 64 + (t0 >> 5) + sc) * RSO_BYTES;
            float gClv[2]; f32x4 grv[2][4];
#pragma unroll
            for (int kt = 0; kt < 2; ++kt) { gClv[kt] = *(const float*)(rso + 24576 + (32 * kt + l31) * 4);
#pragma unroll
                for (int gi = 0; gi < 4; ++gi) grv[kt][gi] = *(const f32x4*)(rso + 24576 + (32 * kt + 8 * gi + 4 * half) * 4); }
            bf16x8 taF[2][2], u0F[2][2];
#pragma unroll
            for (int t2 = 0; t2 < 2; ++t2) {
                f32x16 TA = zero16(); TA = MFMA32(tP[0], PKF(0, t2, 0), TA); TA = MFMA32(tP[1], PKF(0, t2, 1), TA);
                taF[t2][0] = pack8<0>(TA); taF[t2][1] = pack8<1>(TA);
                f32x16 P1 = zero16(); P1 = MFMA32(akF[0], PKF(4, t2, 0), P1); P1 = MFMA32(akF[1], PKF(4, t2, 1), P1);
                f32x16 U0 = zero16(); U0 = MFMA32(tP[0], pack8<0>(P1), U0); U0 = MFMA32(tP[1], pack8<1>(P1), U0);
                u0F[t2][0] = pack8<0>(U0); u0F[t2][1] = pack8<1>(U0);
                f32x16 O0 = zero16(); O0 = MFMA32(rbF[0], u0F[t2][0], O0); O0 = MFMA32(rbF[1], u0F[t2][1], O0);
                O0 = MFMA32(rkF[0], PKF(4, t2, 0), O0); O0 = MFMA32(rkF[1], PKF(4, t2, 1), O0);
                *(bf16x8*)(rso + 12288 + t2 * 2048 + lane * 32) = pack8<0>(O0); *(bf16x8*)(rso + 12288 + t2 * 2048 + lane * 32 + 16) = pack8<1>(O0);
            }
            bf16x8 idF[2];
#pragma unroll
            for (int s = 0; s < 2; ++s)
#pragma unroll
                for (int e = 0; e < 8; ++e) idF[s][e] = (16 * s + 8 * (e >> 2) + 4 * half + (e & 3) == l31) ? (short)0x3F80 : (short)0;
#pragma unroll
            for (int kt = 0; kt < 2; ++kt) {
                f32x16 RRT = zero16(); RRT = MFMA32(PKF(3, kt, 0), idF[0], RRT); RRT = MFMA32(PKF(3, kt, 1), idF[1], RRT);
                RRT = MFMA32(taF[kt][0], rbF[0], RRT); RRT = MFMA32(taF[kt][1], rbF[1], RRT);
                *(bf16x8*)(rso + ((kt * 2 + 0) * 64 + lane) * 16) = pack8<0>(RRT); *(bf16x8*)(rso + ((kt * 2 + 1) * 64 + lane) * 16) = pack8<1>(RRT);
                const bf16x8 btP0 = PKF(1, kt, 0), btP1 = PKF(1, kt, 1);
                const float gCl = gClv[kt];
#pragma unroll
                for (int k0 = 0; k0 < 2; ++k0) {
                    f32x16 G = zero16(); G = MFMA32(taF[k0][0], btP0, G); G = MFMA32(taF[k0][1], btP1, G);
#pragma unroll
                    for (int r = 0; r < 16; ++r) G[r] *= gCl;
                    *(bf16x8*)(rso + 4096 + (((k0 * 2 + kt) * 2 + 0) * 64 + lane) * 16) = pack8<0>(G); *(bf16x8*)(rso + 4096 + (((k0 * 2 + kt) * 2 + 1) * 64 + lane) * 16) = pack8<1>(G); }
#pragma unroll
                for (int vt = 0; vt < 2; ++vt) {
                    f32x16 HT = zero16(); HT = MFMA32(btP0, u0F[vt][0], HT); HT = MFMA32(btP1, u0F[vt][1], HT);
                    HT = MFMA32(PKF(2, kt, 0), PKF(4, vt, 0), HT); HT = MFMA32(PKF(2, kt, 1), PKF(4, vt, 1), HT);
#pragma unroll
                    for (int r = 0; r < 16; ++r) HT[r] *= grv[kt][r >> 2][r & 3];
                    *(bf16x8*)(rso + 16384 + (kt * 2 + vt) * 2048 + lane * 32) = pack8<0>(HT); *(bf16x8*)(rso + 16384 + (kt * 2 + vt) * 2048 + lane * 32 + 16) = pack8<1>(HT); }
            }
#undef PKF
            }
            RW_SYNC();
        }
        RW_SYNC();
    }
    __syncthreads();
}
__device__ __forceinline__ void rwkv_scan_wave(const unsigned char* RSO, bf16* RO, int item, int lane) {
    const int chain = item >> 1, vt = item & 1, b = chain >> 4, h = chain & 15, l31 = lane & 31, half = lane >> 5;
    f32x16 ST[2]; ST[0] = zero16(); ST[1] = zero16();
    const unsigned char* rs = RSO + (size_t)chain * 64 * RSO_BYTES;
#pragma unroll 1
    for (int c = 0; c < 64; ++c, rs += RSO_BYTES) {
        bf16x8 rrF[2][2], gF[2][2][2]; v4u oR[2], nR[2][2]; f32x4 g4[2][4];
#pragma unroll
        for (int kt = 0; kt < 2; ++kt)
#pragma unroll
            for (int s2 = 0; s2 < 2; ++s2) { rrF[kt][s2] = *(const bf16x8*)(rs + ((kt * 2 + s2) * 64 + lane) * 16);
#pragma unroll
                for (int k1 = 0; k1 < 2; ++k1) gF[kt][k1][s2] = *(const bf16x8*)(rs + 4096 + (((kt * 2 + k1) * 2 + s2) * 64 + lane) * 16); }
        oR[0] = *(const v4u*)(rs + 12288 + vt * 2048 + lane * 32); oR[1] = *(const v4u*)(rs + 12288 + vt * 2048 + lane * 32 + 16);
#pragma unroll
        for (int k1 = 0; k1 < 2; ++k1) { nR[k1][0] = *(const v4u*)(rs + 16384 + (k1 * 2 + vt) * 2048 + lane * 32); nR[k1][1] = *(const v4u*)(rs + 16384 + (k1 * 2 + vt) * 2048 + lane * 32 + 16);
#pragma unroll
            for (int gi = 0; gi < 4; ++gi) g4[k1][gi] = *(const f32x4*)(rs + 24576 + (32 * k1 + 8 * gi + 4 * half) * 4); }
        asm volatile("" :: "v"(rrF[0][0]), "v"(rrF[0][1]), "v"(rrF[1][0]), "v"(rrF[1][1]), "v"(gF[0][0][0]), "v"(gF[0][0][1]), "v"(gF[0][1][0]), "v"(gF[0][1][1]), "v"(gF[1][0][0]), "v"(gF[1][0][1]), "v"(gF[1][1][0]), "v"(gF[1][1][1]),
                     "v"(oR[0]), "v"(oR[1]), "v"(nR[0][0]), "v"(nR[0][1]), "v"(nR[1][0]), "v"(nR[1][1]), "v"(g4[0][0]), "v"(g4[0][1]), "v"(g4[0][2]), "v"(g4[0][3]), "v"(g4[1][0]), "v"(g4[1][1]), "v"(g4[1][2]), "v"(g4[1][3]) : "memory");
        f32x16 O = unpack_tile(oR[0], oR[1]);
        f32x16 N[2];
#pragma unroll
        for (int k1 = 0; k1 < 2; ++k1) { N[k1] = unpack_tile(nR[k1][0], nR[k1][1]);
#pragma unroll
            for (int gi = 0; gi < 4; ++gi) { const f32x4 g = g4[k1][gi];
                N[k1][4 * gi] += g.x * ST[k1][4 * gi]; N[k1][4 * gi + 1] += g.y * ST[k1][4 * gi + 1]; N[k1][4 * gi + 2] += g.z * ST[k1][4 * gi + 2]; N[k1][4 * gi + 3] += g.w * ST[k1][4 * gi + 3]; } }
        bf16x8 sf[2][2];
#pragma unroll
        for (int kt = 0; kt < 2; ++kt) { sf[kt][0] = pack8<0>(ST[kt]); sf[kt][1] = pack8<1>(ST[kt]); }
#pragma unroll
        for (int kt = 0; kt < 2; ++kt)
#pragma unroll
            for (int s2 = 0; s2 < 2; ++s2) { O = MFMA32(rrF[kt][s2], sf[kt][s2], O);
#pragma unroll
                for (int k1 = 0; k1 < 2; ++k1) N[k1] = MFMA32(gF[kt][k1][s2], sf[kt][s2], N[k1]); }
        ST[0] = N[0]; ST[1] = N[1];
        bf16* op = RO + ((size_t)b * SEQ + 32 * c) * 1024 + h * 64 + 32 * vt + l31;
#pragma unroll
        for (int r = 0; r < 16; r += 2) { const unsigned w = cvt_pk_bf16(O[r], O[r + 1]);
            op[(size_t)(8 * (r >> 2) + 4 * half + (r & 3)) * 1024] = (bf16)(w & 0xffffu); op[(size_t)(8 * (r >> 2) + 4 * half + (r & 3) + 1) * 1024] = (bf16)(w >> 16); }
    }
}
__device__ __forceinline__ float sum8(float x) { x += dpp_f<0xB1>(x); x += dpp_f<0x4E>(x); x += dpp_f<0x141>(x); return x; }
__device__ __forceinline__ void unpack8(const v4u q, float (&o)[8]) { o[0] = bf_lo(q.x); o[1] = bf_hi(q.x); o[2] = bf_lo(q.y); o[3] = bf_hi(q.y); o[4] = bf_lo(q.z); o[5] = bf_hi(q.z); o[6] = bf_lo(q.w); o[7] = bf_hi(q.w); }
typedef unsigned v8u __attribute__((ext_vector_type(8)));
__device__ __forceinline__ v8u ld2(const void* a, const void* b) { const v4u x = *(const v4u*)a, y = *(const v4u*)b; v8u t; t.lo = x; t.hi = y; return t; }
__device__ __forceinline__ void rwkv_post(const bf16* RO, const bf16* cC, const float* BON, const bf16* GS, const float* mu, const float* gn_w, const float* gn_b, bf16* YC, int gtid, int nthr) {
    const int c8 = gtid & 127, c0 = 8 * c8;
    float muv[8], gwc[8], gbc[8];
#pragma unroll
    for (int e = 0; e < 8; ++e) { muv[e] = mu[2048 + c0 + e]; gwc[e] = gn_w[c0 + e]; gbc[e] = gn_b[c0 + e]; }
    for (int m4 = (gtid >> 7) * 4; m4 < M; m4 += (nthr >> 7) * 4) {
        v8u C[4]; v4u V[4], Pv; f32x2 bn[4];
        const bool hp = (m4 & (SEQ - 1)) > 0; const v4u z4 = (v4u){0u, 0u, 0u, 0u};
        Pv = *(const v4u*)(cC + (size_t)(hp ? m4 - 1 : m4) * 3584 + c0 + 2048);
#pragma unroll
        for (int j = 0; j < 4; ++j) { const int m = m4 + j;
            V[j] = *(const v4u*)(cC + (size_t)m * 3584 + c0 + 2048); C[j] = ld2(GS + (size_t)m * 1024 + c0, RO + (size_t)m * 1024 + c0); bn[j] = *(const f32x2*)(BON + ((size_t)m * 16 + (c8 >> 3)) * 2); }
        asm volatile("" :: "v"(V[0]), "v"(V[1]), "v"(V[2]), "v"(V[3]), "v"(C[0]), "v"(C[1]), "v"(C[2]), "v"(C[3]), "v"(bn[0]), "v"(bn[1]), "v"(bn[2]), "v"(bn[3]), "v"(Pv) : "memory");
        v4u pvv = hp ? Pv : z4;
#pragma unroll
        for (int j = 0; j < 4; ++j) {
            const v4u xv = V[j];
            const float bon = bn[j].x + bn[j].y;
            float o_[8], so = 0.f;
            unpack8((v4u)C[j].hi, o_);
#pragma unroll
            for (int e = 0; e < 8; ++e) so += o_[e];
            const float mean = sum8(so) * (1.0f / 64.0f);
            float sv = 0.f;
#pragma unroll
            for (int e = 0; e < 8; ++e) { o_[e] -= mean; sv += o_[e] * o_[e]; }
            const float rs = 1.0f / sqrtf(sum8(sv) * (1.0f / 64.0f) + 64e-5f);
            float v_[8], p_[8], g_[8], y[8];
            unpack8(xv, v_); unpack8(pvv, p_); unpack8((v4u)C[j].lo, g_);
#pragma unroll
            for (int e = 0; e < 8; ++e) { const float vv = v_[e] + (p_[e] - v_[e]) * muv[e]; y[e] = (o_[e] * rs * gwc[e] + gbc[e] + bon * vv) * g_[e]; }
            pvv = xv;
            v4u w; w.x = cvt_pk_bf16(y[0], y[1]); w.y = cvt_pk_bf16(y[2], y[3]); w.z = cvt_pk_bf16(y[4], y[5]); w.w = cvt_pk_bf16(y[6], y[7]);
            *(v4u*)(YC + (size_t)(m4 + j) * 2560 + c0) = w; }
    }
}
#define XB_TMO      128
#define XB_XCNT(j)  (256  + 64 * (j))
#define XB_XSUB(j)  (1280 + 64 * (j))
#define XB_XGEN(j)  (2304 + 64 * (j))
#define XB_TOP      3328
#define XB_TOPGEN   3392
#define XCD_BAR_WORDS 3456
#define XB_SPIN_CAP (1u << 18)

__device__ __forceinline__ unsigned xb_ld(unsigned* p)              { return __hip_atomic_load(p, __ATOMIC_RELAXED, __HIP_MEMORY_SCOPE_AGENT); }
__device__ __forceinline__ unsigned xb_add(unsigned* p, unsigned v) { return __hip_atomic_fetch_add(p, v, __ATOMIC_RELAXED, __HIP_MEMORY_SCOPE_AGENT); }
__device__ __forceinline__ unsigned xb_xcc_id() { return (unsigned)__builtin_amdgcn_s_getreg((3 << 11) | 20) & 0xFu; }
#define XB_SPIN(cond, bar) do { unsigned _sp = 0; while (cond) { __builtin_amdgcn_s_sleep(1); \
    if ((++_sp & 255u) == 0u) { if (xb_ld(&(bar)[XB_TMO])) break; if (_sp > XB_SPIN_CAP) { atomicAdd(&(bar)[XB_TMO], 1u); break; } } } } while (0)

struct XcdBarrier {
    unsigned* bar; unsigned x;
    volatile LAS unsigned* st;
};

__device__ __forceinline__ XcdBarrier xcd_barrier_post(unsigned* bar, volatile LAS unsigned* st, int tid_) {
    XcdBarrier b; b.bar = bar; b.x = xb_xcc_id(); b.st = st;
    if (tid_ == 0) (void)xb_add(&bar[XB_XCNT(b.x)], 1u);
    return b;
}
__device__ __forceinline__ void xcd_barrier_complete(unsigned* bar, unsigned x, unsigned& nloc, unsigned& nx) {
    const unsigned G = gridDim.x * gridDim.y * gridDim.z;
    unsigned sum, cnt, mine, sp = 0u;
    for (;;) {
        sum = 0u; cnt = 0u; mine = 0u;
#pragma unroll
        for (unsigned j = 0; j < 16; ++j) { const unsigned c = xb_ld(&bar[XB_XCNT(j)]); sum += c; cnt += (c > 0u) ? 1u : 0u; mine = (j == x) ? c : mine; }
        if (sum == G) break;
        __builtin_amdgcn_s_sleep(1);
        if ((++sp & 255u) == 0u) { if (xb_ld(&bar[XB_TMO])) break; if (sp > XB_SPIN_CAP) { atomicAdd(&bar[XB_TMO], 1u); break; } }
    }
    nloc = mine > 0u ? mine : 1u; nx = cnt > 0u ? cnt : 1u;
}

__device__ __forceinline__ void xcd_barrier(const XcdBarrier& b, int tid_) {
    asm volatile("s_waitcnt vmcnt(0)" ::: "memory");
    __syncthreads();
    if (tid_ == 0) {
        unsigned* bar = b.bar;
        __builtin_amdgcn_s_waitcnt(0);
        unsigned nloc = b.st[0], nx = b.st[1];
        if (nloc == 0u) { xcd_barrier_complete(bar, b.x, nloc, nx); b.st[0] = nloc; b.st[1] = nx; }
        const unsigned old = xb_add(&bar[XB_XSUB(b.x)], 1u);
        const unsigned gen = old / nloc;
        if (old + 1u == (gen + 1u) * nloc) {
            __builtin_amdgcn_fence(__ATOMIC_RELEASE, "agent");
            asm volatile("s_waitcnt vmcnt(0)" ::: "memory");
            const unsigned og = xb_add(&bar[XB_TOP], 1u);
            const unsigned tg = og / nx;
            if (og + 1u == (tg + 1u) * nx) xb_add(&bar[XB_TOPGEN], 1u);
            else XB_SPIN(xb_ld(&bar[XB_TOPGEN]) == tg, bar);
            __builtin_amdgcn_fence(__ATOMIC_ACQUIRE, "agent");
            xb_add(&bar[XB_XGEN(b.x)], 1u);
            asm volatile("s_waitcnt vmcnt(0)" ::: "memory");
        } else {
            XB_SPIN(xb_ld(&bar[XB_XGEN(b.x)]) == gen, bar);
            __builtin_amdgcn_fence(__ATOMIC_ACQUIRE, "agent");
            asm volatile("s_waitcnt vmcnt(0)" ::: "memory");
        }
    }
    __syncthreads();
}

struct Args { const float* in[29]; float* out; unsigned char* ws; int ph_lo, ph_hi; };
__global__ void __launch_bounds__(NWAVES * 64, 2) fwd(Args a) {
    extern __shared__ __attribute__((aligned(16))) unsigned char lds_raw[];
    LAS unsigned char* lds = (LAS unsigned char*)lds_raw;
    const int tid0 = threadIdx.x;
    const int G = gridDim.x, bx = blockIdx.x, NGW = G * NWAVES;
#ifdef ZERO_ALL_LDS
    for (int u = tid0; u < LDS_BYTES / 4; u += NWAVES * 64) ((LAS unsigned*)lds)[u] = 0u;
#else
    for (int u = tid0; u < (LDS_BYTES - LDSCTL_OFF) / 4; u += NWAVES * 64) ((LAS unsigned*)(lds + LDSCTL_OFF))[u] = 0u;
#endif
    __syncthreads();
    { const int hwslot_ = (int)__builtin_amdgcn_s_getreg((5 << 11) | 4) & 63; if ((threadIdx.x & 63) == 0) ((LAS int*)(lds + LDSCTL_OFF + 1024))[hwslot_] = (int)(threadIdx.x >> 6); }
    __syncthreads();
    unsigned char* ws0 = a.ws;
    unsigned* ctl = (unsigned*)(ws0 + WS_CTL);
    const int lo = a.ph_lo, hi = a.ph_hi;
    XcdBarrier bar; bar.bar = ctl + CW_BAR; bar.x = 0; bar.st = nullptr;
    if (hi - lo > 1) bar = xcd_barrier_post(ctl + CW_BAR, (volatile LAS unsigned*)(lds + MISC_OFF) + 8, (int)threadIdx.x);
#define PH_IF if (lo <= pc && pc < hi)
#define OPQ(p) do { __attribute__((address_space(1))) char* g_ = (__attribute__((address_space(1))) char*)(p); asm volatile("" : "+s"(g_)); (p) = (decltype(p))g_; } while (0)
#ifndef GDN_OLD
#define GDN_OLD 0
#endif
#ifndef ATT_OLD
#define ATT_OLD 0
#endif
#ifndef REPG
#define REPG 1
#endif
#ifndef REP0
#define REP0 1
#endif
#ifndef REPGP
#define REPGP 1
#endif
#ifndef REP7
#define REP7 1
#endif
#ifndef REPW
#define REPW 1
#endif
#ifndef REPD
#define REPD 1
#endif
#ifndef REPO
#define REPO 1
#endif
#ifndef REPGS
#define REPGS 1
#endif
#ifndef REPRS
#define REPRS 1
#endif
#ifndef RW_WPB
#define RW_WPB 4
#endif
#define RW_END (64 + 256 / RW_WPB)
#ifndef REPA
#define REPA 1
#endif
#ifndef REP8
#define REP8 1
#endif
#ifndef REPP
#define REPP 1
#endif
#ifndef REP6
#define REP6 1
#endif
#ifndef SKIPMASK
#define SKIPMASK 0
#endif
#define PH_IFN(k) if (!((SKIPMASK >> (k)) & 1) && lo <= pc && pc < hi)
#define PH_ENTER unsigned char* ws = ws0; OPQ(ws); const char __attribute__((address_space(4)))* kp_ = (const char __attribute__((address_space(4)))*)__builtin_amdgcn_kernarg_segment_ptr(); OPQ(kp_); const Args __attribute__((address_space(4)))* ap_ = (const Args __attribute__((address_space(4)))*)kp_; int tid = __builtin_amdgcn_readfirstlane(((volatile LAS int*)(lds + LDSCTL_OFF + 1024))[(int)__builtin_amdgcn_s_getreg((5 << 11) | 4) & 63]) * 64 + LANEID_OPQ(); asm volatile("" : "+v"(tid)); const int lane = tid & 63, wave = __builtin_amdgcn_readfirstlane(tid >> 6), gw = bx * NWAVES + wave; LAS float* wl = (LAS float*)(lds + RING_OFF + wave * 16384); (void)lane; (void)gw; (void)wl;
#define LANEID_OPQ() ({ unsigned z_; asm volatile("v_mov_b32 %0, 0" : "=v"(z_)); (int)__builtin_amdgcn_mbcnt_hi(~0u, __builtin_amdgcn_mbcnt_lo(~0u, z_)); })
#define PH_TID (__builtin_amdgcn_readfirstlane(((volatile LAS int*)(lds + LDSCTL_OFF + 1024))[(int)__builtin_amdgcn_s_getreg((5 << 11) | 4) & 63]) * 64 + LANEID_OPQ())
#ifndef NBAR
#define NBAR 1
#endif
#define PH_SEAM do { if (lo <= pc && pc + 1 < hi) for (int nb_ = 0; nb_ < NBAR; ++nb_) xcd_barrier(bar, PH_TID); ++pc; } while (0)
#define WB ((bf16*)(ws + WS_WB))
#define H ((bf16*)(ws + WS_H))
#define ACT ((bf16*)(ws + WS_ACT))
#define CA ((bf16*)(ws + WS_CA))
#define CB ((bf16*)(ws + WS_CB))
#define CC ((bf16*)(ws + WS_CC))
#define CG ((bf16*)(ws + WS_CG))
#define QR ((bf16*)(ws + WS_QR))
#define KR ((bf16*)(ws + WS_KR))
#define KT ((bf16*)(ws + WS_KT))
#define VT ((bf16*)(ws + WS_VT))
#define OG ((bf16*)(ws + WS_OG))
#define FR (ws + WS_FR)
#define UF ((float*)(ws + WS_UF))
#define GSC ((float*)(ws + WS_GSC))
#define GO ((bf16*)(ws + WS_GO))
#define LSE ((float*)(ws + WS_LSE))
#define RSO (ws + WS_RSO)
#define RO ((bf16*)(ws + WS_RO))
#define VS ((bf16*)(ws + WS_VS))
#define GS ((bf16*)(ws + WS_GS))
#define BON ((float*)(ws + WS_BON))
#define W2T ((bf16*)(ws + WS_LW) + (size_t)l * 524288)
#define A2T ((bf16*)(ws + WS_LW) + (size_t)l * 524288 + 131072)
#define G2T ((bf16*)(ws + WS_LW) + (size_t)l * 524288 + 262144)
#define YA ((bf16*)(ws + WS_YA))
#define YB ((bf16*)(ws + WS_YA) + 512)
#define YC ((bf16*)(ws + WS_YA) + 1536)
#define MB ((bf16*)(ws + WS_MB))
#define MT ((float*)(ws + WS_MT))
#define INP(i) ((const float*)(__attribute__((address_space(1))) const float*)ap_->in[i])
#define X ((float*)(__attribute__((address_space(1))) float*)ap_->out)

    int pc = 0;
    for (int l = 0; l < DEPTH; ++l) {
        for (int f = 0; f < 2; ++f) {
            PH_IFN(0) for (int r0_ = 0; r0_ < REP0; ++r0_) { PH_ENTER if (r0_) __syncthreads();
                if (f == 0) {
                    int rot = 0;
                    conv_matrix(INP(2) + (size_t)l * D * 2 * FF, D, 2 * FF, WB + W_GU1, 2 * FF, MapGu(), wl, rot, gw, NGW, lane);
                    conv_matrix(INP(3) + (size_t)l * FF * D, FF, D, WB + W_D1, D, MapId(), wl, rot, gw, NGW, lane);
                    conv_matrix(INP(5) + (size_t)l * D * 18384, D, 18384, WB + W_IN, NIN_PAD, MapIn(), wl, rot, gw, NGW, lane);
                    conv_matrix(INP(21) + (size_t)l * 512 * D, 512, D, WB + W_PA, D, MapId(), wl, rot, gw, NGW, lane, 512, 2560);
                    conv_matrix(INP(22) + (size_t)l * 1024 * D, 1024, D, WB + W_PA + 512, D, MapId(), wl, rot, gw, NGW, lane, 1024, 2560);
                    conv_matrix(INP(23) + (size_t)l * 1024 * D, 1024, D, WB + W_PA + 1536, D, MapId(), wl, rot, gw, NGW, lane, 1024, 2560);
                    conv_matrix(INP(24) + (size_t)l * D * D, D, D, WB + W_WO, D, MapId(), wl, rot, gw, NGW, lane);
                    conv_matrix(INP(26) + (size_t)l * D * 2 * FF, D, 2 * FF, WB + W_GU2, 2 * FF, MapGu(), wl, rot, gw, NGW, lane);
                    conv_matrix(INP(27) + (size_t)l * FF * D, FF, D, WB + W_D2, D, MapId(), wl, rot, gw, NGW, lane);
                    conv_matrix(INP(12) + (size_t)l * 96 * 1024, 96, 1024, W2T, 1024, MapId(), wl, rot, gw, NGW, lane, 128);
                    conv_matrix(INP(14) + (size_t)l * 96 * 1024, 96, 1024, A2T, 1024, MapId(), wl, rot, gw, NGW, lane, 128);
                    conv_matrix(INP(15) + (size_t)l * 256 * 1024, 256, 1024, G2T, 1024, MapId(), wl, rot, gw, NGW, lane);
                }
                const bool first = (l == 0 && f == 0);
                norm_rows(first ? INP(0) : X, first ? X : nullptr, (f == 0 ? INP(1) : INP(25)) + (size_t)l * D, H, gw, NGW, lane);
            }
            PH_SEAM;
            PH_IFN(1) { PH_ENTER
                const bf16* pa_ = H; const bf16* pb_ = WB + (f == 0 ? W_GU1 : W_GU2); bf16* po_ = ACT; OPQ(pa_); OPQ(pb_); OPQ(po_);
                pg8::Gemm g{pa_, pb_, M, 2 * FF, D}; pg8::StaticOrder S; S.init(M, 2 * FF, G, bx);
                pg8::EpiSwiglu E{po_, FF};
                for (int rg_ = 0; rg_ < REPG; ++rg_) { if (rg_) __syncthreads(); pg8::gemm_phase<pg8::EpiSwiglu, pg8::StaticOrder, true, true>(lds + RING_OFF, g, S, E, tid); }
            }
            PH_SEAM;
            PH_IFN(2) { PH_ENTER
                const bf16* pa_ = ACT; const bf16* pb_ = WB + (f == 0 ? W_D1 : W_D2); float* po_ = X; OPQ(pa_); OPQ(pb_); OPQ(po_);
                pg8::Gemm g{pa_, pb_, M, D, FF}; pg8::StaticOrder S; S.init(M, D, G, bx);
                for (int rd_ = 0; rd_ < REPD; ++rd_) { if (rd_) __syncthreads(); pg8::EpiResid E{po_, D, rd_ + 1 < REPD ? 0.0f : 0.5f};
                pg8::gemm_phase<pg8::EpiResid, pg8::StaticOrder, true, true>(lds + RING_OFF, g, S, E, tid); }
            }
            PH_SEAM;
            if (f == 0) {
                PH_IFN(3) { PH_ENTER
                    const float* px = X; bf16* ph = H; OPQ(px); OPQ(ph); norm_rows(px, nullptr, INP(4) + (size_t)l * D, ph, gw, NGW, lane); }
                PH_SEAM;
                PH_IFN(4) { PH_ENTER
                    const bf16* pa_ = H; const bf16* pb_ = WB + W_IN; bf16 *o0 = CA, *o1 = CB, *o2 = CC, *o3 = CG; OPQ(pa_); OPQ(pb_); OPQ(o0); OPQ(o1); OPQ(o2); OPQ(o3);
                    pg8::Gemm g{pa_, pb_, M, NIN_PAD, D}; pg8::StaticOrder S; S.init(M, NIN_PAD, G, bx);
                    pg8::EpiCols E{o0, o1, o2, o3};
                    for (int rw_ = 0; rw_ < REPW; ++rw_) { if (rw_) __syncthreads(); pg8::gemm_phase<pg8::EpiCols, pg8::StaticOrder, true, true>(lds + RING_OFF, g, S, E, tid); }
                }
                PH_SEAM;
                PH_IFN(5) { PH_ENTER
                    { const bf16* p0 = CC; unsigned char* p1 = RSO; float* p2 = (float*)(ws + WS_BON2); bf16* p3 = GS; unsigned char* p5 = ws + WS_SCR; const bf16 *p6 = W2T, *p7 = A2T, *p8 = G2T; OPQ(p0); OPQ(p1); OPQ(p2); OPQ(p3); OPQ(p5); OPQ(p6); OPQ(p7); OPQ(p8);
                      for (int rp_ = 0; rp_ < REPP; ++rp_)
                      for (int grp = bx; grp < M / 64; grp += G)
                          rwkv_prep_blk(p0, INP(10) + (size_t)l * 3520, INP(11) + (size_t)l * 1024, INP(13) + (size_t)l * 1024, INP(16) + (size_t)l * 1024, INP(17) + (size_t)l * 1024, INP(18) + (size_t)l * 1024,
                                        p6, p7, p8, p1, p2, p3, p5, grp, tid, lds + RING_OFF); }
                    { const bf16* p0 = CB; const bf16* p1 = CC; bf16 *p2 = QR, *p3 = KR, *p4 = KT, *p5 = VT; unsigned char* p6 = FR; float *p7 = UF, *p8 = GSC; OPQ(p0); OPQ(p1); OPQ(p2); OPQ(p3); OPQ(p4); OPQ(p5); OPQ(p6); OPQ(p7); OPQ(p8);
#ifndef NO_GDN_PREP
                      for (int rgp_ = 0; rgp_ < REPGP; ++rgp_)
                      for (int unit = gw; unit < (M / 64) * 8; unit += NGW)
                          gdn_prep_unit(p0, p1, INP(6) + (size_t)l * 4 * 3072, INP(7) + (size_t)l * 8, INP(8) + (size_t)l * 8, p2, p3, p4, p5, p6, p7, p8, unit, lane, lds + RING_OFF + wave * 16384);
#endif
                    }
                }
                PH_SEAM;
                PH_IFN(6) for (int rep_ = 0; rep_ < REP6; ++rep_) { PH_ENTER if (rep_ > 0) { __syncthreads(); }
                    if (bx < 64) { const unsigned char* p0 = FR; const float* p1 = UF; const float* p2 = GSC; bf16* p3 = GO; OPQ(p0); OPQ(p1); OPQ(p2); OPQ(p3); for (int rgs_ = 0; rgs_ < REPGS; ++rgs_) { if (rgs_) __syncthreads(); gdn_scan_blk(p0, p1, p2, p3, bx, tid, lds + RING_OFF); } }
                    else if (bx < RW_END) { if (wave < RW_WPB) { const unsigned char* p0 = RSO; bf16* p1 = RO; OPQ(p0); OPQ(p1); for (int rrs_ = 0; rrs_ < REPRS; ++rrs_) rwkv_scan_wave(p0, p1, (bx - 64) * RW_WPB + wave, lane); } }
                    else { const bf16* p0 = CA; bf16* p1 = OG; float* p2 = LSE; OPQ(p0); OPQ(p1); OPQ(p2); const int ab = __builtin_amdgcn_readfirstlane(tid >> 9) + (int)blockIdx.x - RW_END, an = G - RW_END; for (int ra_ = 0; ra_ < REPA; ++ra_) attn_phase(p0, p1, p2, lds + RING_OFF, tid, ab, an); }
                }
                PH_SEAM;
                PH_IFN(7) for (int r7_ = 0; r7_ < REP7; ++r7_) { PH_ENTER const bf16* p0 = GO; const bf16* p1 = CB; bf16* p2 = YB; OPQ(p0); OPQ(p1); OPQ(p2); gdn_post(p0, p1, INP(9) + (size_t)l * 128, p2, bx * NWAVES * 64 + tid, G * NWAVES * 64);
                    { const bf16* q0 = RO; const bf16* q1 = CC; const float* q2 = (const float*)(ws + WS_BON2); const bf16* q3 = GS; bf16* q4 = YC; OPQ(q0); OPQ(q1); OPQ(q2); OPQ(q3); OPQ(q4);
                      rwkv_post(q0, q1, q2, q3, INP(10) + (size_t)l * 3520, INP(19) + (size_t)l * 1024, INP(20) + (size_t)l * 1024, q4, bx * NWAVES * 64 + tid, G * NWAVES * 64); }
                    const bf16* p3 = OG; const float* p4 = LSE; bf16* p5 = YA; OPQ(p3); OPQ(p4); OPQ(p5); attn_combine(p3, p4, p5, bx * NWAVES * 64 + tid, G * NWAVES * 64);
                }
                PH_SEAM;
                PH_IFN(8) for (int r8_ = 0; r8_ < REP8; ++r8_) { PH_ENTER if (r8_) __syncthreads();
                    pg8::StaticOrder S; S.init(M, D, G, bx);
                    { const bf16* pa_ = YA; const bf16* pb_ = WB + W_PA; const bf16* pg_ = CG; bf16* po_ = MB; OPQ(pa_); OPQ(pb_); OPQ(pg_); OPQ(po_);
                      pg8::Gemm g{pa_, pb_, M, D, 2560}; pg8::EpiGate3 E{pg_, po_}; pg8::gemm_phase<pg8::EpiGate3, pg8::StaticOrder, true, true>(lds + RING_OFF, g, S, E, tid); }
                }
                PH_SEAM;
                PH_IFN(9) { PH_ENTER
                    const bf16* pa_ = MB; const bf16* pb_ = WB + W_WO; float* po_ = X; OPQ(pa_); OPQ(pb_); OPQ(po_);
                    pg8::Gemm g{pa_, pb_, M, D, D}; pg8::StaticOrder S; S.init(M, D, G, bx);
                    for (int ro_ = 0; ro_ < REPO; ++ro_) { if (ro_) __syncthreads(); pg8::EpiResid E{po_, D, ro_ + 1 < REPO ? 0.0f : 1.0f};
                    pg8::gemm_phase<pg8::EpiResid, pg8::StaticOrder, true, true>(lds + RING_OFF, g, S, E, tid); }
                }
                PH_SEAM;
            }
        }
    }
    PH_IFN(10) { PH_ENTER float* px = X; OPQ(px); final_norm_rows(px, INP(28), gw, NGW, lane); }
#undef PH_IF
#undef PH_SEAM
}

extern "C" void kernel_launch(void* const* d_in, const int* in_sizes, int n_in, void* d_out, int out_size, void* d_ws, size_t ws_size, hipStream_t stream) {
    static int grid = 0;
    if (grid == 0) {
        if (n_in != 29 || out_size != M * D || ws_size < WS_END) { fprintf(stderr, "kernel_launch: unexpected shapes (n_in %d out %d ws %zu)\n", n_in, out_size, ws_size); grid = -1; return; }
        int dev = 0, cus = 0;
        if (hipGetDevice(&dev) != hipSuccess || hipDeviceGetAttribute(&cus, hipDeviceAttributeMultiprocessorCount, dev) != hipSuccess) { grid = -1; return; }
        if (hipFuncSetAttribute((const void*)fwd, hipFuncAttributeMaxDynamicSharedMemorySize, LDS_BYTES) != hipSuccess) { fprintf(stderr, "kernel_launch: hipFuncSetAttribute failed\n"); grid = -1; return; }
        int per_cu = 0; (void)hipOccupancyMaxActiveBlocksPerMultiprocessor(&per_cu, (const void*)fwd, NWAVES * 64, LDS_BYTES); (void)hipGetLastError();
        grid = cus;
        if (per_cu < 1) fprintf(stderr, "kernel_launch: occupancy query reports %d\n", per_cu);
    }
    if (grid < 0) return;
    if (hipMemsetAsync((char*)d_ws + WS_CTL, 0, CTL_ZERO_BYTES, stream) != hipSuccess) return;
#ifdef POISON_HOST
    (void)hipMemsetAsync((char*)d_ws + WS_H, 0x3C, WS_END - WS_H, stream);
#endif
    Args a{};
    for (int i = 0; i < 29; ++i) a.in[i] = (const float*)d_in[i];
    a.out = (float*)d_out; a.ws = (unsigned char*)d_ws;
#if MK_PER_PHASE
    for (int p = 0; p < N_PHASES; ++p) { a.ph_lo = p; a.ph_hi = p + 1; hipLaunchKernelGGL(fwd, dim3(grid), dim3(NWAVES * 64), LDS_BYTES, stream, a); }
#else
    a.ph_lo = 0; a.ph_hi = N_PHASES; hipLaunchKernelGGL(fwd, dim3(grid), dim3(NWAVES * 64), LDS_BYTES, stream, a);
#endif
}
```

```cpp
#define MK_PER_PHASE 0
#include <hip/hip_runtime.h>
#include <cstdio>
#include <cstdint>
namespace pg8 {
#define PG8_LAS __attribute__((address_space(3)))
typedef unsigned short bf16_t;
typedef short bf16x8 __attribute__((ext_vector_type(8)));
typedef float f32x4 __attribute__((ext_vector_type(4)));
typedef unsigned u32x4 __attribute__((ext_vector_type(4)));
constexpr int BM = 256, BK = 64, HALF = 128, HTB = HALF * BK * 2  , STAGE_BYTES = 8 * HTB, NXCD = 8, WGM = 8;

__host__ __device__ __forceinline__ int lds_byte(int r, int c) { const int st = (r >> 4) * 2 + (c >> 5), rr = r & 15, cc = c & 31, ob = rr * 64 + cc * 2; return st * 1024 + (ob ^ (((ob >> 9) & 1) << 5)); }
__host__ __device__ __forceinline__ void stage_rc(int b, int& R, int& C) { const int st = b / 1024, sb = b % 1024, swz = sb ^ (((sb >> 9) & 1) << 5); R = (st >> 1) * 16 + swz / 64; C = (st & 1) * 32 + (swz % 64) / 2; }
__host__ __device__ __forceinline__ int perm32(int rho) { const int n = rho >> 4, i = rho & 15; return 8 * (i >> 2) + 4 * n + (i & 3); }

struct Unit { int pm, pn; };
struct Gemm { const bf16_t* A; const bf16_t* Bt; int M, N, K; };

struct StaticOrder {
    int nM, nN, nwg, G, c;
    __host__ __device__ void init(int M, int N, int G_, int c_) { nM = M / BM; nN = N / BM; nwg = nM * nN; G = G_; c = c_; }
    __host__ __device__ bool next(int i, Unit& u) const {
        const long L = (long)i * G + c; if (L >= nwg) return false;
        int wgid = (int)L; { const int q = nwg / NXCD, r = nwg % NXCD, xcd = wgid % NXCD, off = wgid / NXCD; wgid = (xcd < r ? xcd * (q + 1) : r * (q + 1) + (xcd - r) * q) + off; }
        const int nig = WGM * nN, gid = wgid / nig, fm = gid * WGM, gsz = (nM - fm) < WGM ? (nM - fm) : WGM;
        u.pm = fm + ((wgid % nig) % gsz); u.pn = (wgid % nig) / gsz; return true;
    }
    __device__ __forceinline__ void a_ready(const Unit&) const {}
    __device__ __forceinline__ void done(const Unit&) const {}
};
typedef __bf16 bf16x2_t __attribute__((ext_vector_type(2)));
typedef float f32x2_t __attribute__((ext_vector_type(2)));
__device__ __forceinline__ unsigned cvt_pk_bf16(float lo, float hi) { const f32x2_t v = {lo, hi}; const bf16x2_t b = __builtin_convertvector(v, bf16x2_t); return __builtin_bit_cast(unsigned, b); }
__device__ __forceinline__ float bf_lo(unsigned w) { return __uint_as_float(w << 16); }
__device__ __forceinline__ float bf_hi(unsigned w) { return __uint_as_float(w & 0xffff0000u); }
__device__ __forceinline__ float sigmoid_f(float x) { return __builtin_amdgcn_rcpf(1.0f + __expf(-x)); }
__device__ __forceinline__ float silu_f(float x) { return x * sigmoid_f(x); }

struct EpiSwiglu {
    static constexpr bool PERM = true, AFTER_DRAIN = false, HAS_HOOK = false;
    bf16_t* O; int ldc;
    __device__ __forceinline__ void operator()(const f32x4 (&acc)[2][2][4][2], const Unit& u, int wr, int wc, int fr, int fq) const {
        const int row0 = u.pm * BM + wr * 64 + fr, col0 = u.pn * HALF + wc * 32 + 8 * fq;
#pragma unroll
        for (int ai = 0; ai < 2; ++ai)
#pragma unroll
            for (int m = 0; m < 4; ++m) { bf16_t* rowp = O + (size_t)(row0 + ai * HALF + m * 16) * ldc + col0;
                const f32x4 g0 = acc[ai][0][m][0], g1 = acc[ai][0][m][1], u0 = acc[ai][1][m][0], u1 = acc[ai][1][m][1];
                f32x4 v0, v1;
#pragma unroll
                for (int j = 0; j < 4; ++j) { v0[j] = silu_f(g0[j]) * u0[j]; v1[j] = silu_f(g1[j]) * u1[j]; }
                u32x4 w; w.x = cvt_pk_bf16(v0[0], v0[1]); w.y = cvt_pk_bf16(v0[2], v0[3]); w.z = cvt_pk_bf16(v1[0], v1[1]); w.w = cvt_pk_bf16(v1[2], v1[3]);
                *(u32x4*)rowp = w; }
    }
};
struct EpiResid {
    static constexpr bool PERM = false, AFTER_DRAIN = false, HAS_HOOK = false;
    float* X; int ldc; float scale;
    __device__ __forceinline__ void operator()(const f32x4 (&acc)[2][2][4][2], const Unit& u, int wr, int wc, int fr, int fq) const {
        const int row0 = u.pm * BM + wr * 64 + fr, col0 = u.pn * BM + wc * 32 + 4 * fq;
#pragma unroll
        for (int ai = 0; ai < 2; ++ai) { f32x4 o[4][2][2];
#pragma unroll
            for (int m = 0; m < 4; ++m) { const float* rowp = X + (size_t)(row0 + ai * HALF + m * 16) * ldc + col0;
#pragma unroll
                for (int bj = 0; bj < 2; ++bj)
#pragma unroll
                    for (int n = 0; n < 2; ++n) o[m][bj][n] = *(const f32x4*)(rowp + bj * HALF + n * 16); }
            asm volatile("" ::: "memory");
#pragma unroll
            for (int m = 0; m < 4; ++m) { float* rowp = X + (size_t)(row0 + ai * HALF + m * 16) * ldc + col0;
#pragma unroll
                for (int bj = 0; bj < 2; ++bj)
#pragma unroll
                    for (int n = 0; n < 2; ++n) *(f32x4*)(rowp + bj * HALF + n * 16) = o[m][bj][n] + acc[ai][bj][m][n] * scale; }
            asm volatile("" ::: "memory"); }
    }
};
struct EpiCols {
    static constexpr bool PERM = true, AFTER_DRAIN = false, HAS_HOOK = false;
    bf16_t *cA, *cB, *cC, *cG;
    __device__ __forceinline__ void operator()(const f32x4 (&acc)[2][2][4][2], const Unit& u, int wr, int wc, int fr, int fq) const {
        bf16_t* base; int ldc, colt;
        if (u.pn < 18) { base = cA; ldc = 4608; colt = u.pn * BM; }
        else if (u.pn < 34) { base = cB; ldc = 4096; colt = (u.pn - 18) * BM; }
        else if (u.pn < 48) { base = cC; ldc = 3584; colt = (u.pn - 34) * BM; }
        else { base = cG; ldc = 6144; colt = (u.pn - 48) * BM; }
        const int row0 = u.pm * BM + wr * 64 + fr, col0 = colt + wc * 32 + 8 * fq;
#pragma unroll
        for (int ai = 0; ai < 2; ++ai)
#pragma unroll
            for (int m = 0; m < 4; ++m) { bf16_t* rowp = base + (size_t)(row0 + ai * HALF + m * 16) * ldc + col0;
#pragma unroll
                for (int bj = 0; bj < 2; ++bj) { const f32x4 v0 = acc[ai][bj][m][0], v1 = acc[ai][bj][m][1];
                    u32x4 w; w.x = cvt_pk_bf16(v0[0], v0[1]); w.y = cvt_pk_bf16(v0[2], v0[3]); w.z = cvt_pk_bf16(v1[0], v1[1]); w.w = cvt_pk_bf16(v1[2], v1[3]);
                    *(u32x4*)(rowp + bj * HALF) = w; } }
    }
};
template <int MODE> struct EpiGate {
    static constexpr bool PERM = true, AFTER_DRAIN = false, HAS_HOOK = false;
    const bf16_t* G; float* T; bf16_t* O;
    __device__ __forceinline__ void operator()(const f32x4 (&acc)[2][2][4][2], const Unit& u, int wr, int wc, int fr, int fq) const {
        const int row0 = u.pm * BM + wr * 64 + fr, col0 = u.pn * BM + wc * 32 + 8 * fq;
#pragma unroll
        for (int ai = 0; ai < 2; ++ai)
#pragma unroll
            for (int m = 0; m < 4; ++m) { const size_t r = (size_t)(row0 + ai * HALF + m * 16);
#pragma unroll
                for (int bj = 0; bj < 2; ++bj) { const int c = col0 + bj * HALF;
                    const u32x4 gw = *(const u32x4*)(G + r * 6144 + c);
                    f32x4 a0 = acc[ai][bj][m][0], a1 = acc[ai][bj][m][1];
                    a0[0] *= sigmoid_f(bf_lo(gw.x)); a0[1] *= sigmoid_f(bf_hi(gw.x)); a0[2] *= sigmoid_f(bf_lo(gw.y)); a0[3] *= sigmoid_f(bf_hi(gw.y));
                    a1[0] *= sigmoid_f(bf_lo(gw.z)); a1[1] *= sigmoid_f(bf_hi(gw.z)); a1[2] *= sigmoid_f(bf_lo(gw.w)); a1[3] *= sigmoid_f(bf_hi(gw.w));
                    f32x4* tp = (f32x4*)(T + r * 2048 + c);
                    if (MODE == 0) { tp[0] = a0; tp[1] = a1; }
                    else if (MODE == 1) { tp[0] = tp[0] + a0; tp[1] = tp[1] + a1; }
                    else { a0 = a0 + tp[0]; a1 = a1 + tp[1];
                        u32x4 w; w.x = cvt_pk_bf16(a0[0], a0[1]); w.y = cvt_pk_bf16(a0[2], a0[3]); w.z = cvt_pk_bf16(a1[0], a1[1]); w.w = cvt_pk_bf16(a1[2], a1[3]);
                        *(u32x4*)(O + r * 2048 + c) = w; }
                    asm volatile("" ::: "memory"); } }
    }
};


struct EpiGate3 {
    static constexpr bool PERM = true, AFTER_DRAIN = false, HAS_HOOK = true;
    static constexpr int H0 = 8, H1 = 24;
    const bf16_t* G; bf16_t* O;
    __device__ __forceinline__ void hook(f32x4 (&acc)[2][2][4][2], const Unit& u, int t, int wr, int wc, int fr, int fq) const {
        const int row0 = u.pm * BM + wr * 64 + fr, col0 = u.pn * BM + wc * 32 + 8 * fq + (t == H0 ? 0 : 2048);
#pragma unroll
        for (int ai = 0; ai < 2; ++ai)
#pragma unroll
            for (int mp = 0; mp < 2; ++mp) { u32x4 ga[2][2], gb[2][2];
#pragma unroll
                for (int mm = 0; mm < 2; ++mm) { const unsigned ro = (unsigned)(row0 + ai * HALF + (2 * mp + mm) * 16) * 12288u + 2u * (unsigned)col0;
#pragma unroll
                    for (int bj = 0; bj < 2; ++bj) { const char* gp = (const char*)G + (ro + 256u * (unsigned)bj); ga[mm][bj] = *(const u32x4*)gp; gb[mm][bj] = *(const u32x4*)(gp + 4096); } }
                asm volatile("" ::: "memory");
#pragma unroll
                for (int mm = 0; mm < 2; ++mm)
#pragma unroll
                    for (int bj = 0; bj < 2; ++bj) { const int m = 2 * mp + mm;
                        const unsigned a4[4] = {ga[mm][bj].x, ga[mm][bj].y, ga[mm][bj].z, ga[mm][bj].w}, b4[4] = {gb[mm][bj].x, gb[mm][bj].y, gb[mm][bj].z, gb[mm][bj].w};
#pragma unroll
                        for (int q = 0; q < 4; ++q) {
                            const float r0 = (1.0f + __expf(-bf_lo(b4[q]))) * __builtin_amdgcn_rcpf(1.0f + __expf(-bf_lo(a4[q]))), r1 = (1.0f + __expf(-bf_hi(b4[q]))) * __builtin_amdgcn_rcpf(1.0f + __expf(-bf_hi(a4[q])));
                            acc[ai][bj][m][q >> 1][2 * (q & 1)] *= r0; acc[ai][bj][m][q >> 1][2 * (q & 1) + 1] *= r1; } }
                asm volatile("" ::: "memory"); }
    }
    __device__ __forceinline__ void operator()(const f32x4 (&acc)[2][2][4][2], const Unit& u, int wr, int wc, int fr, int fq) const {
        const int row0 = u.pm * BM + wr * 64 + fr, col0 = u.pn * BM + wc * 32 + 8 * fq;
#pragma unroll
        for (int ai = 0; ai < 2; ++ai) { u32x4 gw[4][2];
#pragma unroll
            for (int m = 0; m < 4; ++m)
#pragma unroll
                for (int bj = 0; bj < 2; ++bj) gw[m][bj] = *(const u32x4*)((const char*)G + ((unsigned)(row0 + ai * HALF + m * 16) * 12288u + 8192u + 2u * (unsigned)(col0 + bj * HALF)));
            asm volatile("" ::: "memory");
#pragma unroll
            for (int m = 0; m < 4; ++m) { const unsigned rr = (unsigned)(row0 + ai * HALF + m * 16);
#pragma unroll
                for (int bj = 0; bj < 2; ++bj) { const unsigned c = (unsigned)(col0 + bj * HALF); const u32x4 g = gw[m][bj];
                    f32x4 a0 = acc[ai][bj][m][0], a1 = acc[ai][bj][m][1];
                    a0[0] *= sigmoid_f(bf_lo(g.x)); a0[1] *= sigmoid_f(bf_hi(g.x)); a0[2] *= sigmoid_f(bf_lo(g.y)); a0[3] *= sigmoid_f(bf_hi(g.y));
                    a1[0] *= sigmoid_f(bf_lo(g.z)); a1[1] *= sigmoid_f(bf_hi(g.z)); a1[2] *= sigmoid_f(bf_lo(g.w)); a1[3] *= sigmoid_f(bf_hi(g.w));
                    u32x4 w; w.x = cvt_pk_bf16(a0[0], a0[1]); w.y = cvt_pk_bf16(a0[2], a0[3]); w.z = cvt_pk_bf16(a1[0], a1[1]); w.w = cvt_pk_bf16(a1[2], a1[3]);
                    *(u32x4*)((char*)O + (rr * 4096u + 2u * c)) = w; } }
            asm volatile("" ::: "memory"); }
    }
};
template <class Epi, class Sched, bool ALIGN_EPI = false, bool SP2 = false>
__device__ __forceinline__ void gemm_phase(PG8_LAS unsigned char* lds, const Gemm g, const Sched& S, const Epi& E, int tid_in) {
    int tid_raw = tid_in; asm volatile("" : "+v"(tid_raw));
    const int tid = tid_raw, wid = __builtin_amdgcn_readfirstlane(tid >> 6), lane = tid & 63, wr = wid >> 2, wc = wid & 3, fr = lane & 15, fq = lane >> 4;
    const int K = g.K, nt = K / BK;
    unsigned voffA[2], voffB[2];
#pragma unroll
    for (int i = 0; i < 2; ++i) { int R, C; stage_rc(tid * 16 + i * 8192, R, C); const int Rb = Epi::PERM ? ((R & ~31) + perm32(R & 31)) : R;
        voffA[i] = (unsigned)(R * K + C) * 2u; voffB[i] = (unsigned)(Rb * K + C) * 2u; }
    const size_t kstep = (size_t)(BK * 2);
    const size_t hstep = (size_t)HALF * K * 2;
    const size_t tstep = 2 * hstep;
    const unsigned ldsw = (unsigned)wid * 1024u;
    const int aoff = lds_byte(wr * 64 + fr, fq * 8), boff = lds_byte(wc * 32 + fr, fq * 8);
#define PG8_SA(b, h) (((b) * 2 + (h)) * HTB)
#define PG8_SB(b, h) ((4 + (b) * 2 + (h)) * HTB)
#define PG8_STAGE(bufoff, gbase, voff) do { _Pragma("unroll") for (int _i = 0; _i < 2; ++_i) \
        __builtin_amdgcn_global_load_lds((const unsigned*)((const char*)(gbase) + (voff)[_i]), (PG8_LAS unsigned*)(lds + (bufoff) + ldsw + _i * 8192), 16, 0, 0); } while (0)
#define PG8_LDA(dst, b, h) do { _Pragma("unroll") for (int m = 0; m < 4; ++m) _Pragma("unroll") for (int k = 0; k < 2; ++k) dst[m][k] = *(const PG8_LAS bf16x8*)(lds + PG8_SA(b, h) + aoff + m * 2048 + k * 1024); } while (0)
#define PG8_LDB(dst, b, h) do { _Pragma("unroll") for (int n = 0; n < 2; ++n) _Pragma("unroll") for (int k = 0; k < 2; ++k) dst[n][k] = *(const PG8_LAS bf16x8*)(lds + PG8_SB(b, h) + boff + n * 2048 + k * 1024); } while (0)
#define PG8_MMA(ai, bj, At, Bt) do { __builtin_amdgcn_s_setprio(1); _Pragma("unroll") for (int m = 0; m < 4; ++m) _Pragma("unroll") for (int n = 0; n < 2; ++n) _Pragma("unroll") for (int k = 0; k < 2; ++k) \
        acc[ai][bj][m][n] = __builtin_amdgcn_mfma_f32_16x16x32_bf16(Bt[n][k], At[m][k], acc[ai][bj][m][n], 0, 0, 0); __builtin_amdgcn_s_setprio(0); } while (0)
#define PG8_WAIT_V(n) asm volatile("s_waitcnt vmcnt(" #n ")" ::: "memory")
#define PG8_WAIT_L(n) asm volatile("s_waitcnt lgkmcnt(" #n ")" ::: "memory")
#define PG8_BAR __builtin_amdgcn_s_barrier()
#define PG8_SCHED __builtin_amdgcn_sched_barrier(0)
    Unit cur, nxt; int ui = 0;
    if (!S.next(0, cur)) return;
    f32x4 acc[2][2][4][2];
#pragma unroll
    for (int a = 0; a < 2; ++a)
#pragma unroll
        for (int b = 0; b < 2; ++b)
#pragma unroll
            for (int m = 0; m < 4; ++m)
#pragma unroll
                for (int n = 0; n < 2; ++n) acc[a][b][m][n] = (f32x4){0.f, 0.f, 0.f, 0.f};
    bf16x8 At[4][2], B0[2][2], B1[2][2];
    const char* cA = (const char*)g.A + (size_t)cur.pm * tstep; const char* cB = (const char*)g.Bt + (size_t)cur.pn * tstep;
    S.a_ready(cur);
    if constexpr (SP2) {
        PG8_STAGE(PG8_SB(0, 0), cB, voffB); PG8_STAGE(PG8_SB(0, 1), cB + hstep, voffB); PG8_STAGE(PG8_SA(0, 0), cA, voffA); PG8_STAGE(PG8_SA(0, 1), cA + hstep, voffA);
        if (wr == 1) PG8_BAR;
        PG8_WAIT_V(2); PG8_BAR;
        PG8_STAGE(PG8_SB(1, 0), cB + kstep, voffB); PG8_STAGE(PG8_SA(1, 0), cA + kstep, voffA); PG8_STAGE(PG8_SB(1, 1), cB + hstep + kstep, voffB);
        PG8_WAIT_V(6); PG8_BAR;
    } else {
        PG8_STAGE(PG8_SB(0, 0), cB, voffB); PG8_STAGE(PG8_SA(0, 0), cA, voffA); PG8_STAGE(PG8_SB(0, 1), cB + hstep, voffB); PG8_STAGE(PG8_SA(0, 1), cA + hstep, voffA);
        if (wr == 1) PG8_BAR;
        PG8_WAIT_V(4); PG8_BAR;
        PG8_STAGE(PG8_SB(1, 0), cB + kstep, voffB); PG8_STAGE(PG8_SA(1, 0), cA + kstep, voffA); PG8_STAGE(PG8_SB(1, 1), cB + hstep + kstep, voffB);
        PG8_WAIT_V(6); PG8_BAR;
    }
    for (;;) {
        const bool has_next = S.next(ui + 1, nxt);
        const char* nA = has_next ? (const char*)g.A + (size_t)nxt.pm * tstep : cA; const char* nB = has_next ? (const char*)g.Bt + (size_t)nxt.pn * tstep : cB;
        for (int t = 0; t < nt; t += 2) {
            const bool last = (t == nt - 2);
            const char* a1 = cA + (size_t)(t + 1) * kstep;
            const char* a2 = last ? nA : cA + (size_t)(t + 2) * kstep; const char* b2 = last ? nB : cB + (size_t)(t + 2) * kstep;
            const char* a3 = a2 + kstep; const char* b3 = b2 + kstep;
            if (last && has_next) S.a_ready(nxt);
            if constexpr (Epi::HAS_HOOK) { if (t == Epi::H0 || t == Epi::H1) { E.hook(acc, cur, t, wr, wc, fr, fq); PG8_WAIT_V(0); } }
            if constexpr (SP2) {
            PG8_LDB(B0, 0, 0); PG8_LDB(B1, 0, 1); PG8_SCHED; PG8_LDA(At, 0, 0); PG8_STAGE(PG8_SA(1, 1), a1 + hstep, voffA);
            PG8_WAIT_V(8); PG8_WAIT_L(0); PG8_BAR; PG8_MMA(0, 0, At, B0); PG8_MMA(0, 1, At, B1); PG8_BAR; PG8_SCHED;
            PG8_LDA(At, 0, 1); PG8_STAGE(PG8_SB(0, 0), b2, voffB); PG8_STAGE(PG8_SB(0, 1), b2 + hstep, voffB); PG8_STAGE(PG8_SA(0, 0), a2, voffA);
            PG8_WAIT_V(8); PG8_WAIT_L(0); PG8_BAR; PG8_MMA(1, 0, At, B0); PG8_MMA(1, 1, At, B1); PG8_BAR; PG8_SCHED;
            PG8_LDB(B0, 1, 0); PG8_LDB(B1, 1, 1); PG8_SCHED; PG8_LDA(At, 1, 0); PG8_STAGE(PG8_SA(0, 1), a2 + hstep, voffA);
            PG8_WAIT_V(8); PG8_WAIT_L(0); PG8_BAR; PG8_MMA(0, 0, At, B0); PG8_MMA(0, 1, At, B1); PG8_BAR; PG8_SCHED;
            PG8_LDA(At, 1, 1); PG8_STAGE(PG8_SB(1, 0), b3, voffB); PG8_STAGE(PG8_SB(1, 1), b3 + hstep, voffB); PG8_STAGE(PG8_SA(1, 0), a3, voffA);
            PG8_WAIT_V(8); PG8_WAIT_L(0); PG8_BAR; PG8_MMA(1, 0, At, B0); PG8_MMA(1, 1, At, B1); PG8_BAR; PG8_SCHED;
            } else {
            PG8_LDB(B0, 0, 0); PG8_SCHED; PG8_LDA(At, 0, 0); PG8_STAGE(PG8_SA(1, 1), a1 + hstep, voffA);
            PG8_WAIT_L(8); PG8_BAR; PG8_WAIT_L(0); PG8_MMA(0, 0, At, B0); PG8_BAR; PG8_SCHED;
            PG8_LDB(B1, 0, 1); PG8_STAGE(PG8_SB(0, 0), b2, voffB);
            PG8_BAR; PG8_WAIT_L(0); PG8_MMA(0, 1, At, B1); PG8_BAR;
            PG8_LDA(At, 0, 1); PG8_STAGE(PG8_SA(0, 0), a2, voffA);
            PG8_BAR; PG8_WAIT_L(0); PG8_MMA(1, 0, At, B0); PG8_BAR; PG8_SCHED;
            PG8_STAGE(PG8_SB(0, 1), b2 + hstep, voffB);
            PG8_WAIT_V(6); PG8_BAR; PG8_MMA(1, 1, At, B1); PG8_BAR;
            PG8_LDB(B0, 1, 0); PG8_SCHED; PG8_LDA(At, 1, 0); PG8_STAGE(PG8_SA(0, 1), a2 + hstep, voffA);
            PG8_WAIT_L(8); PG8_BAR; PG8_WAIT_L(0); PG8_MMA(0, 0, At, B0); PG8_BAR; PG8_SCHED;
            PG8_LDB(B1, 1, 1); PG8_STAGE(PG8_SB(1, 0), b3, voffB);
            PG8_BAR; PG8_WAIT_L(0); PG8_MMA(0, 1, At, B1); PG8_BAR;
            PG8_LDA(At, 1, 1); PG8_STAGE(PG8_SA(1, 0), a3, voffA);
            PG8_BAR; PG8_WAIT_L(0); PG8_MMA(1, 0, At, B0); PG8_BAR; PG8_SCHED;
            PG8_STAGE(PG8_SB(1, 1), b3 + hstep, voffB);
            PG8_WAIT_V(6); PG8_BAR; PG8_MMA(1, 1, At, B1); PG8_BAR;
            }
        }
        if constexpr (ALIGN_EPI) { if (wr == 0) PG8_BAR; }
        if constexpr (!Epi::AFTER_DRAIN) { E(acc, cur, wr, wc, fr, fq); S.done(cur); }
        if (!has_next) break;
#pragma unroll
        for (int a = 0; a < 2; ++a)
#pragma unroll
            for (int b = 0; b < 2; ++b)
#pragma unroll
                for (int m = 0; m < 4; ++m)
#pragma unroll
                    for (int n = 0; n < 2; ++n) acc[a][b][m][n] = (f32x4){0.f, 0.f, 0.f, 0.f};
        cur = nxt; cA = nA; cB = nB; ++ui;
        if constexpr (ALIGN_EPI) { if (wr == 1) PG8_BAR; }
    }
    PG8_WAIT_V(0);
    if constexpr (!ALIGN_EPI) { if (wr == 0) PG8_BAR; }
    PG8_BAR;
    if constexpr (Epi::AFTER_DRAIN) { E.fused(acc, cur, wr, wc, fr, fq, lds, wid, lane); S.done(cur); }
#undef PG8_SA
#undef PG8_SB
#undef PG8_STAGE
#undef PG8_LDA
#undef PG8_LDB
#undef PG8_MMA
#undef PG8_WAIT_V
#undef PG8_WAIT_L
#undef PG8_BAR
#undef PG8_SCHED
}
}

constexpr int NWAVES = 8;
constexpr int M = 16384, D = 2048, FF = 5632, SEQ = 2048, DEPTH = 4;
constexpr int NIN_PAD = 18432;
constexpr float NORM_EPS = 1e-6f;
#ifndef MK_PER_PHASE
#define MK_PER_PHASE 0
#endif
constexpr int PH_PER_LAYER = 13, N_PHASES = DEPTH * PH_PER_LAYER + 1;

constexpr size_t MiB = 1u << 20;
constexpr size_t WS_CTL = 0, CTL_ZERO_BYTES = 1 * MiB;
constexpr size_t WS_WB = 1 * MiB;
constexpr size_t W_GU1 = 0, W_D1 = 23068672, W_IN = 34603008, W_PA = 72351744, W_PB = 73400320, W_PC = 75497472, W_WO = 77594624, W_GU2 = 81788928, W_D2 = 104857600;
constexpr size_t WS_H = 223 * MiB;
constexpr size_t WS_CA = 287 * MiB, WS_CB = 431 * MiB, WS_CC = 559 * MiB, WS_CG = 671 * MiB;
constexpr size_t WS_ACT = WS_CA;
constexpr size_t WS_QR = 863 * MiB, WS_KR = 895 * MiB, WS_KT = 927 * MiB, WS_VT = 959 * MiB;
constexpr size_t WS_FR = 991 * MiB, WS_UF = 1095 * MiB, WS_GSC = 1865 * MiB, WS_GO = 1160 * MiB;
constexpr size_t WS_MT = 863 * MiB;
constexpr size_t WS_RSO = 1224 * MiB, WS_RO = 1520 * MiB, WS_VS = 1584 * MiB, WS_GS = 1616 * MiB, WS_BON = 1648 * MiB, WS_LW = 1649 * MiB;
constexpr size_t WS_SCR = 1672 * MiB;
constexpr size_t WS_YA = 1672 * MiB, WS_YB = 1688 * MiB, WS_YC = 1720 * MiB;
constexpr size_t WS_MB = 1752 * MiB;
constexpr size_t WS_OG = 1816 * MiB, WS_LSE = 1864 * MiB;
constexpr size_t WS_BON2 = 1867 * MiB;
constexpr size_t WS_END = 1869 * MiB;
constexpr int CW_BAR = 4096, CW_ATT = 16384;

constexpr int RING_OFF = 0, RING_BYTES = 131072;
constexpr int LDSCTL_OFF = RING_BYTES, MISC_OFF = LDSCTL_OFF + 320;
constexpr int LDS_BYTES = 147456;

#define GAS __attribute__((address_space(1)))
#define LAS __attribute__((address_space(3)))
typedef unsigned short bf16;
typedef unsigned v4u __attribute__((ext_vector_type(4)));
typedef unsigned v2u __attribute__((ext_vector_type(2)));
typedef float f32x4 __attribute__((ext_vector_type(4)));
typedef float f32x2 __attribute__((ext_vector_type(2)));
typedef float f32x16 __attribute__((ext_vector_type(16)));
#define LDS_WAIT() asm volatile("s_waitcnt lgkmcnt(0)" ::: "memory")
#define WAVE_SYNC() do { asm volatile("s_waitcnt lgkmcnt(0)" ::: "memory"); __builtin_amdgcn_wave_barrier(); asm volatile("" ::: "memory"); } while (0)
using pg8::cvt_pk_bf16; using pg8::bf_lo; using pg8::bf_hi; using pg8::sigmoid_f; using pg8::silu_f;

__device__ __forceinline__ float wave_sum(float v) {
#pragma unroll
    for (int o = 1; o < 64; o <<= 1) v += __shfl_xor(v, o);
    return v;
}
__device__ __forceinline__ float wave_max(float v) {
#pragma unroll
    for (int o = 1; o < 64; o <<= 1) v = fmaxf(v, __shfl_xor(v, o));
    return v;
}
__device__ __forceinline__ float softplus_f(float x) { const float e = __expf(x); return x > 20.f ? x : (x < -10.f ? e : __logf(1.0f + e)); }

struct MapId { __device__ __forceinline__ int operator()(int n) const { return n; } };
struct MapGu { __device__ __forceinline__ int operator()(int n) const { return (n >> 8) * 128 + (n & 127) + ((n >> 7) & 1) * FF; } };
struct MapIn { __device__ __forceinline__ int operator()(int n) const {
    if (n < 8704) return n;
    if (n < 12224) return n + 16;
    if (n < 12240) return 8704 + (n - 12224);
    if (n < 12288) return -1;
    return n - 48; } };
template <class Map>
__device__ __forceinline__ void conv_matrix(const float* W, int K, int N, bf16* WT, int NP, Map map, LAS float* scr, int& rot, int gw, int NGW, int lane, int KP = 0, int pitch = 0) {
    if (KP == 0) KP = K;  if (pitch == 0) pitch = KP;
    const int nblk = NP / 32, nitems = (KP / 64) * nblk;
    int start = gw - rot; if (start < 0) start += NGW;
    for (int it = start; it < nitems; it += 2 * NGW) {
        const bool has2 = it + NGW < nitems;
        f32x16 wv[2][2]; int k0_[2], n0_[2], sc_[2];
#pragma unroll
        for (int u = 0; u < 2; ++u) { const int itu = (u == 1 && has2) ? it + NGW : it; const int kb = itu / nblk, nb = itu % nblk; k0_[u] = 64 * kb; n0_[u] = 32 * nb; sc_[u] = map(n0_[u] + (lane & 31));
            const float* wp = W + (sc_[u] >= 0 ? sc_[u] : 0);
#pragma unroll
            for (int i = 0; i < 32; ++i) { int kr = k0_[u] + 2 * i + (lane >> 5); kr = kr < K ? kr : K - 1; wv[u][i >> 4][i & 15] = wp[(size_t)kr * N]; } }
        asm volatile("" :: "v"(wv[0][0]), "v"(wv[0][1]), "v"(wv[1][0]), "v"(wv[1][1]) : "memory");
#pragma unroll
        for (int u = 0; u < 2; ++u) { if (u == 1 && !has2) break;
            const int k0 = k0_[u], n0 = n0_[u]; const bool cok = sc_[u] >= 0;
#pragma unroll
            for (int i = 0; i < 32; ++i) scr[(2 * i + (lane >> 5)) * 33 + (lane & 31)] = (cok && k0 + 2 * i + (lane >> 5) < K) ? wv[u][i >> 4][i & 15] : 0.f;
            LDS_WAIT(); asm volatile("" ::: "memory");
            const int c = lane & 7;
#pragma unroll
            for (int j = 0; j < 4; ++j) { const int n = (lane >> 3) + 8 * j; const LAS float* s = scr + (8 * c) * 33 + n;
                v4u o; o.x = cvt_pk_bf16(s[0 * 33], s[1 * 33]); o.y = cvt_pk_bf16(s[2 * 33], s[3 * 33]); o.z = cvt_pk_bf16(s[4 * 33], s[5 * 33]); o.w = cvt_pk_bf16(s[6 * 33], s[7 * 33]);
                *(v4u*)(WT + (size_t)(n0 + n) * pitch + k0 + 8 * c) = o; }
            LDS_WAIT(); asm volatile("" ::: "memory"); }
    }
    rot = (rot + nitems) % NGW;
}

__device__ __forceinline__ void norm_rows(const float* xs, float* xcopy, const float* gain, bf16* hout, int gw, int NGW, int lane) {
    f32x4 g[8];
#pragma unroll
    for (int j = 0; j < 8; ++j) g[j] = ((const f32x4*)gain)[lane + 64 * j];
    for (int m2 = gw * 2; m2 < M; m2 += NGW * 2) {
        f32x4 v[2][8]; float s[2] = {0.f, 0.f};
#pragma unroll
        for (int q = 0; q < 2; ++q) { const f32x4* xr = (const f32x4*)(xs + (size_t)(m2 + q) * D) + lane;
#pragma unroll
            for (int j = 0; j < 8; ++j) v[q][j] = xr[64 * j]; }
#pragma unroll
        for (int q = 0; q < 2; ++q) {
#pragma unroll
            for (int j = 0; j < 8; ++j) s[q] += (v[q][j].x * v[q][j].x + v[q][j].y * v[q][j].y) + (v[q][j].z * v[q][j].z + v[q][j].w * v[q][j].w);
            s[q] = wave_sum(s[q]); const float rs = 1.0f / sqrtf(s[q] * (1.0f / D) + NORM_EPS);
            if (xcopy) {
#pragma unroll
                for (int j = 0; j < 8; ++j) ((f32x4*)(xcopy + (size_t)(m2 + q) * D))[lane + 64 * j] = v[q][j]; }
            v2u* o8 = (v2u*)(hout + (size_t)(m2 + q) * D) + lane;
#pragma unroll
            for (int j = 0; j < 8; ++j) { v2u o; o.x = cvt_pk_bf16(v[q][j].x * rs * g[j].x, v[q][j].y * rs * g[j].y); o.y = cvt_pk_bf16(v[q][j].z * rs * g[j].z, v[q][j].w * rs * g[j].w); o8[64 * j] = o; } }
    }
}
__device__ __forceinline__ void final_norm_rows(float* x, const float* gain, int gw, int NGW, int lane) {
    f32x4 g[8];
#pragma unroll
    for (int j = 0; j < 8; ++j) g[j] = ((const f32x4*)gain)[lane + 64 * j];
    for (int m2 = gw * 2; m2 < M; m2 += NGW * 2) {
        f32x4 v[2][8];
#pragma unroll
        for (int q = 0; q < 2; ++q) { const f32x4* xr = (const f32x4*)(x + (size_t)(m2 + q) * D) + lane;
#pragma unroll
            for (int j = 0; j < 8; ++j) v[q][j] = xr[64 * j]; }
        asm volatile("" :: "v"(v[0][0]), "v"(v[0][1]), "v"(v[0][2]), "v"(v[0][3]), "v"(v[0][4]), "v"(v[0][5]), "v"(v[0][6]), "v"(v[0][7]), "v"(v[1][0]), "v"(v[1][1]), "v"(v[1][2]), "v"(v[1][3]), "v"(v[1][4]), "v"(v[1][5]), "v"(v[1][6]), "v"(v[1][7]) : "memory");
#pragma unroll
        for (int q = 0; q < 2; ++q) { float s = 0.f;
#pragma unroll
            for (int j = 0; j < 8; ++j) s += (v[q][j].x * v[q][j].x + v[q][j].y * v[q][j].y) + (v[q][j].z * v[q][j].z + v[q][j].w * v[q][j].w);
            s = wave_sum(s); const float rs = 1.0f / sqrtf(s * (1.0f / D) + NORM_EPS);
            f32x4* xw = (f32x4*)(x + (size_t)(m2 + q) * D) + lane;
#pragma unroll
            for (int j = 0; j < 8; ++j) xw[64 * j] = v[q][j] * rs * g[j]; }
    }
}

template <int CTRL> __device__ __forceinline__ float dppf(float x) { return __builtin_bit_cast(float, __builtin_amdgcn_update_dpp(0, __builtin_bit_cast(int, x), CTRL, 0xf, 0xf, false)); }
__device__ __forceinline__ void gdn_post(const bf16* GO, const bf16* cB, const float* norm_w, bf16* YB, int gtid, int nthr) {
    const int c8 = gtid & 127, j16 = c8 & 15;
    float nw[8];
#pragma unroll
    for (int e = 0; e < 8; ++e) nw[e] = norm_w[8 * j16 + e];
    for (int m4 = (gtid >> 7) * 4; m4 < M; m4 += (nthr >> 7) * 4) {
        v4u ow[4], zw[4];
#pragma unroll
        for (int j = 0; j < 4; ++j) { const size_t o = (size_t)(m4 + j) * 1024 + 8 * c8; ow[j] = *(const v4u*)(GO + o); zw[j] = *(const v4u*)(cB + (size_t)(m4 + j) * 4096 + 3072 + 8 * c8); }
        asm volatile("" :: "v"(ow[0]), "v"(ow[1]), "v"(ow[2]), "v"(ow[3]), "v"(zw[0]), "v"(zw[1]), "v"(zw[2]), "v"(zw[3]) : "memory");
        f32x4 oa[4], ob[4];
#pragma unroll
        for (int j = 0; j < 4; ++j) { oa[j] = (f32x4){bf_lo(ow[j].x), bf_hi(ow[j].x), bf_lo(ow[j].y), bf_hi(ow[j].y)}; ob[j] = (f32x4){bf_lo(ow[j].z), bf_hi(ow[j].z), bf_lo(ow[j].w), bf_hi(ow[j].w)}; }
#pragma unroll
        for (int j = 0; j < 4; ++j) {
            float ss = (oa[j].x * oa[j].x + oa[j].y * oa[j].y) + (oa[j].z * oa[j].z + oa[j].w * oa[j].w) + (ob[j].x * ob[j].x + ob[j].y * ob[j].y) + (ob[j].z * ob[j].z + ob[j].w * ob[j].w);
            ss += dppf<0xB1>(ss); ss += dppf<0x4E>(ss); ss += dppf<0x141>(ss); ss += dppf<0x140>(ss);
            const float rs = 1.0f / sqrtf(ss * (1.0f / 128.0f) + NORM_EPS);
            v4u w;
            w.x = cvt_pk_bf16(oa[j].x * rs * nw[0] * silu_f(bf_lo(zw[j].x)), oa[j].y * rs * nw[1] * silu_f(bf_hi(zw[j].x)));
            w.y = cvt_pk_bf16(oa[j].z * rs * nw[2] * silu_f(bf_lo(zw[j].y)), oa[j].w * rs * nw[3] * silu_f(bf_hi(zw[j].y)));
            w.z = cvt_pk_bf16(ob[j].x * rs * nw[4] * silu_f(bf_lo(zw[j].z)), ob[j].y * rs * nw[5] * silu_f(bf_hi(zw[j].z)));
            w.w = cvt_pk_bf16(ob[j].z * rs * nw[6] * silu_f(bf_lo(zw[j].w)), ob[j].w * rs * nw[7] * silu_f(bf_hi(zw[j].w)));
            *(v4u*)(YB + (size_t)(m4 + j) * 2560 + 8 * c8) = w; }
    }
}


typedef short bf16x8 __attribute__((ext_vector_type(8)));
typedef short s16x4 __attribute__((ext_vector_type(4)));
#define MFMA32(a, b, c) __builtin_amdgcn_mfma_f32_32x32x16_bf16((a), (b), (c), 0, 0, 0)
template <int S2> __device__ __forceinline__ bf16x8 pack8(const f32x16& v) {
    v4u w; w.x = cvt_pk_bf16(v[8 * S2 + 0], v[8 * S2 + 1]); w.y = cvt_pk_bf16(v[8 * S2 + 2], v[8 * S2 + 3]); w.z = cvt_pk_bf16(v[8 * S2 + 4], v[8 * S2 + 5]); w.w = cvt_pk_bf16(v[8 * S2 + 6], v[8 * S2 + 7]);
    return __builtin_bit_cast(bf16x8, w);
}
__device__ __forceinline__ f32x16 zero16() { f32x16 z;
#pragma unroll
    for (int i = 0; i < 16; ++i) { float t; asm volatile("v_mov_b32 %0, 0" : "=v"(t)); z[i] = t; } return z; }
__device__ __forceinline__ unsigned off_b(unsigned row, unsigned ch) { return 256u * row + 16u * (ch ^ (((row & 3u) << 2) | ((row >> 2) & 3u))); }

__device__ __forceinline__ void attn_phase(const bf16* cA, bf16* OG, float* LSE, LAS unsigned char* lds, int tid, int blk, int nblk) {
    const int lane = tid & 63, hf = tid >> 8, tl = tid & 255, wq = hf ? 3 - ((tid >> 6) & 3) : (tid >> 6) & 3, l31 = lane & 31, half = lane >> 5;
    LAS unsigned char* Ks = lds + hf * 65536; LAS unsigned char* Vs = Ks + 32768;
    const int blk16 = (lane >> 4) & 1, q4 = (lane & 15) >> 2, p4 = lane & 3;
    for (int pi0 = blk; pi0 < 768; pi0 += nblk) {
        const int pi = (nblk & 7) == 0 ? pi0 - blk + (blk & 7) * (nblk >> 3) + (blk >> 3) : pi0;
        const int unit = 2 * pi + hf, g = unit >> 9, rem = unit & 511;
        const int b = rem >> 6, slot = (rem >> 4) & 3;
        int res, qb, dil;
        if (g == 0) { res = 0; qb = rem & 15; dil = 1; } else if (g == 1) { res = (rem >> 2) & 3; qb = rem & 3; dil = 4; } else { res = rem & 15; qb = 0; dil = 16; }
        const int h = 4 * g + slot;
        const size_t rowstride = (size_t)dil * 4608;
        const bf16* base = cA + ((size_t)b * SEQ + res) * 4608 + h * 128;
        const int iq = 128 * qb + 32 * wq + l31;
        bf16x8 qf[8];
        { const bf16* qp = base + (size_t)iq * rowstride + 8 * half;
#pragma unroll
          for (int s = 0; s < 8; ++s) qf[s] = *(const bf16x8*)(qp + 16 * s); }
        f32x16 O[4];
#pragma unroll
        for (int c = 0; c < 4; ++c) O[c] = zero16();
        float mrun = -1e30f, lsum = 0.f;
        const float sc2 = 0.08838834764831845f * 1.4426950408889634f, sl2 = exp2f(-8.0f * (float)(h + 1) / 12.0f) * (float)dil * 1.4426950408889634f;
        const int nslot = g == 2 ? 1 : 2;
#pragma unroll 1
        for (int pslot = 0; pslot < nslot; ++pslot) {
            const int pass = pslot;
            const int kb = qb - pass; const bool have = kb >= 0;
            if (have) {
                v4u kreg[8], vreg[8];
#pragma unroll
                for (int it = 0; it < 8; ++it) { const int n = tl + 256 * it, row = n >> 4, ch = n & 15; const bf16* src = base + (size_t)(128 * kb + row) * rowstride + 8 * ch;
                    kreg[it] = *(const v4u*)(src + 1536); vreg[it] = *(const v4u*)(src + 3072); }
#pragma unroll
                for (int it = 0; it < 8; ++it) { const int n = tl + 256 * it, row = n >> 4, ch = n & 15; const unsigned o = off_b(row, ch);
                    *(LAS v4u*)(Ks + o) = kreg[it]; *(LAS v4u*)(Vs + o) = vreg[it]; }
            }
            __syncthreads();
            if (have) {
#pragma unroll 1
                for (int kj = 0; kj < 4; ++kj) {
                    if (pass == 0 ? (kj > wq) : (kj < wq)) continue;
                    f32x16 acc = zero16();
#pragma unroll
                    for (int s = 0; s < 8; ++s) { const bf16x8 kf = *(const LAS bf16x8*)(Ks + off_b(32 * kj + l31, 2 * s + half)); acc = MFMA32(kf, qf[s], acc); }
                    const int d0 = (pass == 0 ? 0 : 128) + 32 * wq + l31 - 32 * kj - 4 * half;
                    float mloc = -1e30f, ps = 0.f, mnew, alpha;
                    const float cb = -sl2 * (float)d0;
                    if (kj == wq) {
#pragma unroll
                        for (int r = 0; r < 16; ++r) { const int kr = 8 * (r >> 2) + (r & 3); const bool valid = pass == 0 ? (kr <= d0) : (d0 - kr <= 128);
                            const float sv = valid ? __builtin_fmaf(acc[r], sc2, __builtin_fmaf(sl2, (float)kr, cb)) : -1e30f; acc[r] = sv; mloc = fmaxf(mloc, sv); }
                        mloc = fmaxf(mloc, __shfl_xor(mloc, 32));
                        mnew = fmaxf(mrun, mloc); alpha = __builtin_amdgcn_exp2f(mrun - mnew); mrun = mnew;
#pragma unroll
                        for (int r = 0; r < 16; ++r) { const float p = acc[r] > -1e29f ? __builtin_amdgcn_exp2f(acc[r] - mnew) : 0.f; acc[r] = p; ps += p; }
                    } else {
#pragma unroll
                        for (int r = 0; r < 16; ++r) { const float sv = __builtin_fmaf(acc[r], sc2, __builtin_fmaf(sl2, (float)(8 * (r >> 2) + (r & 3)), cb)); acc[r] = sv; mloc = fmaxf(mloc, sv); }
                        mloc = fmaxf(mloc, __shfl_xor(mloc, 32));
                        mnew = fmaxf(mrun, mloc); alpha = __builtin_amdgcn_exp2f(mrun - mnew); mrun = mnew;
#pragma unroll
                        for (int r = 0; r < 16; ++r) { const float p = __builtin_amdgcn_exp2f(acc[r] - mnew); acc[r] = p; ps += p; }
                    }
                    lsum = lsum * alpha + ps;
                    if (!__all(alpha == 1.0f)) {
#pragma unroll
                        for (int c = 0; c < 4; ++c)
#pragma unroll
                            for (int r = 0; r < 16; ++r) O[c][r] *= alpha; }
                    const bf16x8 pf0 = pack8<0>(acc), pf1 = pack8<1>(acc);
#pragma unroll
                    for (int s2 = 0; s2 < 2; ++s2)
#pragma unroll
                        for (int c = 0; c < 4; ++c) {
                            const unsigned rb0 = 32 * kj + 16 * s2 + 4 * half + q4, ch = 4 * c + 2 * blk16 + (p4 >> 1);
                            const s16x4 v0 = __builtin_amdgcn_ds_read_tr16_b64_v4i16((LAS s16x4*)(Vs + off_b(rb0, ch) + 8 * (p4 & 1)));
                            const s16x4 v1 = __builtin_amdgcn_ds_read_tr16_b64_v4i16((LAS s16x4*)(Vs + off_b(rb0 + 8, ch) + 8 * (p4 & 1)));
                            bf16x8 vf; vf[0] = v0[0]; vf[1] = v0[1]; vf[2] = v0[2]; vf[3] = v0[3]; vf[4] = v1[0]; vf[5] = v1[1]; vf[6] = v1[2]; vf[7] = v1[3];
                            O[c] = MFMA32(vf, s2 == 0 ? pf0 : pf1, O[c]);
                        }
                }
            }
            __syncthreads();
        }
        const float ltot = lsum + __shfl_xor(lsum, 32), inv = 1.0f / ltot;
        const size_t mq = (size_t)b * SEQ + res + (size_t)iq * dil;
        bf16* op = OG + ((size_t)g * M + mq) * 512 + slot * 128 + 4 * half;
#pragma unroll
        for (int c = 0; c < 4; ++c)
#pragma unroll
            for (int gi = 0; gi < 4; ++gi) { v2u w; w.x = cvt_pk_bf16(O[c][4 * gi] * inv, O[c][4 * gi + 1] * inv); w.y = cvt_pk_bf16(O[c][4 * gi + 2] * inv, O[c][4 * gi + 3] * inv);
                *(v2u*)(op + 32 * c + 8 * gi) = w; }
        if (half == 0) LSE[((size_t)g * M + mq) * 4 + slot] = mrun * 0.6931471805599453f + __logf(ltot);
    }
}
__device__ __forceinline__ void attn_combine(const bf16* OG, const float* LSE, bf16* YA, int gtid, int nthr) {
    for (int it0 = gtid; it0 < M * 64; it0 += 4 * nthr) {
        float l[4][3]; v4u og[4][3];
#pragma unroll
        for (int u = 0; u < 4; ++u) { const int it = it0 + u * nthr, m = it >> 6, c8 = it & 63, slot = c8 >> 4;
#pragma unroll
            for (int g = 0; g < 3; ++g) { l[u][g] = LSE[((size_t)g * M + m) * 4 + slot]; og[u][g] = *(const v4u*)(OG + ((size_t)g * M + m) * 512 + 8 * c8); } }
        asm volatile("" :: "v"(l[0][0]), "v"(l[0][1]), "v"(l[0][2]), "v"(l[1][0]), "v"(l[1][1]), "v"(l[1][2]), "v"(l[2][0]), "v"(l[2][1]), "v"(l[2][2]), "v"(l[3][0]), "v"(l[3][1]), "v"(l[3][2]),
                     "v"(og[0][0]), "v"(og[0][1]), "v"(og[0][2]), "v"(og[1][0]), "v"(og[1][1]), "v"(og[1][2]), "v"(og[2][0]), "v"(og[2][1]), "v"(og[2][2]), "v"(og[3][0]), "v"(og[3][1]), "v"(og[3][2]) : "memory");
#pragma unroll
        for (int u = 0; u < 4; ++u) { const int it = it0 + u * nthr, m = it >> 6, c8 = it & 63;
            const float l0 = l[u][0], l1 = l[u][1], l2 = l[u][2];
            const float mx = fmaxf(l0, fmaxf(l1, l2)); float w0 = __expf(l0 - mx), w1 = __expf(l1 - mx), w2 = __expf(l2 - mx); const float inv = 1.0f / (w0 + w1 + w2); w0 *= inv; w1 *= inv; w2 *= inv;
            const v4u a = og[u][0], b = og[u][1], c = og[u][2];
            v4u o;
            o.x = cvt_pk_bf16(w0 * bf_lo(a.x) + w1 * bf_lo(b.x) + w2 * bf_lo(c.x), w0 * bf_hi(a.x) + w1 * bf_hi(b.x) + w2 * bf_hi(c.x));
            o.y = cvt_pk_bf16(w0 * bf_lo(a.y) + w1 * bf_lo(b.y) + w2 * bf_lo(c.y), w0 * bf_hi(a.y) + w1 * bf_hi(b.y) + w2 * bf_hi(c.y));
            o.z = cvt_pk_bf16(w0 * bf_lo(a.z) + w1 * bf_lo(b.z) + w2 * bf_lo(c.z), w0 * bf_hi(a.z) + w1 * bf_hi(b.z) + w2 * bf_hi(c.z));
            o.w = cvt_pk_bf16(w0 * bf_lo(a.w) + w1 * bf_lo(b.w) + w2 * bf_lo(c.w), w0 * bf_hi(a.w) + w1 * bf_hi(b.w) + w2 * bf_hi(c.w));
            *(v4u*)(YA + (size_t)m * 2560 + 8 * c8) = o; }
    }
}

constexpr int GFR_BYTES = 26 * 1024;
__device__ __forceinline__ void gdn_prep_unit(const bf16* cB, const bf16* cC, const float* convw, const float* a_log, const float* dt_bias,
                                              bf16* QR, bf16* KR, bf16* KT, bf16* VT, unsigned char* FR, float* UF, float* GSC, int unit, int lane, LAS unsigned char* wlb) {
    const int grp = unit >> 3, h = unit & 7, m0 = grp * 64, m = m0 + lane, t0 = m0 & (SEQ - 1), l31 = lane & 31, half = lane >> 5;
    LAS float* Lg = (LAS float*)wlb; LAS float* Lbr = Lg + 64; LAS float* Lrk = Lg + 128; LAS float* Lrq = Lg + 192; LAS float* Lb = Lg + 256; LAS float* Lt2 = Lg + 320;
    LAS float* Acol = Lg + 384;
    LAS float* Lss = Lg + 384;
    bf16x8 kfr[2][8], qfr[2][8];
    { LAS unsigned char* KSL = (LAS unsigned char*)(Lss + 256);
#pragma unroll
      for (int sc = 0; sc < 2; ++sc)
#pragma unroll
      for (int qk = 0; qk < 2; ++qk) {
        int lz = lane; asm volatile("" : "+v"(lz));
        { const int c16 = lz & 15, t8 = lz >> 4, col = qk * 1024 + h * 128 + 8 * c16, tb = 32 * sc + 8 * t8;
          f32x4 wa[4], wb[4];
#pragma unroll
          for (int j = 0; j < 4; ++j) { wa[j] = *(const f32x4*)(convw + j * 3072 + col); wb[j] = *(const f32x4*)(convw + j * 3072 + col + 4); }
          const bf16* rowp = cB + (size_t)(m0 + tb) * 4096 + col; const bool hasp = t0 + tb > 0;
          v4u xs[8], xp[3];
#pragma unroll
          for (int i = 0; i < 8; ++i) xs[i] = *(const v4u*)(rowp + (size_t)i * 4096);
#pragma unroll
          for (int i = 0; i < 3; ++i) xp[i] = *(const v4u*)(hasp ? rowp - (3 - i) * 4096 : rowp);
          asm volatile("" :: "v"(xs[0]), "v"(xs[1]), "v"(xs[2]), "v"(xs[3]), "v"(xs[4]), "v"(xs[5]), "v"(xs[6]), "v"(xs[7]), "v"(xp[0]), "v"(xp[1]), "v"(xp[2]) : "memory");
          const v4u zz = (v4u){0u, 0u, 0u, 0u}; v4u x0 = hasp ? xp[0] : zz, x1 = hasp ? xp[1] : zz, x2 = hasp ? xp[2] : zz;
          unsigned tbuf[8][4];
#pragma unroll
          for (int ii = 0; ii < 8; ++ii) { const v4u x3 = xs[ii];
              float y[8];
              y[0] = bf_lo(x0.x) * wa[0].x + bf_lo(x1.x) * wa[1].x + bf_lo(x2.x) * wa[2].x + bf_lo(x3.x) * wa[3].x; y[1] = bf_hi(x0.x) * wa[0].y + bf_hi(x1.x) * wa[1].y + bf_hi(x2.x) * wa[2].y + bf_hi(x3.x) * wa[3].y;
              y[2] = bf_lo(x0.y) * wa[0].z + bf_lo(x1.y) * wa[1].z + bf_lo(x2.y) * wa[2].z + bf_lo(x3.y) * wa[3].z; y[3] = bf_hi(x0.y) * wa[0].w + bf_hi(x1.y) * wa[1].w + bf_hi(x2.y) * wa[2].w + bf_hi(x3.y) * wa[3].w;
              y[4] = bf_lo(x0.z) * wb[0].x + bf_lo(x1.z) * wb[1].x + bf_lo(x2.z) * wb[2].x + bf_lo(x3.z) * wb[3].x; y[5] = bf_hi(x0.z) * wb[0].y + bf_hi(x1.z) * wb[1].y + bf_hi(x2.z) * wb[2].y + bf_hi(x3.z) * wb[3].y;
              y[6] = bf_lo(x0.w) * wb[0].z + bf_lo(x1.w) * wb[1].z + bf_lo(x2.w) * wb[2].z + bf_lo(x3.w) * wb[3].z; y[7] = bf_hi(x0.w) * wb[0].w + bf_hi(x1.w) * wb[1].w + bf_hi(x2.w) * wb[2].w + bf_hi(x3.w) * wb[3].w;
              x0 = x1; x1 = x2; x2 = x3;
              float ss = 0.f;
#pragma unroll
              for (int e = 0; e < 8; ++e) { y[e] = silu_f(y[e]); ss += y[e] * y[e]; }
              ss += dppf<0xB1>(ss); ss += dppf<0x4E>(ss); ss += dppf<0x141>(ss); ss += dppf<0x140>(ss);
              if (c16 == 0) Lss[qk * 64 + tb + ii] = ss;
              const unsigned w4[4] = {cvt_pk_bf16(y[0], y[1]), cvt_pk_bf16(y[2], y[3]), cvt_pk_bf16(y[4], y[5]), cvt_pk_bf16(y[6], y[7])};
              LAS unsigned char* dq = KSL + (((c16 >> 2) * 2 + ((c16 >> 1) & 1)) * 64 + 8 * t8 + ii) * 16 + 8 * (c16 & 1);
              *(LAS v2u*)dq = (v2u){w4[0], w4[1]}; *(LAS v2u*)(dq + 512) = (v2u){w4[2], w4[3]};
              if (qk == 0) { unsigned char* gq = FR + (size_t)(unit * 2 + sc) * GFR_BYTES + 8192 + (((c16 >> 2) * 2 + ((c16 >> 1) & 1)) * 64 + 8 * t8 + ii) * 16 + 8 * (c16 & 1);
                  *(v2u*)gq = (v2u){w4[0], w4[1]}; *(v2u*)(gq + 512) = (v2u){w4[2], w4[3]}; }
              if (qk == 1) {
#pragma unroll
              for (int e = 0; e < 8; ++e) { const unsigned hv = (e & 1) ? (w4[e >> 1] >> 16) : (w4[e >> 1] & 0xffffu); tbuf[e][ii >> 1] = (ii & 1) ? (tbuf[e][ii >> 1] | (hv << 16)) : hv; } } }
          if (qk == 1)
#pragma unroll
          for (int e = 0; e < 8; ++e) { unsigned char* dk = FR + (size_t)(unit * 2 + sc) * GFR_BYTES + 16384 + (((c16 >> 2) * 2 + (t8 >> 1)) * 64 + 8 * (c16 & 3) + e) * 16 + 8 * (t8 & 1);
              *(v2u*)dk = (v2u){tbuf[e][0], tbuf[e][1]}; *(v2u*)(dk + 512) = (v2u){tbuf[e][2], tbuf[e][3]}; } }
        WAVE_SYNC();
#pragma unroll
        for (int s = 0; s < 8; ++s) { const bf16x8 f = *(const LAS bf16x8*)(KSL + (s * 64 + lz) * 16); if (qk == 0) qfr[sc][s] = f; else kfr[sc][s] = f; }
        WAVE_SYNC();
      }
    }
    WAVE_SYNC();
    const float ssq = Lss[lane], ssk = Lss[64 + lane];
    WAVE_SYNC();
    const float rq = (1.0f / sqrtf(ssq + 1e-6f)) * 0.08838834764831845f, rk = 1.0f / sqrtf(ssk + 1e-6f);
    const float alpha = bf_lo((unsigned)cC[(size_t)m * 3584 + 3520 + h]), bl = bf_lo((unsigned)cC[(size_t)m * 3584 + 3528 + h]);
    const float ld = -__expf(a_log[h]) * softplus_f(alpha + dt_bias[h]), beta = sigmoid_f(bl);
    float g = ld;
#pragma unroll
    for (int d = 1; d < 32; d <<= 1) { const float yv = __shfl_up(g, d, 32); if (l31 >= d) g += yv; }
    const float glast = __shfl(g, lane | 31), eg = __expf(g);
    Lg[lane] = g; Lbr[lane] = beta * rk; Lrk[lane] = rk; Lrq[lane] = rq; Lb[lane] = beta; Lt2[lane] = beta * rk * eg;
    { int lq = lane; asm volatile("" : "+v"(lq)); GSC[(size_t)unit * 132 + lq] = rq * eg; GSC[(size_t)unit * 132 + 64 + lq] = rk * __expf(glast - g); }
    if (l31 == 31) GSC[(size_t)unit * 132 + 128 + half] = __expf(glast);
    asm volatile("s_waitcnt vmcnt(0)" ::: "memory");
    WAVE_SYNC();
#pragma unroll
    for (int sc = 0; sc < 2; ++sc) {
        f32x16 X, XT;
        { X = zero16(); XT = zero16();
#pragma unroll
          for (int s = 0; s < 8; ++s) { X = MFMA32(kfr[sc][s], kfr[sc][s], X); XT = MFMA32(kfr[sc][s], qfr[sc][s], XT); } }
        const float gcol = Lg[32 * sc + l31], rkcol = Lrk[32 * sc + l31], rqcol = Lrq[32 * sc + l31];
        f32x16 AT;
#pragma unroll
        for (int gi = 0; gi < 4; ++gi) { const int r0 = 8 * gi + 4 * half; const f32x4 gr = *(const LAS f32x4*)(Lg + 32 * sc + r0), br = *(const LAS f32x4*)(Lbr + 32 * sc + r0), kr = *(const LAS f32x4*)(Lrk + 32 * sc + r0);
            f32x4 av;
#pragma unroll
            for (int e = 0; e < 4; ++e) { const int row = r0 + e; const float gre = gr[e];
                av[e] = row > l31 ? X[4 * gi + e] * br[e] * rkcol * __expf(fminf(gre - gcol, 0.f)) : 0.f;
                AT[4 * gi + e] = row <= l31 ? XT[4 * gi + e] * rqcol * kr[e] * __expf(fminf(gcol - gre, 0.f)) : 0.f; }
            *(LAS f32x4*)(Acol + sc * 1024 + l31 * 32 + r0) = av; }
        unsigned char* fr = FR + (size_t)(unit * 2 + sc) * GFR_BYTES;
        *(bf16x8*)(fr + 24576 + lane * 16) = pack8<0>(AT); *(bf16x8*)(fr + 25600 + lane * 16) = pack8<1>(AT);
    }
    WAVE_SYNC();
    float tr[32];
#pragma unroll
    for (int j = 0; j < 32; ++j) tr[j] = 0.f;
    tr[31] = l31 == 31 ? 1.f : 0.f;
    { const LAS float* Ac = Acol + half * 1024; int li = l31;
#pragma unroll
      for (int j = 30; j >= 0; --j) { asm volatile("" : "+v"(li));
          float a0 = li == j ? 1.f : 0.f, a1 = 0.f;
#pragma unroll
          for (int k4 = ((j + 1) & ~3); k4 < 32; k4 += 4) { const f32x4 a = *(const LAS f32x4*)(Ac + j * 32 + k4); a0 -= tr[k4] * a.x + tr[k4 + 2] * a.z; a1 -= tr[k4 + 1] * a.y + tr[k4 + 3] * a.w; }
          tr[j] = a0 + a1; asm volatile("" : "+v"(tr[j]) :: "memory"); } }
    WAVE_SYNC();
    LAS bf16* T1l = (LAS bf16*)Acol; LAS bf16* T2l = T1l + 64 * 32;
    {
#pragma unroll
      for (int j8 = 0; j8 < 4; ++j8) { v4u o1, o2; float a[8], c[8];
#pragma unroll
          for (int q = 0; q < 2; ++q) { const f32x4 bb = *(const LAS f32x4*)(Lb + 32 * half + 8 * j8 + 4 * q), tt = *(const LAS f32x4*)(Lt2 + 32 * half + 8 * j8 + 4 * q);
#pragma unroll
              for (int e = 0; e < 4; ++e) { a[4 * q + e] = tr[8 * j8 + 4 * q + e] * bb[e]; c[4 * q + e] = tr[8 * j8 + 4 * q + e] * tt[e]; } }
          o1.x = cvt_pk_bf16(a[0], a[1]); o1.y = cvt_pk_bf16(a[2], a[3]); o1.z = cvt_pk_bf16(a[4], a[5]); o1.w = cvt_pk_bf16(a[6], a[7]);
          o2.x = cvt_pk_bf16(c[0], c[1]); o2.y = cvt_pk_bf16(c[2], c[3]); o2.z = cvt_pk_bf16(c[4], c[5]); o2.w = cvt_pk_bf16(c[6], c[7]);
          *(LAS v4u*)(T1l + lane * 32 + 8 * j8) = o1; *(LAS v4u*)(T2l + lane * 32 + 8 * j8) = o2; } }
    WAVE_SYNC();
    bf16x8 t1f[2][2], t2p[2][2];
#pragma unroll
    for (int sc = 0; sc < 2; ++sc) { const LAS bf16* T1r = T1l + (32 * sc + l31) * 32; const LAS bf16* T2r = T2l + (32 * sc + l31) * 32;
        t1f[sc][0] = *(const LAS bf16x8*)(T1r + 8 * half); t1f[sc][1] = *(const LAS bf16x8*)(T1r + 16 + 8 * half);
#pragma unroll
        for (int s2 = 0; s2 < 2; ++s2) { const v2u ta = *(const LAS v2u*)(T2r + 16 * s2 + 4 * half), tb = *(const LAS v2u*)(T2r + 16 * s2 + 8 + 4 * half); t2p[sc][s2] = __builtin_bit_cast(bf16x8, (v4u){ta.x, ta.y, tb.x, tb.y}); } }
    WAVE_SYNC();
    LAS unsigned char* VTL = (LAS unsigned char*)Acol;
#pragma unroll
    for (int sc = 0; sc < 2; ++sc) {
        unsigned char* fr = FR + (size_t)(unit * 2 + sc) * GFR_BYTES;
        unsigned char* uf = (unsigned char*)UF + (size_t)(unit * 2 + sc) * 8192;
        bf16x8 kF[4][2];
#pragma unroll
        for (int c = 0; c < 4; ++c) { kF[c][0] = *(const bf16x8*)(fr + 16384 + ((c * 2 + 0) * 64 + lane) * 16); kF[c][1] = *(const bf16x8*)(fr + 16384 + ((c * 2 + 1) * 64 + lane) * 16); }
        { const int c16 = lane & 15, t8 = lane >> 4, col = 2 * 1024 + h * 128 + 8 * c16, tb = 32 * sc + 8 * t8;
          f32x4 wa[4], wb[4];
#pragma unroll
          for (int j = 0; j < 4; ++j) { wa[j] = *(const f32x4*)(convw + j * 3072 + col); wb[j] = *(const f32x4*)(convw + j * 3072 + col + 4); }
          const bf16* rowp = cB + (size_t)(m0 + tb) * 4096 + col; const bool hasp = t0 + tb > 0;
          v4u xs[8], xp[3];
#pragma unroll
          for (int i = 0; i < 8; ++i) xs[i] = *(const v4u*)(rowp + (size_t)i * 4096);
#pragma unroll
          for (int i = 0; i < 3; ++i) xp[i] = *(const v4u*)(hasp ? rowp - (3 - i) * 4096 : rowp);
          asm volatile("" :: "v"(xs[0]), "v"(xs[1]), "v"(xs[2]), "v"(xs[3]), "v"(xs[4]), "v"(xs[5]), "v"(xs[6]), "v"(xs[7]), "v"(xp[0]), "v"(xp[1]), "v"(xp[2]) : "memory");
          const v4u zz = (v4u){0u, 0u, 0u, 0u}; v4u x0 = hasp ? xp[0] : zz, x1 = hasp ? xp[1] : zz, x2 = hasp ? xp[2] : zz;
          unsigned tbuf[8][4];
#pragma unroll
          for (int ii = 0; ii < 8; ++ii) { const v4u x3 = xs[ii];
              float y[8];
              y[0] = bf_lo(x0.x) * wa[0].x + bf_lo(x1.x) * wa[1].x + bf_lo(x2.x) * wa[2].x + bf_lo(x3.x) * wa[3].x; y[1] = bf_hi(x0.x) * wa[0].y + bf_hi(x1.x) * wa[1].y + bf_hi(x2.x) * wa[2].y + bf_hi(x3.x) * wa[3].y;
              y[2] = bf_lo(x0.y) * wa[0].z + bf_lo(x1.y) * wa[1].z + bf_lo(x2.y) * wa[2].z + bf_lo(x3.y) * wa[3].z; y[3] = bf_hi(x0.y) * wa[0].w + bf_hi(x1.y) * wa[1].w + bf_hi(x2.y) * wa[2].w + bf_hi(x3.y) * wa[3].w;
              y[4] = bf_lo(x0.z) * wb[0].x + bf_lo(x1.z) * wb[1].x + bf_lo(x2.z) * wb[2].x + bf_lo(x3.z) * wb[3].x; y[5] = bf_hi(x0.z) * wb[0].y + bf_hi(x1.z) * wb[1].y + bf_hi(x2.z) * wb[2].y + bf_hi(x3.z) * wb[3].y;
              y[6] = bf_lo(x0.w) * wb[0].z + bf_lo(x1.w) * wb[1].z + bf_lo(x2.w) * wb[2].z + bf_lo(x3.w) * wb[3].z; y[7] = bf_hi(x0.w) * wb[0].w + bf_hi(x1.w) * wb[1].w + bf_hi(x2.w) * wb[2].w + bf_hi(x3.w) * wb[3].w;
              x0 = x1; x1 = x2; x2 = x3;
#pragma unroll
              for (int e = 0; e < 8; ++e) y[e] = silu_f(y[e]);
              const unsigned w4[4] = {cvt_pk_bf16(y[0], y[1]), cvt_pk_bf16(y[2], y[3]), cvt_pk_bf16(y[4], y[5]), cvt_pk_bf16(y[6], y[7])};
#pragma unroll
              for (int e = 0; e < 8; ++e) { const unsigned hv = (e & 1) ? (w4[e >> 1] >> 16) : (w4[e >> 1] & 0xffffu); tbuf[e][ii >> 1] = (ii & 1) ? (tbuf[e][ii >> 1] | (hv << 16)) : hv; } }
#pragma unroll
          for (int e = 0; e < 8; ++e) *(LAS v4u*)(VTL + (8 * c16 + e) * 64 + 16 * t8) = (v4u){tbuf[e][0], tbuf[e][1], tbuf[e][2], tbuf[e][3]}; }
        WAVE_SYNC();
        bf16x8 vF[4][2];
#pragma unroll
        for (int c = 0; c < 4; ++c) { vF[c][0] = *(const LAS bf16x8*)(VTL + (32 * c + l31) * 64 + 16 * half); vF[c][1] = *(const LAS bf16x8*)(VTL + (32 * c + l31) * 64 + 32 + 16 * half); }
#pragma unroll
        for (int c = 0; c < 4; ++c) {
            f32x16 U = zero16(); U = MFMA32(t1f[sc][0], vF[c][0], U); U = MFMA32(t1f[sc][1], vF[c][1], U);
            *(bf16x8*)(uf + c * 2048 + lane * 32) = pack8<0>(U); *(bf16x8*)(uf + c * 2048 + lane * 32 + 16) = pack8<1>(U);
            f32x16 WT = zero16(); WT = MFMA32(kF[c][0], t2p[sc][0], WT); WT = MFMA32(kF[c][1], t2p[sc][1], WT);
#pragma unroll
            for (int r = 0; r < 16; ++r) WT[r] = -WT[r];
            *(bf16x8*)(fr + ((c * 2 + 0) * 64 + lane) * 16) = pack8<0>(WT); *(bf16x8*)(fr + ((c * 2 + 1) * 64 + lane) * 16) = pack8<1>(WT);
        }
        WAVE_SYNC();
    }
}
constexpr int GSLOT = GFR_BYTES + 512;
__device__ __forceinline__ void gdn_scan_blk(const unsigned char* FR, const float* UF, const float* GSC, bf16* GO, int bh, int tid, LAS unsigned char* lds) {
    const int b = bh >> 3, h = bh & 7, wave = tid >> 6, lane = tid & 63, l31 = lane & 31, half = lane >> 5, ltid = tid - 256;
    f32x16 S[4]; v4u Un0 = (v4u){0u, 0u, 0u, 0u}, Un1 = Un0;
#pragma unroll
    for (int kt = 0; kt < 4; ++kt) S[kt] = zero16();
    const int grp0 = (b * SEQ) >> 6;

    if (wave >= 4) {
#pragma unroll
        for (int c0 = 0; c0 < 2; ++c0) { const unsigned char* src = FR + (size_t)((grp0 * 8 + h) * 2 + c0) * GFR_BYTES; LAS unsigned char* dst = lds + c0 * GSLOT;
#pragma unroll
            for (int i = 0; i < 7; ++i) { const int idx = ltid + 256 * i; if (idx < 1664) *(LAS v4u*)(dst + idx * 16) = *(const v4u*)(src + (size_t)idx * 16); }
            const float* sc = GSC + (size_t)(grp0 * 8 + h) * 132;
            if (ltid < 16) *(LAS v4u*)(dst + GFR_BYTES + ltid * 16) = *(const v4u*)(sc + (ltid < 8 ? 32 * c0 + 4 * ltid : 64 + 32 * c0 + 4 * (ltid - 8)));
            else if (ltid == 16) *(LAS float*)(dst + GFR_BYTES + 256) = sc[128 + c0]; }
    } else {
        const int unit0 = grp0 * 8 + h;
        const unsigned char* up = (const unsigned char*)UF + ((size_t)(unit0 * 2) * 4 + wave) * 2048 + lane * 32;
        Un0 = *(const v4u*)up; Un1 = *(const v4u*)(up + 16);

    }
#pragma unroll 1
    for (int c = 0; c < 64; ++c) {
        __syncthreads();
        if (wave >= 4) {
            if (c + 2 < 64) { const int un = (grp0 + ((c + 2) >> 1)) * 8 + h, cc = (c + 2) & 1; const unsigned char* src = FR + (size_t)(un * 2 + cc) * GFR_BYTES; LAS unsigned char* dst = lds + ((c + 2) % 3) * GSLOT;
                v4u tmp[7], tsc = (v4u){0u, 0u, 0u, 0u}; float tcd = 0.f; const float* sc = GSC + (size_t)un * 132;
#pragma unroll
                for (int i = 0; i < 7; ++i) { const int idx = ltid + 256 * i; tmp[i] = idx < 1664 ? *(const v4u*)(src + (size_t)idx * 16) : (v4u){0u, 0u, 0u, 0u}; }
                if (ltid < 16) tsc = *(const v4u*)(sc + (ltid < 8 ? 32 * cc + 4 * ltid : 64 + 32 * cc + 4 * (ltid - 8)));
                else if (ltid == 16) tcd = sc[128 + cc];
#pragma unroll
                for (int i = 0; i < 7; ++i) { const int idx = ltid + 256 * i; if (idx < 1664) *(LAS v4u*)(dst + idx * 16) = tmp[i]; }
                if (ltid < 16) *(LAS v4u*)(dst + GFR_BYTES + ltid * 16) = tsc;
                else if (ltid == 16) *(LAS float*)(dst + GFR_BYTES + 256) = tcd; }
        } else {
            const LAS unsigned char* buf = lds + (c % 3) * GSLOT;
            f32x16 VN; f32x4 qsv[4], ksv[4];
            { const v4u a = Un0, b = Un1; VN[0] = bf_lo(a.x); VN[1] = bf_hi(a.x); VN[2] = bf_lo(a.y); VN[3] = bf_hi(a.y); VN[4] = bf_lo(a.z); VN[5] = bf_hi(a.z); VN[6] = bf_lo(a.w); VN[7] = bf_hi(a.w);
              VN[8] = bf_lo(b.x); VN[9] = bf_hi(b.x); VN[10] = bf_lo(b.y); VN[11] = bf_hi(b.y); VN[12] = bf_lo(b.z); VN[13] = bf_hi(b.z); VN[14] = bf_lo(b.w); VN[15] = bf_hi(b.w); }
            const LAS float* scq = (const LAS float*)(buf + GFR_BYTES);
#pragma unroll
            for (int gi = 0; gi < 4; ++gi) { qsv[gi] = *(const LAS f32x4*)(scq + 8 * gi + 4 * half); ksv[gi] = *(const LAS f32x4*)(scq + 32 + 8 * gi + 4 * half); }
            const float cd = scq[64];
            if (c + 1 < 64) { const int un = (grp0 + ((c + 1) >> 1)) * 8 + h; const unsigned char* up = (const unsigned char*)UF + ((size_t)(un * 2 + ((c + 1) & 1)) * 4 + wave) * 2048 + lane * 32;
                Un0 = *(const v4u*)up; Un1 = *(const v4u*)(up + 16); }
            bf16x8 Sf[4][2];
#pragma unroll
            for (int kt = 0; kt < 4; ++kt) { Sf[kt][0] = pack8<0>(S[kt]); Sf[kt][1] = pack8<1>(S[kt]); }
            f32x16 O1 = zero16();
#pragma unroll
            for (int kt = 0; kt < 4; ++kt)
#pragma unroll
                for (int s2 = 0; s2 < 2; ++s2) { VN = MFMA32(*(const LAS bf16x8*)(buf + ((kt * 2 + s2) * 64 + lane) * 16), Sf[kt][s2], VN);
                                                O1 = MFMA32(*(const LAS bf16x8*)(buf + 8192 + ((kt * 2 + s2) * 64 + lane) * 16), Sf[kt][s2], O1); }
            const bf16x8 vf0 = pack8<0>(VN), vf1 = pack8<1>(VN);
            f32x16 O2 = zero16();
            O2 = MFMA32(*(const LAS bf16x8*)(buf + 24576 + lane * 16), vf0, O2); O2 = MFMA32(*(const LAS bf16x8*)(buf + 25600 + lane * 16), vf1, O2);
            bf16* op = GO + ((size_t)b * SEQ + 32 * c) * 1024 + h * 128 + 32 * wave + l31;
#pragma unroll
            for (int r = 0; r < 16; r += 2) { const int tok = 8 * (r >> 2) + 4 * half + (r & 3); const unsigned w = cvt_pk_bf16(qsv[r >> 2][r & 3] * O1[r] + O2[r], qsv[r >> 2][(r & 3) + 1] * O1[r + 1] + O2[r + 1]);
                op[(size_t)tok * 1024] = (bf16)(w & 0xffffu); op[(size_t)(tok + 1) * 1024] = (bf16)(w >> 16); }
            f32x16 VS;
#pragma unroll
            for (int r = 0; r < 16; ++r) VS[r] = VN[r] * ksv[r >> 2][r & 3];
            const bf16x8 vs0 = pack8<0>(VS), vs1 = pack8<1>(VS);
#pragma unroll
            for (int kt = 0; kt < 4; ++kt) {
#pragma unroll
                for (int r = 0; r < 16; ++r) S[kt][r] *= cd;
                S[kt] = MFMA32(*(const LAS bf16x8*)(buf + 16384 + ((kt * 2 + 0) * 64 + lane) * 16), vs0, S[kt]);
                S[kt] = MFMA32(*(const LAS bf16x8*)(buf + 16384 + ((kt * 2 + 1) * 64 + lane) * 16), vs1, S[kt]); }
        }
    }
    __syncthreads();
}

template <int CTRL> __device__ __forceinline__ float dpp_f(float x) { return __builtin_bit_cast(float, __builtin_amdgcn_update_dpp(0, __builtin_bit_cast(int, x), CTRL, 0xf, 0xf, false)); }
__device__ __forceinline__ float sum32(float x) {
#ifdef SAFE_SUM
    x += __shfl_xor(x, 1); x += __shfl_xor(x, 2); x += __shfl_xor(x, 4); x += __shfl_xor(x, 8); x += __shfl_xor(x, 16); return x; }
#else
    x += dpp_f<0xB1>(x); x += dpp_f<0x4E>(x); x += dpp_f<0x141>(x); x += dpp_f<0x140>(x); x += __shfl_xor(x, 16); return x; }
#endif
__device__ __forceinline__ v2u pack4(float a, float b, float c, float d) { v2u w; w.x = cvt_pk_bf16(a, b); w.y = cvt_pk_bf16(c, d); return w; }
__device__ __forceinline__ bf16x8 ld2x8(const bf16* p) { const v2u a = *(const v2u*)p, b = *(const v2u*)(p + 8); return __builtin_bit_cast(bf16x8, (v4u){a.x, a.y, b.x, b.y}); }
__device__ __forceinline__ f32x16 ld_tile(const float* p) { f32x16 t;
#pragma unroll
    for (int q = 0; q < 4; ++q) { const f32x4 u = *(const f32x4*)(p + 4 * q); t[4 * q] = u.x; t[4 * q + 1] = u.y; t[4 * q + 2] = u.z; t[4 * q + 3] = u.w; } return t; }
__device__ __forceinline__ f32x16 unpack_tile(const v4u a, const v4u b) { f32x16 t;
    t[0] = bf_lo(a.x); t[1] = bf_hi(a.x); t[2] = bf_lo(a.y); t[3] = bf_hi(a.y); t[4] = bf_lo(a.z); t[5] = bf_hi(a.z); t[6] = bf_lo(a.w); t[7] = bf_hi(a.w);
    t[8] = bf_lo(b.x); t[9] = bf_hi(b.x); t[10] = bf_lo(b.y); t[11] = bf_hi(b.y); t[12] = bf_lo(b.z); t[13] = bf_hi(b.z); t[14] = bf_lo(b.w); t[15] = bf_hi(b.w); return t; }
__device__ __forceinline__ void st_tile(float* p, const f32x16& t) {
#pragma unroll
    for (int q = 0; q < 4; ++q) *(f32x4*)(p + 4 * q) = (f32x4){t[4 * q], t[4 * q + 1], t[4 * q + 2], t[4 * q + 3]}; }
__device__ __forceinline__ float ldbf(const void* base, unsigned off) { return bf_lo((unsigned)*(const bf16*)((const char*)base + off)); }
__device__ __forceinline__ void stbf(void* base, unsigned off, float v) { *(bf16*)((char*)base + off) = (bf16)(cvt_pk_bf16(v, 0.f) & 0xffffu); }
#ifdef SAFE_SUM
#define RW_SYNC() do { asm volatile("s_waitcnt vmcnt(0) lgkmcnt(0)" ::: "memory"); __builtin_amdgcn_fence(__ATOMIC_ACQUIRE, "agent"); asm volatile("s_waitcnt vmcnt(0) lgkmcnt(0)" ::: "memory"); __builtin_amdgcn_wave_barrier(); asm volatile("" ::: "memory"); } while (0)
#else
#define RW_SYNC() WAVE_SYNC()
#endif
__device__ __forceinline__ bf16x8 natf(const bf16* X, int kt, int s, int lane) { return *(const bf16x8*)(X + ((kt * 4 + s) * 64 + lane) * 8); }
__device__ __forceinline__ bf16x8 perf(const bf16* X, int kt, int s, int l31, int half) { const bf16* p = X + ((kt * 4 + s) * 64 + l31) * 8 + 4 * half; const v2u a = *(const v2u*)p, b = *(const v2u*)(p + 256); return __builtin_bit_cast(bf16x8, (v4u){a.x, a.y, b.x, b.y}); }
constexpr int NPARK = 4;
constexpr int RSO_BYTES = 24832;
constexpr int XL_PITCH = 912;
constexpr int RW_SCR = 72 * 1024;

template <bool ONLY_A>
__device__ __forceinline__ void lora_tiles(const LAS unsigned char* XL, const bf16* W2T, const bf16* A2T, const bf16* G2T, int sc, int cch, int l31, int half, f32x16& Wl, f32x16& Al, f32x16& Gl) {
    const LAS unsigned char* xr = XL + (32 * sc + l31) * XL_PITCH + 16 * half;
    Al = zero16();
#pragma unroll
    for (int s = 0; s < 6; ++s) Al = MFMA32(*(const LAS bf16x8*)(xr + 192 + 32 * s), *(const bf16x8*)(A2T + (size_t)cch * 128 + 16 * s + 8 * half), Al);
    if (!ONLY_A) {
        Wl = zero16(); Gl = zero16();
#pragma unroll
        for (int s = 0; s < 6; ++s) Wl = MFMA32(*(const LAS bf16x8*)(xr + 32 * s), *(const bf16x8*)(W2T + (size_t)cch * 128 + 16 * s + 8 * half), Wl);
#pragma unroll
        for (int s = 0; s < 16; ++s) Gl = MFMA32(*(const LAS bf16x8*)(xr + 384 + 32 * s), *(const bf16x8*)(G2T + (size_t)cch * 256 + 16 * s + 8 * half), Gl);
    }
}
__device__ __forceinline__ void rwkv_prep_blk(const bf16* cC, const float* mu, const float* w0, const float* a0, const float* k_k, const float* k_a, const float* r_k,
                                              const bf16* W2T, const bf16* A2T, const bf16* G2T, unsigned char* RSO, float* BON, bf16* GS, unsigned char* SCR,
                                              int grp, int tid, LAS unsigned char* lds) {
    const int m0 = grp * 64, b = m0 >> 11, t0 = m0 & (SEQ - 1);
    LAS unsigned char* XL = lds + 69632;
    if (tid < 448) { const int cg = tid % 56, tb = 8 * (tid / 56), cc = 3072 + 8 * cg; const bf16* rowp = cC + (size_t)(m0 + tb) * 3584 + cc; const bool hp0 = t0 + tb > 0;
        v4u xq[8], xp = *(const v4u*)(hp0 ? rowp - 3584 : rowp);
#pragma unroll
        for (int u = 0; u < 8; ++u) xq[u] = *(const v4u*)(rowp + (size_t)u * 3584);
        const f32x4 ma = *(const f32x4*)(mu + cc), mb = *(const f32x4*)(mu + cc + 4);
        asm volatile("" :: "v"(xq[0]), "v"(xq[1]), "v"(xq[2]), "v"(xq[3]), "v"(xq[4]), "v"(xq[5]), "v"(xq[6]), "v"(xq[7]), "v"(xp) : "memory");
        if (!hp0) xp = (v4u){0u, 0u, 0u, 0u};
#pragma unroll
        for (int u = 0; u < 8; ++u) { const v4u x = xq[u];
            float y[8];
            y[0] = bf_lo(x.x) + (bf_lo(xp.x) - bf_lo(x.x)) * ma.x; y[1] = bf_hi(x.x) + (bf_hi(xp.x) - bf_hi(x.x)) * ma.y; y[2] = bf_lo(x.y) + (bf_lo(xp.y) - bf_lo(x.y)) * ma.z; y[3] = bf_hi(x.y) + (bf_hi(xp.y) - bf_hi(x.y)) * ma.w;
            y[4] = bf_lo(x.z) + (bf_lo(xp.z) - bf_lo(x.z)) * mb.x; y[5] = bf_hi(x.z) + (bf_hi(xp.z) - bf_hi(x.z)) * mb.y; y[6] = bf_lo(x.w) + (bf_lo(xp.w) - bf_lo(x.w)) * mb.z; y[7] = bf_hi(x.w) + (bf_hi(xp.w) - bf_hi(x.w)) * mb.w;
            xp = x;
#pragma unroll
            for (int e = 0; e < 8; ++e) y[e] = cg < 12 ? tanhf(y[e]) : (cg < 24 ? y[e] : sigmoid_f(y[e]));
            v4u o; o.x = cvt_pk_bf16(y[0], y[1]); o.y = cvt_pk_bf16(y[2], y[3]); o.z = cvt_pk_bf16(y[4], y[5]); o.w = cvt_pk_bf16(y[6], y[7]);
            *(LAS v4u*)(XL + (tb + u) * XL_PITCH + 16 * cg) = o; } }
    { LAS float* RN = (LAS float*)(lds + 135168);
      asm volatile("" : "+v"(tid));
      const int kg = tid & 127; const f32x4 ma = *(const f32x4*)(mu + 1024 + 8 * kg), mb = *(const f32x4*)(mu + 1024 + 8 * kg + 4), ka = *(const f32x4*)(k_k + 8 * kg), kb = *(const f32x4*)(k_k + 8 * kg + 4);
      const int tk0 = 16 * (tid >> 7); const bf16* rowp = cC + (size_t)(m0 + tk0) * 3584 + 1024 + 8 * kg; const bool hp0 = t0 + tk0 > 0;
      v4u xp = *(const v4u*)(hp0 ? rowp - 3584 : rowp);
#pragma unroll
      for (int j8 = 0; j8 < 16; j8 += 8) { v4u xq[8];
#pragma unroll
        for (int u = 0; u < 8; ++u) xq[u] = *(const v4u*)(rowp + (size_t)(j8 + u) * 3584);
        asm volatile("" :: "v"(xq[0]), "v"(xq[1]), "v"(xq[2]), "v"(xq[3]), "v"(xq[4]), "v"(xq[5]), "v"(xq[6]), "v"(xq[7]), "v"(xp) : "memory");
        if (j8 == 0 && !hp0) xp = (v4u){0u, 0u, 0u, 0u};
#pragma unroll
        for (int u = 0; u < 8; ++u) { const int tok = tk0 + j8 + u;
          const v4u x = xq[u];
          float y[8];
          y[0] = (bf_lo(x.x) + (bf_lo(xp.x) - bf_lo(x.x)) * ma.x) * ka.x; y[1] = (bf_hi(x.x) + (bf_hi(xp.x) - bf_hi(x.x)) * ma.y) * ka.y; y[2] = (bf_lo(x.y) + (bf_lo(xp.y) - bf_lo(x.y)) * ma.z) * ka.z; y[3] = (bf_hi(x.y) + (bf_hi(xp.y) - bf_hi(x.y)) * ma.w) * ka.w;
          y[4] = (bf_lo(x.z) + (bf_lo(xp.z) - bf_lo(x.z)) * mb.x) * kb.x; y[5] = (bf_hi(x.z) + (bf_hi(xp.z) - bf_hi(x.z)) * mb.y) * kb.y; y[6] = (bf_lo(x.w) + (bf_lo(xp.w) - bf_lo(x.w)) * mb.z) * kb.z; y[7] = (bf_hi(x.w) + (bf_hi(xp.w) - bf_hi(x.w)) * mb.w) * kb.w;
          xp = x;
          float ss = (y[0] * y[0] + y[1] * y[1]) + (y[2] * y[2] + y[3] * y[3]) + (y[4] * y[4] + y[5] * y[5]) + (y[6] * y[6] + y[7] * y[7]);
          ss += dpp_f<0xB1>(ss); ss += dpp_f<0x4E>(ss); ss += dpp_f<0x141>(ss);
          if ((kg & 7) == 0) RN[(kg >> 3) * 64 + tok] = 1.0f / sqrtf(ss + 1e-6f); } } }
    __syncthreads();
    int lane_ = tid & 63; const int wave = __builtin_amdgcn_readfirstlane(tid >> 6);
    LAS float* Acol = (LAS float*)(lds + wave * 8704);
    bf16* scr = (bf16*)(SCR + (size_t)(blockIdx.x * 8 + wave) * RW_SCR);
    bf16 *AR = scr, *BR = scr + 4096, *KRr = scr + 8192, *RRr = scr + 12288, *AT = scr + 16384, *BT = scr + 20480, *KTt = scr + 24576, *RT = scr + 28672, *VTt = scr + 32768;
    unsigned char* FS = (unsigned char*)(scr + 36864) - 0;
#pragma unroll 1
    for (int hh = 0; hh < 2; ++hh) {
        const int h = 2 * wave + hh;
#ifndef REP2
#define REP2 1
#endif
        for (int rp2_ = 0; rp2_ < REP2; ++rp2_)
#pragma unroll 1
        for (int sc = 0; sc < 2; ++sc) {
            asm volatile("" : "+v"(lane_)); const int l31 = lane_ & 31, half = lane_ >> 5;
            v2u pk[2][5][4];
            {
            unsigned char* rso = RSO + (size_t)((b * 16 + h) * 64 + (t0 >> 5) + sc) * RSO_BYTES;
#pragma unroll
            for (int ct = 0; ct < 2; ++ct) {
                const int c = h * 64 + 32 * ct + l31, cl = 32 * ct + l31;
                f32x16 Wl, Al;
                LAS unsigned char* WL = (LAS unsigned char*)Acol;
                v4u st[7];
#pragma unroll
                for (int t = 0; t < 7; ++t) { int item = t * 64 + lane_; item = item > 395 ? 395 : item; const int ar = item / 132, rem = item - ar * 132, row = rem >> 2, q = rem & 3;
                    int tk = 32 * sc + row - 1; tk = (t0 + tk < 0) ? 0 : tk;
                    st[t] = *(const v4u*)((const char*)cC + (unsigned)(m0 + tk) * 7168u + 2u * (unsigned)(ar * 1024 + h * 64 + 32 * ct + 8 * q)); }
                { bf16x8 gw[16];
#pragma unroll
                  for (int s = 0; s < 16; ++s) gw[s] = *(const bf16x8*)(G2T + (size_t)c * 256 + 16 * s + 8 * half);
                  asm volatile("" ::: "memory");
                  f32x16 Gl = zero16(); const LAS unsigned char* xg = XL + (32 * sc + l31) * XL_PITCH + 16 * half + 384;
#pragma unroll
                  for (int s = 0; s < 16; ++s) Gl = MFMA32(*(const LAS bf16x8*)(xg + 32 * s), gw[s], Gl);
#pragma unroll
                  for (int r = 0; r < 16; ++r) *(LAS bf16*)(WL + (8 * (r >> 2) + 4 * half + (r & 3)) * 80 + 2 * l31) = (bf16)(cvt_pk_bf16(Gl[r], 0.f) & 0xffffu);
                  WAVE_SYNC();
#pragma unroll
                  for (int u = 0; u < 2; ++u) { const int item = u * 64 + lane_, row = item >> 2, q = item & 3;
                      *(v4u*)((char*)GS + (unsigned)(m0 + 32 * sc + row) * 2048u + 2u * (unsigned)(h * 64 + 32 * ct + 8 * q)) = *(const LAS v4u*)(WL + row * 80 + 16 * q); }
                  WAVE_SYNC(); }
#pragma unroll
                for (int t = 0; t < 7; ++t) { const int item = t * 64 + lane_; const int ar = item / 132, rem = item - ar * 132, row = rem >> 2, q = rem & 3;
                    if (item < 396) *(LAS v4u*)(WL + ar * 2640 + row * 80 + 16 * q) = st[t]; }
                WAVE_SYNC();
                const float mur = mu[c], muk = mu[1024 + c], muv = mu[2048 + c], w0c = w0[c], a0c = a0[c], kkc = k_k[c], kac = k_a[c], rkc = r_k[c];
                { bf16x8 ww[6], aw[6];
#pragma unroll
                  for (int s = 0; s < 6; ++s) { ww[s] = *(const bf16x8*)(W2T + (size_t)c * 128 + 16 * s + 8 * half); aw[s] = *(const bf16x8*)(A2T + (size_t)c * 128 + 16 * s + 8 * half); }
                  asm volatile("" ::: "memory");
                  const LAS unsigned char* xr0 = XL + (32 * sc + l31) * XL_PITCH + 16 * half; Wl = zero16(); Al = zero16();
#pragma unroll
                  for (int s = 0; s < 6; ++s) { Wl = MFMA32(*(const LAS bf16x8*)(xr0 + 32 * s), ww[s], Wl); Al = MFMA32(*(const LAS bf16x8*)(xr0 + 192 + 32 * s), aw[s], Al); } }
                float lw[16], rr[16], kx[16];
#pragma unroll
                for (int gi = 0; gi < 4; ++gi) {
                    const int tok0 = 32 * sc + 8 * gi + 4 * half; const bool hp = t0 + tok0 > 0;
                    const LAS unsigned char* p0 = WL + (8 * gi + 4 * half) * 80 + 2 * l31;
                    float pr = hp ? bf_lo((unsigned)*(const LAS bf16*)p0) : 0.f, pkk = hp ? bf_lo((unsigned)*(const LAS bf16*)(p0 + 2640)) : 0.f, pv = hp ? bf_lo((unsigned)*(const LAS bf16*)(p0 + 5280)) : 0.f; float vv[4];
#pragma unroll
                    for (int e = 0; e < 4; ++e) { const int r = 4 * gi + e; const LAS unsigned char* p = p0 + 80 * (e + 1);
                        const float xr = bf_lo((unsigned)*(const LAS bf16*)p), xk = bf_lo((unsigned)*(const LAS bf16*)(p + 2640)), xv = bf_lo((unsigned)*(const LAS bf16*)(p + 5280));
                        rr[r] = xr + (pr - xr) * mur; kx[r] = xk + (pkk - xk) * muk; vv[e] = xv + (pv - xv) * muv; pr = xr; pkk = xk; pv = xv;
                        lw[r] = -0.6065306597f * sigmoid_f(w0c + Wl[r]);
                        Al[r] = sigmoid_f(a0c + Al[r]); }
                    pk[ct][4][gi] = pack4(vv[0], vv[1], vv[2], vv[3]); }
                float lg[16], tot[4], oth[4];
#pragma unroll
                for (int gi = 0; gi < 4; ++gi) { lg[4 * gi] = lw[4 * gi]; lg[4 * gi + 1] = lg[4 * gi] + lw[4 * gi + 1]; lg[4 * gi + 2] = lg[4 * gi + 1] + lw[4 * gi + 2]; lg[4 * gi + 3] = lg[4 * gi + 2] + lw[4 * gi + 3]; tot[gi] = lg[4 * gi + 3]; }
#pragma unroll
                for (int gi = 0; gi < 4; ++gi) oth[gi] = __shfl_xor(tot[gi], 32);
                float basev = 0.f;
#pragma unroll
                for (int gi = 0; gi < 4; ++gi) { const float off = basev + (half ? oth[gi] : 0.f);
#pragma unroll
                    for (int e = 0; e < 4; ++e) lg[4 * gi + e] += off;
                    basev += tot[gi] + oth[gi]; }
                if (half == 0) *(float*)(rso + 24576 + cl * 4) = __expf(basev);
                float gam[16], gprev[4];
#pragma unroll
                for (int r = 0; r < 16; ++r) gam[r] = __expf(lg[r]);
#pragma unroll
                for (int gi = 0; gi < 4; ++gi) { const float o3 = __shfl_xor(gam[4 * gi + 3], 32);
                    gprev[gi] = half ? o3 : 0.f; }
                { float o3p[4];
#pragma unroll
                  for (int gi = 0; gi < 4; ++gi) o3p[gi] = __shfl_xor(gam[4 * gi + 3], 32);
#pragma unroll
                  for (int gi = 0; gi < 4; ++gi) if (!half) gprev[gi] = gi == 0 ? 1.0f : o3p[gi - 1]; }
                float bv = 0.f;
#pragma unroll
                for (int gi = 0; gi < 4; ++gi) { float At_[4], Bt_[4], Kt_[4], Rt_[4];
                    const f32x4 rn4 = *(const LAS f32x4*)((LAS float*)(lds + 135168) + h * 64 + 32 * sc + 8 * gi + 4 * half);
#pragma unroll
                    for (int e = 0; e < 4; ++e) { const int r = 4 * gi + e; const float a = Al[r], kk = kx[r] * kkc * rn4[e], k2 = kx[r] * (1.0f + (a - 1.0f) * kac);
                        const float gg = gam[r], gi_ = __builtin_amdgcn_rcpf(gg), gp = e == 0 ? gprev[gi] : gam[r - 1];
                        At_[e] = -kk * gp; Bt_[e] = kk * a * gi_; Kt_[e] = k2 * gi_; Rt_[e] = rr[r] * gg; { const float sr = sum32(rr[r] * k2 * rkc); bv = (l31 == r) ? sr : bv; } }
                    pk[ct][0][gi] = pack4(At_[0], At_[1], At_[2], At_[3]); pk[ct][1][gi] = pack4(Bt_[0], Bt_[1], Bt_[2], Bt_[3]);
                    pk[ct][2][gi] = pack4(Kt_[0], Kt_[1], Kt_[2], Kt_[3]); pk[ct][3][gi] = pack4(Rt_[0], Rt_[1], Rt_[2], Rt_[3]);
                    }
                if (ct == 0) {
                    char* pkp = (char*)AT + lane_ * 16;
#pragma unroll
                    for (int ar = 0; ar < NPARK; ++ar)
#pragma unroll
                        for (int s2 = 0; s2 < 2; ++s2) *(v4u*)(pkp + (ar * 2 + s2) * 1024) = (v4u){pk[0][5 - NPARK + ar][2 * s2].x, pk[0][5 - NPARK + ar][2 * s2].y, pk[0][5 - NPARK + ar][2 * s2 + 1].x, pk[0][5 - NPARK + ar][2 * s2 + 1].y}; }
                { if (l31 < 16) BON[((size_t)(m0 + 32 * sc + 8 * (l31 >> 2) + 4 * half + (l31 & 3)) * 16 + h) * 2 + ct] = bv; }
            }
        }
            asm volatile("s_waitcnt vmcnt(0)" ::: "memory");
            RW_SYNC();
            { const char* pkp = (const char*)AT + lane_ * 16;
#pragma unroll
              for (int ar = 0; ar < NPARK; ++ar)
#pragma unroll
                  for (int s2 = 0; s2 < 2; ++s2) { const v4u q = *(const v4u*)(pkp + (ar * 2 + s2) * 1024); pk[0][5 - NPARK + ar][2 * s2] = (v2u){q.x, q.y}; pk[0][5 - NPARK + ar][2 * s2 + 1] = (v2u){q.z, q.w}; } }
            bf16x8 akF[2], rbF[2], rkF[2];
            {
            LAS unsigned char* G0 = (LAS unsigned char*)Acol; LAS unsigned char* G1 = G0 + 4096;
#define GWR(arr, G) do { _Pragma("unroll") for (int ct_ = 0; ct_ < 2; ++ct_) _Pragma("unroll") for (int gi_ = 0; gi_ < 4; ++gi_) { const v2u q_ = pk[ct_][arr][gi_]; _Pragma("unroll") for (int e_ = 0; e_ < 4; ++e_) { \
                const int row_ = 8 * gi_ + 4 * half + e_; const unsigned v_ = (e_ & 1) ? ((e_ >> 1) ? q_.y : q_.x) >> 16 : ((e_ >> 1) ? q_.y : q_.x) & 0xffffu; \
                *(LAS bf16*)((G) + row_ * 128 + 16 * ((4 * ct_ + (l31 >> 3)) ^ ((row_ >> 1) & 7)) + 2 * (l31 & 7)) = (bf16)v_; } } } while (0)
#define GRD(G, s_) (*(const LAS bf16x8*)((G) + l31 * 128 + 16 * ((2 * (s_) + half) ^ ((l31 >> 1) & 7))))
            f32x4 avv[4];
            GWR(0, G0); GWR(1, G1); WAVE_SYNC();
            bf16x8 xF[4], yF[4];
#pragma unroll
            for (int s = 0; s < 4; ++s) { xF[s] = GRD(G0, s); yF[s] = GRD(G1, s); }
            { f32x16 AB = zero16();
#pragma unroll
              for (int s = 0; s < 4; ++s) AB = MFMA32(xF[s], yF[s], AB);
#pragma unroll
              for (int gi = 0; gi < 4; ++gi)
#pragma unroll
                  for (int e = 0; e < 4; ++e) avv[gi][e] = (8 * gi + 4 * half + e) > l31 ? -AB[4 * gi + e] : 0.f; }
            WAVE_SYNC(); GWR(3, G0); WAVE_SYNC();
#pragma unroll
            for (int s = 0; s < 4; ++s) xF[s] = GRD(G0, s);
            { f32x16 RBT = zero16();
#pragma unroll
              for (int s = 0; s < 4; ++s) RBT = MFMA32(yF[s], xF[s], RBT);
#pragma unroll
              for (int r = 0; r < 16; ++r) RBT[r] = (8 * (r >> 2) + 4 * half + (r & 3)) <= l31 ? RBT[r] : 0.f;
              rbF[0] = pack8<0>(RBT); rbF[1] = pack8<1>(RBT); }
            WAVE_SYNC(); GWR(2, G1); WAVE_SYNC();
#pragma unroll
            for (int s = 0; s < 4; ++s) yF[s] = GRD(G1, s);
            { f32x16 RKT = zero16();
#pragma unroll
              for (int s = 0; s < 4; ++s) RKT = MFMA32(yF[s], xF[s], RKT);
#pragma unroll
              for (int r = 0; r < 16; ++r) RKT[r] = (8 * (r >> 2) + 4 * half + (r & 3)) <= l31 ? RKT[r] : 0.f;
              rkF[0] = pack8<0>(RKT); rkF[1] = pack8<1>(RKT); }
            WAVE_SYNC(); GWR(0, G0); WAVE_SYNC();
#pragma unroll
            for (int s = 0; s < 4; ++s) xF[s] = GRD(G0, s);
            { f32x16 AKT = zero16();
#pragma unroll
              for (int s = 0; s < 4; ++s) AKT = MFMA32(yF[s], xF[s], AKT);
#pragma unroll
              for (int r = 0; r < 16; ++r) AKT[r] = (8 * (r >> 2) + 4 * half + (r & 3)) < l31 ? AKT[r] : 0.f;
              akF[0] = pack8<0>(AKT); akF[1] = pack8<1>(AKT); }
            WAVE_SYNC();
#pragma unroll
            for (int gi = 0; gi < 4; ++gi) *(LAS f32x4*)(Acol + l31 * 32 + 8 * gi + 4 * half) = avv[gi];
#undef GWR
#undef GRD
            }
            RW_SYNC();
            {
            float tr[32];
#pragma unroll
            for (int j = 0; j < 32; ++j) tr[j] = 0.f;
            tr[31] = l31 == 31 ? 1.f : 0.f;
            const LAS float* Ac = Acol; int li = l31;
#pragma unroll
            for (int j = 30; j >= 0; --j) { asm volatile("" : "+v"(li));
                float x0 = li == j ? 1.f : 0.f, x1 = 0.f;
#pragma unroll
                for (int k4 = ((j + 1) & ~3); k4 < 32; k4 += 4) { const f32x4 a = *(const LAS f32x4*)(Ac + j * 32 + k4); x0 -= tr[k4] * a.x + tr[k4 + 2] * a.z; x1 -= tr[k4 + 1] * a.y + tr[k4 + 3] * a.w; }
                tr[j] = x0 + x1; asm volatile("" : "+v"(tr[j]) :: "memory"); }
            RW_SYNC();
            LAS bf16* Tl = (LAS bf16*)Acol + 2048;
#pragma unroll
            for (int j8 = 0; j8 < 4; ++j8) { v4u o; o.x = cvt_pk_bf16(tr[8 * j8], tr[8 * j8 + 1]); o.y = cvt_pk_bf16(tr[8 * j8 + 2], tr[8 * j8 + 3]); o.z = cvt_pk_bf16(tr[8 * j8 + 4], tr[8 * j8 + 5]); o.w = cvt_pk_bf16(tr[8 * j8 + 6], tr[8 * j8 + 7]);
                *(LAS v4u*)(Tl + l31 * 32 + 8 * j8) = o; }
            }
            RW_SYNC();
            {
            const int lane = lane_;
#define PKF(arr, ct_, s2_) __builtin_bit_cast(bf16x8, (v4u){pk[ct_][arr][2 * (s2_)].x, pk[ct_][arr][2 * (s2_)].y, pk[ct_][arr][2 * (s2_) + 1].x, pk[ct_][arr][2 * (s2_) + 1].y})
            const LAS bf16* Tl = (const LAS bf16*)Acol + 2048 + l31 * 32;
            bf16x8 tP[2];
#pragma unroll
            for (int s2 = 0; s2 < 2; ++s2) { const v2u a = *(const LAS v2u*)(Tl + 16 * s2 + 4 * half), bq = *(const LAS v2u*)(Tl + 16 * s2 + 8 + 4 * half); tP[s2] = __builtin_bit_cast(bf16x8, (v4u){a.x, a.y, bq.x, bq.y}); }
            unsigned char* rso = RSO + (size_t)((b * 16 + h) * 64 + (t0 >> 5) + sc) * RSO_BYTES;
            float gClv[2]; f32x4 grv[2][4];
#pragma unroll
            for (int kt = 0; kt < 2; ++kt) { gClv[kt] = *(const float*)(rso + 24576 + (32 * kt + l31) * 4);
#pragma unroll
                for (int gi = 0; gi < 4; ++gi) grv[kt][gi] = *(const f32x4*)(rso + 24576 + (32 * kt + 8 * gi + 4 * half) * 4); }
            bf16x8 taF[2][2], u0F[2][2];
#pragma unroll
            for (int t2 = 0; t2 < 2; ++t2) {
                f32x16 TA = zero16(); TA = MFMA32(tP[0], PKF(0, t2, 0), TA); TA = MFMA32(tP[1], PKF(0, t2, 1), TA);
                taF[t2][0] = pack8<0>(TA); taF[t2][1] = pack8<1>(TA);
                f32x16 P1 = zero16(); P1 = MFMA32(akF[0], PKF(4, t2, 0), P1); P1 = MFMA32(akF[1], PKF(4, t2, 1), P1);
                f32x16 U0 = zero16(); U0 = MFMA32(tP[0], pack8<0>(P1), U0); U0 = MFMA32(tP[1], pack8<1>(P1), U0);
                u0F[t2][0] = pack8<0>(U0); u0F[t2][1] = pack8<1>(U0);
                f32x16 O0 = zero16(); O0 = MFMA32(rbF[0], u0F[t2][0], O0); O0 = MFMA32(rbF[1], u0F[t2][1], O0);
                O0 = MFMA32(rkF[0], PKF(4, t2, 0), O0); O0 = MFMA32(rkF[1], PKF(4, t2, 1), O0);
                *(bf16x8*)(rso + 12288 + t2 * 2048 + lane * 32) = pack8<0>(O0); *(bf16x8*)(rso + 12288 + t2 * 2048 + lane * 32 + 16) = pack8<1>(O0);
            }
            bf16x8 idF[2];
#pragma unroll
            for (int s = 0; s < 2; ++s)
#pragma unroll
                for (int e = 0; e < 8; ++e) idF[s][e] = (16 * s + 8 * (e >> 2) + 4 * half + (e & 3) == l31) ? (short)0x3F80 : (short)0;
#pragma unroll
            for (int kt = 0; kt < 2; ++kt) {
                f32x16 RRT = zero16(); RRT = MFMA32(PKF(3, kt, 0), idF[0], RRT); RRT = MFMA32(PKF(3, kt, 1), idF[1], RRT);
                RRT = MFMA32(taF[kt][0], rbF[0], RRT); RRT = MFMA32(taF[kt][1], rbF[1], RRT);
                *(bf16x8*)(rso + ((kt * 2 + 0) * 64 + lane) * 16) = pack8<0>(RRT); *(bf16x8*)(rso + ((kt * 2 + 1) * 64 + lane) * 16) = pack8<1>(RRT);
                const bf16x8 btP0 = PKF(1, kt, 0), btP1 = PKF(1, kt, 1);
                const float gCl = gClv[kt];
#pragma unroll
                for (int k0 = 0; k0 < 2; ++k0) {
                    f32x16 G = zero16(); G = MFMA32(taF[k0][0], btP0, G); G = MFMA32(taF[k0][1], btP1, G);
#pragma unroll
                    for (int r = 0; r < 16; ++r) G[r] *= gCl;
                    *(bf16x8*)(rso + 4096 + (((k0 * 2 + kt) * 2 + 0) * 64 + lane) * 16) = pack8<0>(G); *(bf16x8*)(rso + 4096 + (((k0 * 2 + kt) * 2 + 1) * 64 + lane) * 16) = pack8<1>(G); }
#pragma unroll
                for (int vt = 0; vt < 2; ++vt) {
                    f32x16 HT = zero16(); HT = MFMA32(btP0, u0F[vt][0], HT); HT = MFMA32(btP1, u0F[vt][1], HT);
                    HT = MFMA32(PKF(2, kt, 0), PKF(4, vt, 0), HT); HT = MFMA32(PKF(2, kt, 1), PKF(4, vt, 1), HT);
#pragma unroll
                    for (int r = 0; r < 16; ++r) HT[r] *= grv[kt][r >> 2][r & 3];
                    *(bf16x8*)(rso + 16384 + (kt * 2 + vt) * 2048 + lane * 32) = pack8<0>(HT); *(bf16x8*)(rso + 16384 + (kt * 2 + vt) * 2048 + lane * 32 + 16) = pack8<1>(HT); }
            }
#undef PKF
            }
            RW_SYNC();
        }
        RW_SYNC();
    }
    __syncthreads();
}
__device__ __forceinline__ void rwkv_scan_wave(const unsigned char* RSO, bf16* RO, int item, int lane) {
    const int chain = item >> 1, vt = item & 1, b = chain >> 4, h = chain & 15, l31 = lane & 31, half = lane >> 5;
    f32x16 ST[2]; ST[0] = zero16(); ST[1] = zero16();
    const unsigned char* rs = RSO + (size_t)chain * 64 * RSO_BYTES;
#pragma unroll 1
    for (int c = 0; c < 64; ++c, rs += RSO_BYTES) {
        bf16x8 rrF[2][2], gF[2][2][2]; v4u oR[2], nR[2][2]; f32x4 g4[2][4];
#pragma unroll
        for (int kt = 0; kt < 2; ++kt)
#pragma unroll
            for (int s2 = 0; s2 < 2; ++s2) { rrF[kt][s2] = *(const bf16x8*)(rs + ((kt * 2 + s2) * 64 + lane) * 16);
#pragma unroll
                for (int k1 = 0; k1 < 2; ++k1) gF[kt][k1][s2] = *(const bf16x8*)(rs + 4096 + (((kt * 2 + k1) * 2 + s2) * 64 + lane) * 16); }
        oR[0] = *(const v4u*)(rs + 12288 + vt * 2048 + lane * 32); oR[1] = *(const v4u*)(rs + 12288 + vt * 2048 + lane * 32 + 16);
#pragma unroll
        for (int k1 = 0; k1 < 2; ++k1) { nR[k1][0] = *(const v4u*)(rs + 16384 + (k1 * 2 + vt) * 2048 + lane * 32); nR[k1][1] = *(const v4u*)(rs + 16384 + (k1 * 2 + vt) * 2048 + lane * 32 + 16);
#pragma unroll
            for (int gi = 0; gi < 4; ++gi) g4[k1][gi] = *(const f32x4*)(rs + 24576 + (32 * k1 + 8 * gi + 4 * half) * 4); }
        asm volatile("" :: "v"(rrF[0][0]), "v"(rrF[0][1]), "v"(rrF[1][0]), "v"(rrF[1][1]), "v"(gF[0][0][0]), "v"(gF[0][0][1]), "v"(gF[0][1][0]), "v"(gF[0][1][1]), "v"(gF[1][0][0]), "v"(gF[1][0][1]), "v"(gF[1][1][0]), "v"(gF[1][1][1]),
                     "v"(oR[0]), "v"(oR[1]), "v"(nR[0][0]), "v"(nR[0][1]), "v"(nR[1][0]), "v"(nR[1][1]), "v"(g4[0][0]), "v"(g4[0][1]), "v"(g4[0][2]), "v"(g4[0][3]), "v"(g4[1][0]), "v"(g4[1][1]), "v"(g4[1][2]), "v"(g4[1][3]) : "memory");
        f32x16 O = unpack_tile(oR[0], oR[1]);
        f32x16 N[2];
#pragma unroll
        for (int k1 = 0; k1 < 2; ++k1) { N[k1] = unpack_tile(nR[k1][0], nR[k1][1]);
#pragma unroll
            for (int gi = 0; gi < 4; ++gi) { const f32x4 g = g4[k1][gi];
                N[k1][4 * gi] += g.x * ST[k1][4 * gi]; N[k1][4 * gi + 1] += g.y * ST[k1][4 * gi + 1]; N[k1][4 * gi + 2] += g.z * ST[k1][4 * gi + 2]; N[k1][4 * gi + 3] += g.w * ST[k1][4 * gi + 3]; } }
        bf16x8 sf[2][2];
#pragma unroll
        for (int kt = 0; kt < 2; ++kt) { sf[kt][0] = pack8<0>(ST[kt]); sf[kt][1] = pack8<1>(ST[kt]); }
#pragma unroll
        for (int kt = 0; kt < 2; ++kt)
#pragma unroll
            for (int s2 = 0; s2 < 2; ++s2) { O = MFMA32(rrF[kt][s2], sf[kt][s2], O);
#pragma unroll
                for (int k1 = 0; k1 < 2; ++k1) N[k1] = MFMA32(gF[kt][k1][s2], sf[kt][s2], N[k1]); }
        ST[0] = N[0]; ST[1] = N[1];
        bf16* op = RO + ((size_t)b * SEQ + 32 * c) * 1024 + h * 64 + 32 * vt + l31;
#pragma unroll
        for (int r = 0; r < 16; r += 2) { const unsigned w = cvt_pk_bf16(O[r], O[r + 1]);
            op[(size_t)(8 * (r >> 2) + 4 * half + (r & 3)) * 1024] = (bf16)(w & 0xffffu); op[(size_t)(8 * (r >> 2) + 4 * half + (r & 3) + 1) * 1024] = (bf16)(w >> 16); }
    }
}
__device__ __forceinline__ float sum8(float x) { x += dpp_f<0xB1>(x); x += dpp_f<0x4E>(x); x += dpp_f<0x141>(x); return x; }
__device__ __forceinline__ void unpack8(const v4u q, float (&o)[8]) { o[0] = bf_lo(q.x); o[1] = bf_hi(q.x); o[2] = bf_lo(q.y); o[3] = bf_hi(q.y); o[4] = bf_lo(q.z); o[5] = bf_hi(q.z); o[6] = bf_lo(q.w); o[7] = bf_hi(q.w); }
typedef unsigned v8u __attribute__((ext_vector_type(8)));
__device__ __forceinline__ v8u ld2(const void* a, const void* b) { const v4u x = *(const v4u*)a, y = *(const v4u*)b; v8u t; t.lo = x; t.hi = y; return t; }
__device__ __forceinline__ void rwkv_post(const bf16* RO, const bf16* cC, const float* BON, const bf16* GS, const float* mu, const float* gn_w, const float* gn_b, bf16* YC, int gtid, int nthr) {
    const int c8 = gtid & 127, c0 = 8 * c8;
    float muv[8], gwc[8], gbc[8];
#pragma unroll
    for (int e = 0; e < 8; ++e) { muv[e] = mu[2048 + c0 + e]; gwc[e] = gn_w[c0 + e]; gbc[e] = gn_b[c0 + e]; }
    for (int m4 = (gtid >> 7) * 4; m4 < M; m4 += (nthr >> 7) * 4) {
        v8u C[4]; v4u V[4], Pv; f32x2 bn[4];
        const bool hp = (m4 & (SEQ - 1)) > 0; const v4u z4 = (v4u){0u, 0u, 0u, 0u};
        Pv = *(const v4u*)(cC + (size_t)(hp ? m4 - 1 : m4) * 3584 + c0 + 2048);
#pragma unroll
        for (int j = 0; j < 4; ++j) { const int m = m4 + j;
            V[j] = *(const v4u*)(cC + (size_t)m * 3584 + c0 + 2048); C[j] = ld2(GS + (size_t)m * 1024 + c0, RO + (size_t)m * 1024 + c0); bn[j] = *(const f32x2*)(BON + ((size_t)m * 16 + (c8 >> 3)) * 2); }
        asm volatile("" :: "v"(V[0]), "v"(V[1]), "v"(V[2]), "v"(V[3]), "v"(C[0]), "v"(C[1]), "v"(C[2]), "v"(C[3]), "v"(bn[0]), "v"(bn[1]), "v"(bn[2]), "v"(bn[3]), "v"(Pv) : "memory");
        v4u pvv = hp ? Pv : z4;
#pragma unroll
        for (int j = 0; j < 4; ++j) {
            const v4u xv = V[j];
            const float bon = bn[j].x + bn[j].y;
            float o_[8], so = 0.f;
            unpack8((v4u)C[j].hi, o_);
#pragma unroll
            for (int e = 0; e < 8; ++e) so += o_[e];
            const float mean = sum8(so) * (1.0f / 64.0f);
            float sv = 0.f;
#pragma unroll
            for (int e = 0; e < 8; ++e) { o_[e] -= mean; sv += o_[e] * o_[e]; }
            const float rs = 1.0f / sqrtf(sum8(sv) * (1.0f / 64.0f) + 64e-5f);
            float v_[8], p_[8], g_[8], y[8];
            unpack8(xv, v_); unpack8(pvv, p_); unpack8((v4u)C[j].lo, g_);
#pragma unroll
            for (int e = 0; e < 8; ++e) { const float vv = v_[e] + (p_[e] - v_[e]) * muv[e]; y[e] = (o_[e] * rs * gwc[e] + gbc[e] + bon * vv) * g_[e]; }
            pvv = xv;
            v4u w; w.x = cvt_pk_bf16(y[0], y[1]); w.y = cvt_pk_bf16(y[2], y[3]); w.z = cvt_pk_bf16(y[4], y[5]); w.w = cvt_pk_bf16(y[6], y[7]);
            *(v4u*)(YC + (size_t)(m4 + j) * 2560 + c0) = w; }
    }
}
#define XB_TMO      128
#define XB_XCNT(j)  (256  + 64 * (j))
#define XB_XSUB(j)  (1280 + 64 * (j))
#define XB_XGEN(j)  (2304 + 64 * (j))
#define XB_TOP      3328
#define XB_TOPGEN   3392
#define XCD_BAR_WORDS 3456
#define XB_SPIN_CAP (1u << 18)

__device__ __forceinline__ unsigned xb_ld(unsigned* p)              { return __hip_atomic_load(p, __ATOMIC_RELAXED, __HIP_MEMORY_SCOPE_AGENT); }
__device__ __forceinline__ unsigned xb_add(unsigned* p, unsigned v) { return __hip_atomic_fetch_add(p, v, __ATOMIC_RELAXED, __HIP_MEMORY_SCOPE_AGENT); }
__device__ __forceinline__ unsigned xb_xcc_id() { return (unsigned)__builtin_amdgcn_s_getreg((3 << 11) | 20) & 0xFu; }
#define XB_SPIN(cond, bar) do { unsigned _sp = 0; while (cond) { __builtin_amdgcn_s_sleep(1); \
    if ((++_sp & 255u) == 0u) { if (xb_ld(&(bar)[XB_TMO])) break; if (_sp > XB_SPIN_CAP) { atomicAdd(&(bar)[XB_TMO], 1u); break; } } } } while (0)

struct XcdBarrier {
    unsigned* bar; unsigned x;
    volatile LAS unsigned* st;
};

__device__ __forceinline__ XcdBarrier xcd_barrier_post(unsigned* bar, volatile LAS unsigned* st, int tid_) {
    XcdBarrier b; b.bar = bar; b.x = xb_xcc_id(); b.st = st;
    if (tid_ == 0) (void)xb_add(&bar[XB_XCNT(b.x)], 1u);
    return b;
}
__device__ __forceinline__ void xcd_barrier_complete(unsigned* bar, unsigned x, unsigned& nloc, unsigned& nx) {
    const unsigned G = gridDim.x * gridDim.y * gridDim.z;
    unsigned sum, cnt, mine, sp = 0u;
    for (;;) {
        sum = 0u; cnt = 0u; mine = 0u;
#pragma unroll
        for (unsigned j = 0; j < 16; ++j) { const unsigned c = xb_ld(&bar[XB_XCNT(j)]); sum += c; cnt += (c > 0u) ? 1u : 0u; mine = (j == x) ? c : mine; }
        if (sum == G) break;
        __builtin_amdgcn_s_sleep(1);
        if ((++sp & 255u) == 0u) { if (xb_ld(&bar[XB_TMO])) break; if (sp > XB_SPIN_CAP) { atomicAdd(&bar[XB_TMO], 1u); break; } }
    }
    nloc = mine > 0u ? mine : 1u; nx = cnt > 0u ? cnt : 1u;
}

__device__ __forceinline__ void xcd_barrier(const XcdBarrier& b, int tid_) {
    asm volatile("s_waitcnt vmcnt(0)" ::: "memory");
    __syncthreads();
    if (tid_ == 0) {
        unsigned* bar = b.bar;
        __builtin_amdgcn_s_waitcnt(0);
        unsigned nloc = b.st[0], nx = b.st[1];
        if (nloc == 0u) { xcd_barrier_complete(bar, b.x, nloc, nx); b.st[0] = nloc; b.st[1] = nx; }
        const unsigned old = xb_add(&bar[XB_XSUB(b.x)], 1u);
        const unsigned gen = old / nloc;
        if (old + 1u == (gen + 1u) * nloc) {
            __builtin_amdgcn_fence(__ATOMIC_RELEASE, "agent");
            asm volatile("s_waitcnt vmcnt(0)" ::: "memory");
            const unsigned og = xb_add(&bar[XB_TOP], 1u);
            const unsigned tg = og / nx;
            if (og + 1u == (tg + 1u) * nx) xb_add(&bar[XB_TOPGEN], 1u);
            else XB_SPIN(xb_ld(&bar[XB_TOPGEN]) == tg, bar);
            __builtin_amdgcn_fence(__ATOMIC_ACQUIRE, "agent");
            xb_add(&bar[XB_XGEN(b.x)], 1u);
            asm volatile("s_waitcnt vmcnt(0)" ::: "memory");
        } else {
            XB_SPIN(xb_ld(&bar[XB_XGEN(b.x)]) == gen, bar);
            __builtin_amdgcn_fence(__ATOMIC_ACQUIRE, "agent");
            asm volatile("s_waitcnt vmcnt(0)" ::: "memory");
        }
    }
    __syncthreads();
}

struct Args { const float* in[29]; float* out; unsigned char* ws; int ph_lo, ph_hi; };
__global__ void __launch_bounds__(NWAVES * 64, 2) fwd(Args a) {
    extern __shared__ __attribute__((aligned(16))) unsigned char lds_raw[];
    LAS unsigned char* lds = (LAS unsigned char*)lds_raw;
    const int tid0 = threadIdx.x;
    const int G = gridDim.x, bx = blockIdx.x, NGW = G * NWAVES;
#ifdef ZERO_ALL_LDS
    for (int u = tid0; u < LDS_BYTES / 4; u += NWAVES * 64) ((LAS unsigned*)lds)[u] = 0u;
#else
    for (int u = tid0; u < (LDS_BYTES - LDSCTL_OFF) / 4; u += NWAVES * 64) ((LAS unsigned*)(lds + LDSCTL_OFF))[u] = 0u;
#endif
    __syncthreads();
    { const int hwslot_ = (int)__builtin_amdgcn_s_getreg((5 << 11) | 4) & 63; if ((threadIdx.x & 63) == 0) ((LAS int*)(lds + LDSCTL_OFF + 1024))[hwslot_] = (int)(threadIdx.x >> 6); }
    __syncthreads();
    unsigned char* ws0 = a.ws;
    unsigned* ctl = (unsigned*)(ws0 + WS_CTL);
    const int lo = a.ph_lo, hi = a.ph_hi;
    XcdBarrier bar; bar.bar = ctl + CW_BAR; bar.x = 0; bar.st = nullptr;
    if (hi - lo > 1) bar = xcd_barrier_post(ctl + CW_BAR, (volatile LAS unsigned*)(lds + MISC_OFF) + 8, (int)threadIdx.x);
#define PH_IF if (lo <= pc && pc < hi)
#define OPQ(p) do { __attribute__((address_space(1))) char* g_ = (__attribute__((address_space(1))) char*)(p); asm volatile("" : "+s"(g_)); (p) = (decltype(p))g_; } while (0)
#ifndef GDN_OLD
#define GDN_OLD 0
#endif
#ifndef ATT_OLD
#define ATT_OLD 0
#endif
#ifndef REPG
#define REPG 1
#endif
#ifndef REP0
#define REP0 1
#endif
#ifndef REPGP
#define REPGP 1
#endif
#ifndef REP7
#define REP7 1
#endif
#ifndef REPW
#define REPW 1
#endif
#ifndef REPD
#define REPD 1
#endif
#ifndef REPO
#define REPO 1
#endif
#ifndef REPGS
#define REPGS 1
#endif
#ifndef REPRS
#define REPRS 1
#endif
#ifndef RW_WPB
#define RW_WPB 4
#endif
#define RW_END (64 + 256 / RW_WPB)
#ifndef REPA
#define REPA 1
#endif
#ifndef REP8
#define REP8 1
#endif
#ifndef REPP
#define REPP 1
#endif
#ifndef REP6
#define REP6 1
#endif
#ifndef SKIPMASK
#define SKIPMASK 0
#endif
#define PH_IFN(k) if (!((SKIPMASK >> (k)) & 1) && lo <= pc && pc < hi)
#define PH_ENTER unsigned char* ws = ws0; OPQ(ws); const char __attribute__((address_space(4)))* kp_ = (const char __attribute__((address_space(4)))*)__builtin_amdgcn_kernarg_segment_ptr(); OPQ(kp_); const Args __attribute__((address_space(4)))* ap_ = (const Args __attribute__((address_space(4)))*)kp_; int tid = __builtin_amdgcn_readfirstlane(((volatile LAS int*)(lds + LDSCTL_OFF + 1024))[(int)__builtin_amdgcn_s_getreg((5 << 11) | 4) & 63]) * 64 + LANEID_OPQ(); asm volatile("" : "+v"(tid)); const int lane = tid & 63, wave = __builtin_amdgcn_readfirstlane(tid >> 6), gw = bx * NWAVES + wave; LAS float* wl = (LAS float*)(lds + RING_OFF + wave * 16384); (void)lane; (void)gw; (void)wl;
#define LANEID_OPQ() ({ unsigned z_; asm volatile("v_mov_b32 %0, 0" : "=v"(z_)); (int)__builtin_amdgcn_mbcnt_hi(~0u, __builtin_amdgcn_mbcnt_lo(~0u, z_)); })
#define PH_TID (__builtin_amdgcn_readfirstlane(((volatile LAS int*)(lds + LDSCTL_OFF + 1024))[(int)__builtin_amdgcn_s_getreg((5 << 11) | 4) & 63]) * 64 + LANEID_OPQ())
#ifndef NBAR
#define NBAR 1
#endif
#define PH_SEAM do { if (lo <= pc && pc + 1 < hi) for (int nb_ = 0; nb_ < NBAR; ++nb_) xcd_barrier(bar, PH_TID); ++pc; } while (0)
#define WB ((bf16*)(ws + WS_WB))
#define H ((bf16*)(ws + WS_H))
#define ACT ((bf16*)(ws + WS_ACT))
#define CA ((bf16*)(ws + WS_CA))
#define CB ((bf16*)(ws + WS_CB))
#define CC ((bf16*)(ws + WS_CC))
#define CG ((bf16*)(ws + WS_CG))
#define QR ((bf16*)(ws + WS_QR))
#define KR ((bf16*)(ws + WS_KR))
#define KT ((bf16*)(ws + WS_KT))
#define VT ((bf16*)(ws + WS_VT))
#define OG ((bf16*)(ws + WS_OG))
#define FR (ws + WS_FR)
#define UF ((float*)(ws + WS_UF))
#define GSC ((float*)(ws + WS_GSC))
#define GO ((bf16*)(ws + WS_GO))
#define LSE ((float*)(ws + WS_LSE))
#define RSO (ws + WS_RSO)
#define RO ((bf16*)(ws + WS_RO))
#define VS ((bf16*)(ws + WS_VS))
#define GS ((bf16*)(ws + WS_GS))
#define BON ((float*)(ws + WS_BON))
#define W2T ((bf16*)(ws + WS_LW) + (size_t)l * 524288)
#define A2T ((bf16*)(ws + WS_LW) + (size_t)l * 524288 + 131072)
#define G2T ((bf16*)(ws + WS_LW) + (size_t)l * 524288 + 262144)
#define YA ((bf16*)(ws + WS_YA))
#define YB ((bf16*)(ws + WS_YA) + 512)
#define YC ((bf16*)(ws + WS_YA) + 1536)
#define MB ((bf16*)(ws + WS_MB))
#define MT ((float*)(ws + WS_MT))
#define INP(i) ((const float*)(__attribute__((address_space(1))) const float*)ap_->in[i])
#define X ((float*)(__attribute__((address_space(1))) float*)ap_->out)

    int pc = 0;
    for (int l = 0; l < DEPTH; ++l) {
        for (int f = 0; f < 2; ++f) {
            PH_IFN(0) for (int r0_ = 0; r0_ < REP0; ++r0_) { PH_ENTER if (r0_) __syncthreads();
                if (f == 0) {
                    int rot = 0;
                    conv_matrix(INP(2) + (size_t)l * D * 2 * FF, D, 2 * FF, WB + W_GU1, 2 * FF, MapGu(), wl, rot, gw, NGW, lane);
                    conv_matrix(INP(3) + (size_t)l * FF * D, FF, D, WB + W_D1, D, MapId(), wl, rot, gw, NGW, lane);
                    conv_matrix(INP(5) + (size_t)l * D * 18384, D, 18384, WB + W_IN, NIN_PAD, MapIn(), wl, rot, gw, NGW, lane);
                    conv_matrix(INP(21) + (size_t)l * 512 * D, 512, D, WB + W_PA, D, MapId(), wl, rot, gw, NGW, lane, 512, 2560);
                    conv_matrix(INP(22) + (size_t)l * 1024 * D, 1024, D, WB + W_PA + 512, D, MapId(), wl, rot, gw, NGW, lane, 1024, 2560);
                    conv_matrix(INP(23) + (size_t)l * 1024 * D, 1024, D, WB + W_PA + 1536, D, MapId(), wl, rot, gw, NGW, lane, 1024, 2560);
                    conv_matrix(INP(24) + (size_t)l * D * D, D, D, WB + W_WO, D, MapId(), wl, rot, gw, NGW, lane);
                    conv_matrix(INP(26) + (size_t)l * D * 2 * FF, D, 2 * FF, WB + W_GU2, 2 * FF, MapGu(), wl, rot, gw, NGW, lane);
                    conv_matrix(INP(27) + (size_t)l * FF * D, FF, D, WB + W_D2, D, MapId(), wl, rot, gw, NGW, lane);
                    conv_matrix(INP(12) + (size_t)l * 96 * 1024, 96, 1024, W2T, 1024, MapId(), wl, rot, gw, NGW, lane, 128);
                    conv_matrix(INP(14) + (size_t)l * 96 * 1024, 96, 1024, A2T, 1024, MapId(), wl, rot, gw, NGW, lane, 128);
                    conv_matrix(INP(15) + (size_t)l * 256 * 1024, 256, 1024, G2T, 1024, MapId(), wl, rot, gw, NGW, lane);
                }
                const bool first = (l == 0 && f == 0);
                norm_rows(first ? INP(0) : X, first ? X : nullptr, (f == 0 ? INP(1) : INP(25)) + (size_t)l * D, H, gw, NGW, lane);
            }
            PH_SEAM;
            PH_IFN(1) { PH_ENTER
                const bf16* pa_ = H; const bf16* pb_ = WB + (f == 0 ? W_GU1 : W_GU2); bf16* po_ = ACT; OPQ(pa_); OPQ(pb_); OPQ(po_);
                pg8::Gemm g{pa_, pb_, M, 2 * FF, D}; pg8::StaticOrder S; S.init(M, 2 * FF, G, bx);
                pg8::EpiSwiglu E{po_, FF};
                for (int rg_ = 0; rg_ < REPG; ++rg_) { if (rg_) __syncthreads(); pg8::gemm_phase<pg8::EpiSwiglu, pg8::StaticOrder, true, true>(lds + RING_OFF, g, S, E, tid); }
            }
            PH_SEAM;
            PH_IFN(2) { PH_ENTER
                const bf16* pa_ = ACT; const bf16* pb_ = WB + (f == 0 ? W_D1 : W_D2); float* po_ = X; OPQ(pa_); OPQ(pb_); OPQ(po_);
                pg8::Gemm g{pa_, pb_, M, D, FF}; pg8::StaticOrder S; S.init(M, D, G, bx);
                for (int rd_ = 0; rd_ < REPD; ++rd_) { if (rd_) __syncthreads(); pg8::EpiResid E{po_, D, rd_ + 1 < REPD ? 0.0f : 0.5f};
                pg8::gemm_phase<pg8::EpiResid, pg8::StaticOrder, true, true>(lds + RING_OFF, g, S, E, tid); }
            }
            PH_SEAM;
            if (f == 0) {
                PH_IFN(3) { PH_ENTER
                    const float* px = X; bf16* ph = H; OPQ(px); OPQ(ph); norm_rows(px, nullptr, INP(4) + (size_t)l * D, ph, gw, NGW, lane); }
                PH_SEAM;
                PH_IFN(4) { PH_ENTER
                    const bf16* pa_ = H; const bf16* pb_ = WB + W_IN; bf16 *o0 = CA, *o1 = CB, *o2 = CC, *o3 = CG; OPQ(pa_); OPQ(pb_); OPQ(o0); OPQ(o1); OPQ(o2); OPQ(o3);
                    pg8::Gemm g{pa_, pb_, M, NIN_PAD, D}; pg8::StaticOrder S; S.init(M, NIN_PAD, G, bx);
                    pg8::EpiCols E{o0, o1, o2, o3};
                    for (int rw_ = 0; rw_ < REPW; ++rw_) { if (rw_) __syncthreads(); pg8::gemm_phase<pg8::EpiCols, pg8::StaticOrder, true, true>(lds + RING_OFF, g, S, E, tid); }
                }
                PH_SEAM;
                PH_IFN(5) { PH_ENTER
                    { const bf16* p0 = CC; unsigned char* p1 = RSO; float* p2 = (float*)(ws + WS_BON2); bf16* p3 = GS; unsigned char* p5 = ws + WS_SCR; const bf16 *p6 = W2T, *p7 = A2T, *p8 = G2T; OPQ(p0); OPQ(p1); OPQ(p2); OPQ(p3); OPQ(p5); OPQ(p6); OPQ(p7); OPQ(p8);
                      for (int rp_ = 0; rp_ < REPP; ++rp_)
                      for (int grp = bx; grp < M / 64; grp += G)
                          rwkv_prep_blk(p0, INP(10) + (size_t)l * 3520, INP(11) + (size_t)l * 1024, INP(13) + (size_t)l * 1024, INP(16) + (size_t)l * 1024, INP(17) + (size_t)l * 1024, INP(18) + (size_t)l * 1024,
                                        p6, p7, p8, p1, p2, p3, p5, grp, tid, lds + RING_OFF); }
                    { const bf16* p0 = CB; const bf16* p1 = CC; bf16 *p2 = QR, *p3 = KR, *p4 = KT, *p5 = VT; unsigned char* p6 = FR; float *p7 = UF, *p8 = GSC; OPQ(p0); OPQ(p1); OPQ(p2); OPQ(p3); OPQ(p4); OPQ(p5); OPQ(p6); OPQ(p7); OPQ(p8);
#ifndef NO_GDN_PREP
                      for (int rgp_ = 0; rgp_ < REPGP; ++rgp_)
                      for (int unit = gw; unit < (M / 64) * 8; unit += NGW)
                          gdn_prep_unit(p0, p1, INP(6) + (size_t)l * 4 * 3072, INP(7) + (size_t)l * 8, INP(8) + (size_t)l * 8, p2, p3, p4, p5, p6, p7, p8, unit, lane, lds + RING_OFF + wave * 16384);
#endif
                    }
                }
                PH_SEAM;
                PH_IFN(6) for (int rep_ = 0; rep_ < REP6; ++rep_) { PH_ENTER if (rep_ > 0) { __syncthreads(); }
                    if (bx < 64) { const unsigned char* p0 = FR; const float* p1 = UF; const float* p2 = GSC; bf16* p3 = GO; OPQ(p0); OPQ(p1); OPQ(p2); OPQ(p3); for (int rgs_ = 0; rgs_ < REPGS; ++rgs_) { if (rgs_) __syncthreads(); gdn_scan_blk(p0, p1, p2, p3, bx, tid, lds + RING_OFF); } }
                    else if (bx < RW_END) { if (wave < RW_WPB) { const unsigned char* p0 = RSO; bf16* p1 = RO; OPQ(p0); OPQ(p1); for (int rrs_ = 0; rrs_ < REPRS; ++rrs_) rwkv_scan_wave(p0, p1, (bx - 64) * RW_WPB + wave, lane); } }
                    else { const bf16* p0 = CA; bf16* p1 = OG; float* p2 = LSE; OPQ(p0); OPQ(p1); OPQ(p2); const int ab = __builtin_amdgcn_readfirstlane(tid >> 9) + (int)blockIdx.x - RW_END, an = G - RW_END; for (int ra_ = 0; ra_ < REPA; ++ra_) attn_phase(p0, p1, p2, lds + RING_OFF, tid, ab, an); }
                }
                PH_SEAM;
                PH_IFN(7) for (int r7_ = 0; r7_ < REP7; ++r7_) { PH_ENTER const bf16* p0 = GO; const bf16* p1 = CB; bf16* p2 = YB; OPQ(p0); OPQ(p1); OPQ(p2); gdn_post(p0, p1, INP(9) + (size_t)l * 128, p2, bx * NWAVES * 64 + tid, G * NWAVES * 64);
                    { const bf16* q0 = RO; const bf16* q1 = CC; const float* q2 = (const float*)(ws + WS_BON2); const bf16* q3 = GS; bf16* q4 = YC; OPQ(q0); OPQ(q1); OPQ(q2); OPQ(q3); OPQ(q4);
                      rwkv_post(q0, q1, q2, q3, INP(10) + (size_t)l * 3520, INP(19) + (size_t)l * 1024, INP(20) + (size_t)l * 1024, q4, bx * NWAVES * 64 + tid, G * NWAVES * 64); }
                    const bf16* p3 = OG; const float* p4 = LSE; bf16* p5 = YA; OPQ(p3); OPQ(p4); OPQ(p5); attn_combine(p3, p4, p5, bx * NWAVES * 64 + tid, G * NWAVES * 64);
                }
                PH_SEAM;
                PH_IFN(8) for (int r8_ = 0; r8_ < REP8; ++r8_) { PH_ENTER if (r8_) __syncthreads();
                    pg8::StaticOrder S; S.init(M, D, G, bx);
                    { const bf16* pa_ = YA; const bf16* pb_ = WB + W_PA; const bf16* pg_ = CG; bf16* po_ = MB; OPQ(pa_); OPQ(pb_); OPQ(pg_); OPQ(po_);
                      pg8::Gemm g{pa_, pb_, M, D, 2560}; pg8::EpiGate3 E{pg_, po_}; pg8::gemm_phase<pg8::EpiGate3, pg8::StaticOrder, true, true>(lds + RING_OFF, g, S, E, tid); }
                }
                PH_SEAM;
                PH_IFN(9) { PH_ENTER
                    const bf16* pa_ = MB; const bf16* pb_ = WB + W_WO; float* po_ = X; OPQ(pa_); OPQ(pb_); OPQ(po_);
                    pg8::Gemm g{pa_, pb_, M, D, D}; pg8::StaticOrder S; S.init(M, D, G, bx);
                    for (int ro_ = 0; ro_ < REPO; ++ro_) { if (ro_) __syncthreads(); pg8::EpiResid E{po_, D, ro_ + 1 < REPO ? 0.0f : 1.0f};
                    pg8::gemm_phase<pg8::EpiResid, pg8::StaticOrder, true, true>(lds + RING_OFF, g, S, E, tid); }
                }
                PH_SEAM;
            }
        }
    }
    PH_IFN(10) { PH_ENTER float* px = X; OPQ(px); final_norm_rows(px, INP(28), gw, NGW, lane); }
#undef PH_IF
#undef PH_SEAM
}

extern "C" void kernel_launch(void* const* d_in, const int* in_sizes, int n_in, void* d_out, int out_size, void* d_ws, size_t ws_size, hipStream_t stream) {
    static int grid = 0;
    if (grid == 0) {
        if (n_in != 29 || out_size != M * D || ws_size < WS_END) { fprintf(stderr, "kernel_launch: unexpected shapes (n_in %d out %d ws %zu)\n", n_in, out_size, ws_size); grid = -1; return; }
        int dev = 0, cus = 0;
        if (hipGetDevice(&dev) != hipSuccess || hipDeviceGetAttribute(&cus, hipDeviceAttributeMultiprocessorCount, dev) != hipSuccess) { grid = -1; return; }
        if (hipFuncSetAttribute((const void*)fwd, hipFuncAttributeMaxDynamicSharedMemorySize, LDS_BYTES) != hipSuccess) { fprintf(stderr, "kernel_launch: hipFuncSetAttribute failed\n"); grid = -1; return; }
        int per_cu = 0; (void)hipOccupancyMaxActiveBlocksPerMultiprocessor(&per_cu, (const void*)fwd, NWAVES * 64, LDS_BYTES); (void)hipGetLastError();
        grid = cus;
        if (per_cu < 1) fprintf(stderr, "kernel_launch: occupancy query reports %d\n", per_cu);
    }
    if (grid < 0) return;
    if (hipMemsetAsync((char*)d_ws + WS_CTL, 0, CTL_ZERO_BYTES, stream) != hipSuccess) return;
#ifdef POISON_HOST
    (void)hipMemsetAsync((char*)d_ws + WS_H, 0x3C, WS_END - WS_H, stream);
#endif
    Args a{};
    for (int i = 0; i < 29; ++i) a.in[i] = (const float*)d_in[i];
    a.out = (float*)d_out; a.ws = (unsigned char*)d_ws;
#if MK_PER_PHASE
    for (int p = 0; p < N_PHASES; ++p) { a.ph_lo = p; a.ph_hi = p + 1; hipLaunchKernelGGL(fwd, dim3(grid), dim3(NWAVES * 64), LDS_BYTES, stream, a); }
#else
    a.ph_lo = 0; a.ph_hi = N_PHASES; hipLaunchKernelGGL(fwd, dim3(grid), dim3(NWAVES * 64), LDS_BYTES, stream, a);
#endif
}
```
